# Optimizing an MI355X kernel written in HIP

```python
import math
import jax
import jax.numpy as jnp
from jax import lax
import numpy as np

D_MODEL = 1024
BATCH = 32
SEQ = 256
DEPTH = 4
DEC_BATCH = 2
DEC_SEQ = 2048
PAST_LEN = 256

GRID_W = 64
N_MIXERS = 3
N_GLA = (DEPTH + 2) // 3
N_FN = (DEPTH + 1) // 3
N_HY = DEPTH // 3
EPS = 1e-6

GLA_HEADS = 4
GLA_KEY = D_MODEL // 2
GLA_VAL = D_MODEL
GLA_DK = GLA_KEY // GLA_HEADS
GLA_DV = GLA_VAL // GLA_HEADS
GLA_RANK = 16
GLA_GATE_NORM = 16.0
GLA_CHUNK = 32
GLA_IN = 2 * GLA_KEY + 2 * GLA_VAL + 2 * GLA_RANK

FN_WIDTH = D_MODEL
FN_GROUPS = 4
FN_GC = FN_WIDTH // FN_GROUPS

HY_WIDTH = D_MODEL
HY_ORDER = 2
HY_SHORT = 3
HY_EMB = 33
HY_BANDS = (HY_EMB - 1) // 2
HY_FFN = 64
HY_TARGET = 1e-2
HY_MIN_DECAY = math.log(HY_TARGET) / 1.5
HY_MAX_DECAY = math.log(HY_TARGET) / 0.3

kernel_name = 'hybrid_gla_fnet_hyena_prefix_dit_step'

F32 = jnp.float32


def rms_norm(x, g):
    xf = x.astype(F32)
    y = xf * lax.rsqrt(jnp.mean(xf * xf, axis=-1, keepdims=True) + EPS)
    return (y * g.astype(F32)).astype(x.dtype)


def gla_scan(q, k, v, logg, s0):
    bsz, L, H, _ = q.shape
    dv = v.shape[-1]
    n = L // GLA_CHUNK

    def chunks(a):
        return a.reshape(bsz, n, GLA_CHUNK, *a.shape[2:]).swapaxes(0, 1)

    tri = jnp.tril(jnp.ones((GLA_CHUNK, GLA_CHUNK), dtype=bool))[None, :, :, None, None]

    def step(s, inp):
        qi, ki, vi, gi = inp
        bcum = jnp.cumsum(gi, axis=1)
        o_inter = jnp.einsum('bchk,bhkv->bchv', qi * jnp.exp(bcum), s)
        diff = bcum[:, :, None] - bcum[:, None, :]
        dec = jnp.where(tri, jnp.exp(jnp.where(tri, diff, 0.0)), 0.0)
        att = jnp.einsum('bqhk,bshk,bqshk->bhqs', qi.astype(F32), ki.astype(F32), dec)
        o_intra = jnp.einsum('bhqs,bshv->bqhv', att, vi.astype(F32))
        blast = bcum[:, -1]
        s_new = jnp.exp(blast)[..., None] * s + jnp.einsum(
            'bshk,bshv->bhkv', ki * jnp.exp(blast[:, None] - bcum), vi.astype(F32))
        return s_new, o_inter + o_intra

    s_fin, o = lax.scan(step, s0.astype(F32), (chunks(q), chunks(k), chunks(v), chunks(logg)))
    return o.swapaxes(0, 1).reshape(bsz, L, H, dv), s_fin


def gla_mixer(h, w_in, w_dec, b_dec, onorm_g, w_out, s0_f, s0_b):
    bsz, L, _ = h.shape
    proj = h @ w_in
    o1 = GLA_KEY
    o2 = 2 * GLA_KEY
    o3 = o2 + GLA_VAL
    o4 = o3 + GLA_VAL
    o5 = o4 + GLA_RANK
    q = (proj[..., :o1] * GLA_DK ** -0.5).reshape(bsz, L, GLA_HEADS, GLA_DK)
    k = proj[..., o1:o2].reshape(bsz, L, GLA_HEADS, GLA_DK)
    v = proj[..., o2:o3].reshape(bsz, L, GLA_HEADS, GLA_DV)
    r = proj[..., o3:o4]

    def log_decay(lr, d):
        logit = (lr @ w_dec[d] + b_dec[d]).astype(F32)
        return (jax.nn.log_sigmoid(logit) / GLA_GATE_NORM).reshape(bsz, L, GLA_HEADS, GLA_DK)

    g_f = log_decay(proj[..., o4:o5], 0)
    g_b = log_decay(proj[..., o5:], 1)
    o_f, s_f = gla_scan(q, k, v, g_f, s0_f)
    o_b, s_b = gla_scan(jnp.flip(q, 1), jnp.flip(k, 1), jnp.flip(v, 1), jnp.flip(g_b, 1), s0_b)
    o = o_f + jnp.flip(o_b, 1)
    o = o * lax.rsqrt(jnp.mean(o * o, axis=-1, keepdims=True) + EPS) * onorm_g.astype(F32)
    o = o.reshape(bsz, L, GLA_VAL) * jax.nn.silu(r.astype(F32))
    return o.astype(h.dtype) @ w_out, s_f, s_b


def fnet_mixer(h, w_in, w_out):
    bsz, L, _ = h.shape
    proj = h @ w_in
    u, z = proj[..., :FN_WIDTH], proj[..., FN_WIDTH:]
    ug = u.astype(F32).reshape(bsz, L, FN_GROUPS, FN_GC)
    f = jnp.fft.fft2(ug, axes=(1, 3), norm='ortho').real.reshape(bsz, L, FN_WIDTH)
    y = f * jax.nn.silu(z.astype(F32))
    return y.astype(h.dtype) @ w_out


def hyena_filters(L, w1, b1, w2, b2, w3, b3, w4, freq):
    t = jnp.linspace(0.0, 1.0, L, dtype=F32)[:, None]
    w = 2.0 * math.pi * jnp.arange(L, dtype=F32)[:, None] / L
    f = jnp.linspace(1e-4, HY_BANDS - 1, HY_BANDS, dtype=F32)[None, :]
    zpos = jnp.concatenate([t, jnp.cos(f * w), -jnp.sin(f * w)], axis=-1)
    fr = freq.astype(F32)
    a = jnp.sin(fr * (zpos @ w1 + b1))
    a = jnp.sin(fr * (a @ w2 + b2))
    a = jnp.sin(fr * (a @ w3 + b3))
    hf = (a @ w4).astype(F32).reshape(L, HY_ORDER, 2, HY_WIDTH)
    deltas = jnp.abs(jnp.linspace(HY_MIN_DECAY, HY_MAX_DECAY, HY_WIDTH, dtype=F32))
    hf = hf * jnp.exp(-t * deltas)[:, None, None, :]
    fwd, bwd = hf[:, :, 0], hf[:, :, 1]
    two_sided = jnp.concatenate(
        [fwd, jnp.zeros((1, HY_ORDER, HY_WIDTH), F32), jnp.flip(bwd[1:], axis=0)], axis=0)
    return jnp.fft.rfft(two_sided, axis=0)


def long_conv(u, filt_f):
    L = u.shape[1]
    U = jnp.fft.rfft(u, n=2 * L, axis=1)
    return jnp.fft.irfft(U * filt_f[None], n=2 * L, axis=1)[:, :L]


def hyena_mixer(h, w_in, conv_w, conv_b, w1, b1, w2, b2, w3, b3, w4, freq, d_skip, w_out):
    L = h.shape[1]
    proj = h @ w_in
    u, z = proj[..., :3 * HY_WIDTH], proj[..., 3 * HY_WIDTH:]
    up = jnp.pad(u, ((0, 0), (1, 1), (0, 0)))
    u = up[:, :-2] * conv_w[0] + up[:, 1:-1] * conv_w[1] + up[:, 2:] * conv_w[2] + conv_b
    x1, x2, v = jnp.split(u.astype(F32), 3, axis=-1)
    filt_f = hyena_filters(L, w1, b1, w2, b2, w3, b3, w4, freq)
    y = v
    for n, gate in enumerate((x1, x2)):
        y = gate * (long_conv(y, filt_f[:, n]) + y * d_skip[n].astype(F32))
    y = y * jax.nn.silu(z.astype(F32))
    return y.astype(h.dtype) @ w_out


def setup_inputs(seed: int = 0) -> dict:
    key = jax.random.key(seed)
    ks = iter(jax.random.split(key, 40))

    def nrm(shape, scale):
        return jax.random.normal(next(ks), shape, F32) * scale

    D = D_MODEL
    return {
        'x_prompt': nrm((BATCH, SEQ, D), 1.0),
        'x_sample': nrm((DEC_BATCH, DEC_SEQ, D), 1.0),
        'state_gla': nrm((DEC_BATCH, N_GLA, 2, GLA_HEADS, GLA_DK, GLA_DV), 1.0),
        'c': nrm((DEC_BATCH, D), 1.0),
        'c_ctx': nrm((D,), 1.0),
        'mod_w': nrm((DEPTH, D, 3 * D), 0.5 * D ** -0.5),
        'mod_b': nrm((DEPTH, 3 * D), 0.01),
        'norm_g': 1.0 + nrm((DEPTH, D), 0.05),
        'final_norm_g': 1.0 + nrm((D,), 0.05),
        'gla_w_in': nrm((N_GLA, D, GLA_IN), D ** -0.5),
        'gla_w_dec': nrm((N_GLA, 2, GLA_RANK, GLA_KEY), GLA_RANK ** -0.5),
        'gla_b_dec': nrm((N_GLA, 2, GLA_KEY), 0.5),
        'gla_onorm_g': 1.0 + nrm((N_GLA, GLA_DV), 0.05),
        'gla_w_out': nrm((N_GLA, GLA_VAL, D), GLA_VAL ** -0.5),
        'fn_w_in': nrm((N_FN, D, 2 * FN_WIDTH), D ** -0.5),
        'fn_w_out': nrm((N_FN, FN_WIDTH, D), FN_WIDTH ** -0.5),
        'hy_w_in': nrm((N_HY, D, 4 * HY_WIDTH), D ** -0.5),
        'hy_conv_w': nrm((N_HY, HY_SHORT, 3 * HY_WIDTH), HY_SHORT ** -0.5),
        'hy_conv_b': nrm((N_HY, 3 * HY_WIDTH), 0.02),
        'hy_ffn_w1': nrm((N_HY, HY_EMB, HY_FFN), HY_EMB ** -0.5),
        'hy_ffn_b1': nrm((N_HY, HY_FFN), 0.1),
        'hy_ffn_w2': nrm((N_HY, HY_FFN, HY_FFN), HY_FFN ** -0.5),
        'hy_ffn_b2': nrm((N_HY, HY_FFN), 0.1),
        'hy_ffn_w3': nrm((N_HY, HY_FFN, HY_FFN), HY_FFN ** -0.5),
        'hy_ffn_b3': nrm((N_HY, HY_FFN), 0.1),
        'hy_ffn_w4': nrm((N_HY, HY_FFN, HY_ORDER * 2 * HY_WIDTH), 0.1 * HY_FFN ** -0.5),
        'hy_freq': 1.0 + nrm((N_HY, HY_FFN), 0.1),
        'hy_d': nrm((N_HY, HY_ORDER, HY_WIDTH), 0.5),
        'hy_w_out': nrm((N_HY, HY_WIDTH, D), HY_WIDTH ** -0.5),
    }


def reference(x_prompt, x_sample, state_gla, c, c_ctx, mod_w, mod_b, norm_g, final_norm_g,
              gla_w_in, gla_w_dec, gla_b_dec, gla_onorm_g, gla_w_out,
              fn_w_in, fn_w_out,
              hy_w_in, hy_conv_w, hy_conv_b, hy_ffn_w1, hy_ffn_b1, hy_ffn_w2, hy_ffn_b2,
              hy_ffn_w3, hy_ffn_b3, hy_ffn_w4, hy_freq, hy_d, hy_w_out):
    ctx_mod = jnp.einsum('d,lde->le', jax.nn.silu(c_ctx), mod_w) + mod_b
    lat_mod = jnp.einsum('bd,lde->lbe', jax.nn.silu(c), mod_w) + mod_b[:, None]
    xp, xs = x_prompt, x_sample
    new_states = []
    for i in range(DEPTH):
        kind, j = i % N_MIXERS, i // N_MIXERS
        sh_c, sc_c, g_c = jnp.split(ctx_mod[i], 3, axis=-1)
        sh_s, sc_s, g_s = jnp.split(lat_mod[i][:, None, :], 3, axis=-1)
        hp = rms_norm(xp, norm_g[i]) * (1.0 + sc_c) + sh_c
        hs = rms_norm(xs, norm_g[i]) * (1.0 + sc_s) + sh_s
        if kind == 0:
            zero = jnp.zeros((xp.shape[0], GLA_HEADS, GLA_DK, GLA_DV), F32)
            prm = (gla_w_in[j], gla_w_dec[j], gla_b_dec[j], gla_onorm_g[j], gla_w_out[j])
            op, s_f, s_b = gla_mixer(hp, *prm, zero, zero)
            os_, _, _ = gla_mixer(hs, *prm, state_gla[:, j, 0], state_gla[:, j, 1])
            new_states.append(jnp.stack([s_f, s_b], axis=1))
        elif kind == 1:
            op = fnet_mixer(hp, fn_w_in[j], fn_w_out[j])
            os_ = fnet_mixer(hs, fn_w_in[j], fn_w_out[j])
        else:
            prm = (hy_w_in[j], hy_conv_w[j], hy_conv_b[j], hy_ffn_w1[j], hy_ffn_b1[j],
                   hy_ffn_w2[j], hy_ffn_b2[j], hy_ffn_w3[j], hy_ffn_b3[j], hy_ffn_w4[j],
                   hy_freq[j], hy_d[j], hy_w_out[j])
            op = hyena_mixer(hp, *prm)
            os_ = hyena_mixer(hs, *prm)
        xp = xp + g_c * op
        xs = xs + g_s * os_
    y_prompt = rms_norm(xp, final_norm_g)
    y_sample = rms_norm(xs, final_norm_g)
    new_state_gla = jnp.stack(new_states, axis=1).astype(x_prompt.dtype)
    return (y_prompt, y_sample, new_state_gla)
```

```cpp
#include <hip/hip_runtime.h>
#include <hip/hip_cooperative_groups.h>
#include <cstdio>
namespace cg = cooperative_groups;

typedef unsigned short bf16_t;
typedef short bf16x8 __attribute__((ext_vector_type(8)));
typedef float f32x16 __attribute__((ext_vector_type(16)));

#ifndef PROBE
#define PROBE 0
#endif
#define NTOK 12288
#define NCTX 8192
#define DM 1024
#define LCTX 256
#define LLAT 2048
#define NTHR 256
#define SMEM_BYTES 73728
#define LDSS 72
#define TWO_PI 6.283185307179586f

struct Params {
  const float *x_prompt, *x_sample, *state_gla, *c, *c_ctx, *mod_w, *mod_b, *norm_g, *final_norm_g;
  const float *gla_w_in, *gla_w_dec, *gla_b_dec, *gla_onorm_g, *gla_w_out;
  const float *fn_w_in, *fn_w_out;
  const float *hy_w_in, *hy_conv_w, *hy_conv_b, *hy_w1, *hy_b1, *hy_w2, *hy_b2, *hy_w3, *hy_b3, *hy_w4, *hy_freq, *hy_d, *hy_w_out;
  float* out;
  bf16_t* h;
  bf16_t* big;
  float* modv;
  bf16_t* wt_gla_in0; bf16_t* wt_gla_in1; bf16_t* wt_gla_out0; bf16_t* wt_gla_out1;
  bf16_t* wt_fn_in; bf16_t* wt_fn_out; bf16_t* wt_hy_in; bf16_t* wt_hy_out;
  bf16_t* tabA; bf16_t* tabB_ctx; bf16_t* tabB_lat;
  bf16_t* filt_ctx; bf16_t* filt_lat;
  float* filt_a3;
  unsigned* bar;
  int use_cg; int pad;
};

typedef __bf16 bf16n2 __attribute__((ext_vector_type(2)));
typedef float f32n2 __attribute__((ext_vector_type(2)));
__device__ __forceinline__ unsigned pk2(float a, float b) {
  f32n2 v = {a, b};
  return __builtin_bit_cast(unsigned, __builtin_convertvector(v, bf16n2));
}
__device__ __forceinline__ bf16_t f2bf(float x) { return (bf16_t)(pk2(x, 0.f) & 0xffffu); }
__device__ __forceinline__ float bf2f(bf16_t b) { return __uint_as_float(((unsigned)b) << 16); }
__device__ __forceinline__ float siluf(float x) { return x / (1.f + expf(-x)); }
__device__ __forceinline__ float logsigf(float x) { return fminf(x, 0.f) - log1pf(expf(-fabsf(x))); }
__device__ __forceinline__ int opaque_tid() { int t = threadIdx.x; asm volatile("" : "+v"(t)); return t; }
__device__ __forceinline__ int opq(int t) { asm volatile("" : "+v"(t)); return t; }
__device__ __forceinline__ int opaque_bid() { int b = blockIdx.x; asm volatile("" : "+s"(b)); return b; }
__device__ __forceinline__ int first_item_(int bid, int off) {
  int G = gridDim.x;
  return (int)((bid + G - (off % G)) % G);
}
#define first_item(off) first_item_(bid, off)

#define GEMM_BUF (2 * 128 * LDSS)
__device__ __forceinline__ void gemm_tile(const bf16_t* __restrict__ A, long lda, const bf16_t* __restrict__ B, long ldb,
                                          int K, bf16_t* sbase, f32x16 (&acc)[2][2], const int tid) {
  const int lane = tid & 63, wave = tid >> 6;
  const int wm = wave >> 1, wn = wave & 1;
  const int lr = tid >> 3, lc = (tid & 7) * 8;
#pragma unroll
  for (int i = 0; i < 2; ++i)
#pragma unroll
    for (int j = 0; j < 2; ++j)
#pragma unroll
      for (int r = 0; r < 16; ++r) acc[i][j][r] = 0.f;
  const bf16_t* pa = A + (long)lr * lda + lc;
  const bf16_t* pb = B + (long)lr * ldb + lc;
  uint4 xa0, xa1, xa2, xa3, xb0, xb1, xb2, xb3;
  uint4 ya0, ya1, ya2, ya3, yb0, yb1, yb2, yb3;
#define GEMM_GLOAD(S, ko)                                  \
  S##a0 = *(const uint4*)(pa + (ko));                      \
  S##a1 = *(const uint4*)(pa + 32 * lda + (ko));           \
  S##a2 = *(const uint4*)(pa + 64 * lda + (ko));           \
  S##a3 = *(const uint4*)(pa + 96 * lda + (ko));           \
  S##b0 = *(const uint4*)(pb + (ko));                      \
  S##b1 = *(const uint4*)(pb + 32 * ldb + (ko));           \
  S##b2 = *(const uint4*)(pb + 64 * ldb + (ko));           \
  S##b3 = *(const uint4*)(pb + 96 * ldb + (ko));
#define GEMM_LSTORE(S, buf)                                                                      \
  { bf16_t* wa = sbase + (buf) * GEMM_BUF + lr * LDSS + lc; bf16_t* wb = wa + 128 * LDSS;         \
    *(uint4*)(wa) = S##a0; *(uint4*)(wa + 32 * LDSS) = S##a1; *(uint4*)(wa + 64 * LDSS) = S##a2; *(uint4*)(wa + 96 * LDSS) = S##a3; \
    *(uint4*)(wb) = S##b0; *(uint4*)(wb + 32 * LDSS) = S##b1; *(uint4*)(wb + 64 * LDSS) = S##b2; *(uint4*)(wb + 96 * LDSS) = S##b3; }
#define GEMM_COMPUTE(buf)                                                                         \
  { __builtin_amdgcn_s_setprio(1); const bf16_t* ra = sbase + (buf) * GEMM_BUF + (wm * 64 + (lane & 31)) * LDSS + (lane >> 5) * 8; \
    const bf16_t* rb = sbase + (buf) * GEMM_BUF + 128 * LDSS + (wn * 64 + (lane & 31)) * LDSS + (lane >> 5) * 8; \
    _Pragma("unroll") for (int kk = 0; kk < 4; ++kk) {                                            \
      const bf16x8 af0 = *(const bf16x8*)(ra + kk * 16), af1 = *(const bf16x8*)(ra + 32 * LDSS + kk * 16); \
      const bf16x8 bf0 = *(const bf16x8*)(rb + kk * 16), bf1 = *(const bf16x8*)(rb + 32 * LDSS + kk * 16); \
      acc[0][0] = __builtin_amdgcn_mfma_f32_32x32x16_bf16(af0, bf0, acc[0][0], 0, 0, 0);         \
      acc[0][1] = __builtin_amdgcn_mfma_f32_32x32x16_bf16(af0, bf1, acc[0][1], 0, 0, 0);         \
      acc[1][0] = __builtin_amdgcn_mfma_f32_32x32x16_bf16(af1, bf0, acc[1][0], 0, 0, 0);         \
      acc[1][1] = __builtin_amdgcn_mfma_f32_32x32x16_bf16(af1, bf1, acc[1][1], 0, 0, 0);         \
    } __builtin_amdgcn_s_setprio(0); }
  const int nk = K >> 6;
  GEMM_GLOAD(x, 0)
  if (nk > 1) { GEMM_GLOAD(y, 64) }
  __syncthreads();
  GEMM_LSTORE(x, 0)
  if (nk > 2) { GEMM_GLOAD(x, 128) }
  __syncthreads();
  for (int kt = 0; kt < nk; kt += 2) {
    GEMM_COMPUTE(0)
    if (kt + 1 < nk) { GEMM_LSTORE(y, 1) }
    if (kt + 3 < nk) { GEMM_GLOAD(y, (kt + 3) * 64) }
    __syncthreads();
    if (kt + 1 < nk) {
      GEMM_COMPUTE(1)
      if (kt + 2 < nk) { GEMM_LSTORE(x, 0) }
      if (kt + 4 < nk) { GEMM_GLOAD(x, (kt + 4) * 64) }
      __syncthreads();
    }
  }
}

__device__ __forceinline__ void gemm_tile_h(const bf16_t* __restrict__ A, long lda, const bf16_t* __restrict__ B, long ldb,
                                            int K, bf16_t* sbase, f32x16 (&acc)[2], const int tid) {
  const int lane = tid & 63, wave = tid >> 6;
  const int wm = wave >> 1, wn = wave & 1;
  const int lr = tid >> 3, lc = (tid & 7) * 8;
#pragma unroll
  for (int i = 0; i < 2; ++i)
#pragma unroll
    for (int r = 0; r < 16; ++r) acc[i][r] = 0.f;
  const bf16_t* pa = A + (long)lr * lda + lc;
  const bf16_t* pb = B + (long)lr * ldb + lc;
  uint4 xa0, xa1, xa2, xa3, xb0, xb1;
  uint4 ya0, ya1, ya2, ya3, yb0, yb1;
#define GEMMH_GLOAD(S, ko)                                 \
  S##a0 = *(const uint4*)(pa + (ko));                      \
  S##a1 = *(const uint4*)(pa + 32 * lda + (ko));           \
  S##a2 = *(const uint4*)(pa + 64 * lda + (ko));           \
  S##a3 = *(const uint4*)(pa + 96 * lda + (ko));           \
  S##b0 = *(const uint4*)(pb + (ko));                      \
  S##b1 = *(const uint4*)(pb + 32 * ldb + (ko));
#define GEMMH_LSTORE(S, buf)                                                                     \
  { bf16_t* wa = sbase + (buf) * GEMM_BUF + lr * LDSS + lc; bf16_t* wb = wa + 128 * LDSS;         \
    *(uint4*)(wa) = S##a0; *(uint4*)(wa + 32 * LDSS) = S##a1; *(uint4*)(wa + 64 * LDSS) = S##a2; *(uint4*)(wa + 96 * LDSS) = S##a3; \
    *(uint4*)(wb) = S##b0; *(uint4*)(wb + 32 * LDSS) = S##b1; }
#define GEMMH_COMPUTE(buf)                                                                        \
  { const bf16_t* ra = sbase + (buf) * GEMM_BUF + (wm * 64 + (lane & 31)) * LDSS + (lane >> 5) * 8; \
    const bf16_t* rb = sbase + (buf) * GEMM_BUF + 128 * LDSS + (wn * 32 + (lane & 31)) * LDSS + (lane >> 5) * 8; \
    _Pragma("unroll") for (int kk = 0; kk < 4; ++kk) {                                            \
      const bf16x8 af0 = *(const bf16x8*)(ra + kk * 16), af1 = *(const bf16x8*)(ra + 32 * LDSS + kk * 16); \
      const bf16x8 bf0 = *(const bf16x8*)(rb + kk * 16);                                          \
      acc[0] = __builtin_amdgcn_mfma_f32_32x32x16_bf16(af0, bf0, acc[0], 0, 0, 0);               \
      acc[1] = __builtin_amdgcn_mfma_f32_32x32x16_bf16(af1, bf0, acc[1], 0, 0, 0);               \
    } }
  const int nk = K >> 6;
  GEMMH_GLOAD(x, 0)
  if (nk > 1) { GEMMH_GLOAD(y, 64) }
  __syncthreads();
  GEMMH_LSTORE(x, 0)
  if (nk > 2) { GEMMH_GLOAD(x, 128) }
  __syncthreads();
  for (int kt = 0; kt < nk; kt += 2) {
    if (kt + 1 < nk) { GEMMH_LSTORE(y, 1) }
    if (kt + 3 < nk) { GEMMH_GLOAD(y, (kt + 3) * 64) }
    GEMMH_COMPUTE(0)
    __syncthreads();
    if (kt + 1 < nk) {
      if (kt + 2 < nk) { GEMMH_LSTORE(x, 0) }
      if (kt + 4 < nk) { GEMMH_GLOAD(x, (kt + 4) * 64) }
      GEMMH_COMPUTE(1)
      __syncthreads();
    }
  }
}

#define EPI_BEGIN_(ROWEXPR)                                                        \
  {                                                                                \
    const int e_lane = tid & 63, e_wave = tid >> 6;                                \
    const int e_wm = e_wave >> 1, e_wn = e_wave & 1;                               \
    _Pragma("unroll") for (int e_i = 0; e_i < 2; ++e_i)                            \
    _Pragma("unroll") for (int e_j = 0; e_j < 2; ++e_j)                            \
    _Pragma("unroll") for (int e_r = 0; e_r < 16; ++e_r) {                         \
      const int row = ROWEXPR;                                                     \
      const int col = e_wn * 64 + e_j * 32 + (e_lane & 31);                        \
      const float val = acc[e_i][e_j][e_r];
#define EPI_BEGIN EPI_BEGIN_(e_wm * 64 + e_i * 32 + 8 * (e_r >> 2) + 4 * (e_lane >> 5) + (e_r & 3))
#define EPI_BEGIN_OPQ EPI_BEGIN_(opq(e_wm * 64 + e_i * 32 + 8 * (e_r >> 2) + 4 * (e_lane >> 5)) + (e_r & 3))
#define EPI_END }}
#define EPIS_BEGIN                                                                 \
  {                                                                                \
    const int e_lane = tid & 63, e_wave = tid >> 6;                                \
    const int e_rowl = (e_wave >> 1) * 64 + 4 * (e_lane >> 5);                     \
    const int e_coll = (e_wave & 1) * 64 + (e_lane & 31);                          \
    _Pragma("unroll") for (int e_i = 0; e_i < 2; ++e_i)                            \
    _Pragma("unroll") for (int e_j = 0; e_j < 2; ++e_j)                            \
    _Pragma("unroll") for (int e_r = 0; e_r < 16; ++e_r) {                         \
      const int e_rowu = e_i * 32 + 8 * (e_r >> 2) + (e_r & 3);                    \
      const int e_colu = e_j * 32;                                                 \
      const float val = acc[e_i][e_j][e_r];

__device__ __forceinline__ int tok_which(int t) { return t < NCTX ? 0 : 1 + ((t - NCTX) >> 11); }

static __device__ __forceinline__ void p0_mod(const Params& p, char* smem) {
  const int tid = opaque_tid(); const int bid = opaque_bid(); (void)tid; (void)bid;
  float* sc = (float*)smem;
  float* red = sc + 3 * 1024;
  for (int it = first_item(0); it < 192; it += gridDim.x) {
    __syncthreads();
    for (int i = tid; i < 3 * 1024; i += NTHR) {
      const int w = i >> 10, d = i & 1023;
      sc[i] = siluf((w == 0) ? p.c_ctx[d] : p.c[(w - 1) * 1024 + d]);
    }
    __syncthreads();
    const int l = it / 48, e0 = (it % 48) * 64;
    const int col = tid & 63, dq = tid >> 6;
    float a0 = 0.f, a1 = 0.f, a2 = 0.f;
    const float* wp = p.mod_w + ((long)l * 1024 + dq * 256) * 3072 + e0 + col;
    for (int db = 0; db < 256; db += 16) {
      float wv[16];
#pragma unroll
      for (int d = 0; d < 16; ++d) wv[d] = wp[(long)(db + d) * 3072];
#pragma unroll
      for (int d = 0; d < 16; ++d) {
        a0 += sc[dq * 256 + db + d] * wv[d];
        a1 += sc[1024 + dq * 256 + db + d] * wv[d];
        a2 += sc[2048 + dq * 256 + db + d] * wv[d];
      }
    }
    red[(dq * 3 + 0) * 64 + col] = a0;
    red[(dq * 3 + 1) * 64 + col] = a1;
    red[(dq * 3 + 2) * 64 + col] = a2;
    __syncthreads();
    if (tid < 192) {
      const int w = tid >> 6, cc = tid & 63;
      const float sum = red[(0 * 3 + w) * 64 + cc] + red[(1 * 3 + w) * 64 + cc] + red[(2 * 3 + w) * 64 + cc] + red[(3 * 3 + w) * 64 + cc];
      p.modv[(l * 3 + w) * 3072 + e0 + cc] = sum + p.mod_b[l * 3072 + e0 + cc];
    }
  }
}

static __device__ __forceinline__ void p0_filt_mlp(const Params& p, char* smem) {
  const int tid = opaque_tid(); const int bid = opaque_bid(); (void)tid; (void)bid;
  float* z = (float*)smem;
  float* a = z + 16 * 33;
  float* b = a + 1024;
  float* wS = b + 1024;
  for (int it = first_item(192); it < 144; it += gridDim.x) {
    const int lt = (it < 128) ? 1 : 0;
    const int L = lt ? LLAT : LCTX;
    const int p0 = (lt ? it : (it - 128)) * 16;
    float* a3 = p.filt_a3 + (long)(lt ? 256 : 0) * 64;
    __syncthreads();
    for (int i = tid; i < 16 * 33; i += NTHR) {
      const int pp = i / 33, j = i % 33;
      const int l = p0 + pp;
      const float t = (float)l / (float)(L - 1);
      const float w = TWO_PI * (float)l / (float)L;
      float v;
      if (j == 0) v = t;
      else {
        const int bi = (j - 1) & 15;
        const float f = 1e-4f + (float)bi * ((15.0f - 1e-4f) / 15.0f);
        v = (j <= 16) ? cosf(f * w) : -sinf(f * w);
      }
      z[i] = v;
    }
    const int n = opq(tid & 63), pg = opq(tid >> 6);
    const float fr = p.hy_freq[n];
    for (int i = tid; i < 2112; i += NTHR) wS[i] = p.hy_w1[i];
    __syncthreads();
    {
      float acc[4];
#pragma unroll
      for (int q = 0; q < 4; ++q) acc[q] = p.hy_b1[n];
#pragma unroll 3
      for (int jn = 0; jn < 33; ++jn) {
        const float w = wS[jn * 64 + n];
#pragma unroll
        for (int q = 0; q < 4; ++q) acc[q] += z[(pg * 4 + q) * 33 + jn] * w;
      }
#pragma unroll
      for (int q = 0; q < 4; ++q) a[(pg * 4 + q) * 64 + n] = sinf(fr * acc[q]);
    }
    __syncthreads();
    for (int i = tid; i < 4096; i += NTHR) wS[i] = p.hy_w2[i];
    __syncthreads();
    {
      float acc[4];
#pragma unroll
      for (int q = 0; q < 4; ++q) acc[q] = p.hy_b2[n];
#pragma unroll 4
      for (int jn = 0; jn < 64; ++jn) {
        const float w = wS[jn * 64 + n];
#pragma unroll
        for (int q = 0; q < 4; ++q) acc[q] += a[(pg * 4 + q) * 64 + jn] * w;
      }
#pragma unroll
      for (int q = 0; q < 4; ++q) b[(pg * 4 + q) * 64 + n] = sinf(fr * acc[q]);
    }
    __syncthreads();
    for (int i = tid; i < 4096; i += NTHR) wS[i] = p.hy_w3[i];
    __syncthreads();
    {
      float acc[4];
#pragma unroll
      for (int q = 0; q < 4; ++q) acc[q] = p.hy_b3[n];
#pragma unroll 4
      for (int jn = 0; jn < 64; ++jn) {
        const float w = wS[jn * 64 + n];
#pragma unroll
        for (int q = 0; q < 4; ++q) acc[q] += b[(pg * 4 + q) * 64 + jn] * w;
      }
#pragma unroll
      for (int q = 0; q < 4; ++q) a3[(long)(p0 + pg * 4 + q) * 64 + n] = sinf(fr * acc[q]);
    }
  }
}

static __device__ __forceinline__ void phase_filt_main(const Params& p, char* smem) {
  const int tid = opaque_tid(); const int bid = opaque_bid(); (void)tid; (void)bid;
  float* a = (float*)smem;
  const float dmin = -3.0701134573253945f;
  const float dmax = -15.350567286626973f;
  for (int it = bid; it < 36 * 16; it += gridDim.x) {
    const int pc = it >> 4, cb = it & 15;
    const int lt = (pc < 32) ? 1 : 0;
    const int L = lt ? LLAT : LCTX;
    const int p0 = (lt ? pc : (pc - 32)) * 64;
    bf16_t* filt = lt ? p.filt_lat : p.filt_ctx;
    const float* a3 = p.filt_a3 + ((long)(lt ? 256 : 0) + p0) * 64;
    __syncthreads();
    for (int i = tid; i < 1024; i += NTHR) ((float4*)a)[i] = ((const float4*)a3)[i];
    const int cidx = cb * 256 + opq(tid);
    float w4[64];
#pragma unroll
    for (int k = 0; k < 64; ++k) w4[k] = p.hy_w4[k * 4096 + cidx];
    __syncthreads();
    const int ch = cidx & 1023, od = cidx >> 10, order = od >> 1, dir = od & 1;
    const float delta = fabsf(dmin + (float)ch * ((dmax - dmin) / 1023.0f));
    bf16_t* dst = filt + ((long)(order * 1024 + ch)) * (2 * L);
#pragma unroll 1
    for (int pp = 0; pp < 64; ++pp) {
      const float4* ap = (const float4*)(a + pp * 64);
      float acc = 0.f;
#pragma unroll
      for (int k4 = 0; k4 < 16; ++k4) {
        const float4 av = ap[k4];
        acc += av.x * w4[4 * k4 + 0] + av.y * w4[4 * k4 + 1] + av.z * w4[4 * k4 + 2] + av.w * w4[4 * k4 + 3];
      }
      const int l = p0 + pp;
      const float t = (float)l / (float)(L - 1);
      const float v = acc * expf(-t * delta);
      if (dir == 0) dst[L - 1 - l] = f2bf(v);
      else { if (l == 0) dst[2 * L - 1] = 0; else dst[L - 1 + l] = f2bf(v); }
    }
  }
}

static __device__ __forceinline__ void p0_tables(const Params& p, char* smem) {
  const int tid = opaque_tid(); const int bid = opaque_bid(); (void)tid; (void)bid;
  float2* T = (float2*)smem;
  __syncthreads();
  for (int m = tid; m < 2048; m += NTHR) {
    float sv, cv;
    sincosf(TWO_PI * (float)m / 2048.0f, &sv, &cv);
    T[m] = make_float2(cv, sv);
  }
  __syncthreads();
  const int n_items = 64 + 64 + 4096;
  for (int it = first_item(320); it < n_items; it += gridDim.x) {
    unsigned short vals[8];
    if (it < 64) {
#pragma unroll
      for (int q = 0; q < 8; ++q) {
        const int e = it * 2048 + tid * 8 + q;
        const int m = e >> 8, k = e & 255;
        const int cs = m >> 8, co = m & 255;
        const float2 tv = T[((co * k) & 255) * 8];
        vals[q] = f2bf(cs ? tv.y : tv.x);
      }
      *(uint4*)(p.tabA + (long)it * 2048 + tid * 8) = make_uint4(vals[0] | (vals[1] << 16), vals[2] | (vals[3] << 16), vals[4] | (vals[5] << 16), vals[6] | (vals[7] << 16));
    } else if (it < 128) {
#pragma unroll
      for (int q = 0; q < 8; ++q) {
        const int e = (it - 64) * 2048 + tid * 8 + q;
        const int pp = e >> 9, k = e & 511;
        const int cs = k >> 8, pi = k & 255;
        const float2 tv = T[((pp * pi) & 255) * 8];
        vals[q] = f2bf(cs ? -tv.y : tv.x);
      }
      *(uint4*)(p.tabB_ctx + (long)(it - 64) * 2048 + tid * 8) = make_uint4(vals[0] | (vals[1] << 16), vals[2] | (vals[3] << 16), vals[4] | (vals[5] << 16), vals[6] | (vals[7] << 16));
    } else {
#pragma unroll
      for (int q = 0; q < 8; ++q) {
        const int e = (it - 128) * 2048 + tid * 8 + q;
        const int pp = e >> 12, k = e & 4095;
        const int cs = k >> 11, pi = k & 2047;
        const float2 tv = T[(pp * pi) & 2047];
        vals[q] = f2bf(cs ? -tv.y : tv.x);
      }
      *(uint4*)(p.tabB_lat + (long)(it - 128) * 2048 + tid * 8) = make_uint4(vals[0] | (vals[1] << 16), vals[2] | (vals[3] << 16), vals[4] | (vals[5] << 16), vals[6] | (vals[7] << 16));
    }
  }
}

static __device__ __forceinline__ void wt_transpose_items(const float* __restrict__ W, bf16_t* __restrict__ Wt, int N, int Npad, int off, char* smem) {
  const int tid = opaque_tid(); const int bid = opaque_bid(); (void)tid; (void)bid;
  float* t = (float*)smem;
  const int ntn = Npad / 64;
  const int n_items = ntn * 16;
  for (int it = first_item(off); it < n_items; it += gridDim.x) {
    const int nt = it % ntn, kt = it / ntn;
    const int n0 = nt * 64, k0 = kt * 64;
    __syncthreads();
    const int tx = tid & 63, ty = tid >> 6;
    float v[16];
#pragma unroll
    for (int i = 0; i < 16; ++i) v[i] = (n0 + tx < N) ? W[(long)(k0 + ty + 4 * i) * N + n0 + tx] : 0.f;
#pragma unroll
    for (int i = 0; i < 16; ++i) t[tx * 65 + ty + 4 * i] = v[i];
    __syncthreads();
    const int r = tid >> 2, cch = (tid & 3) * 16;
    unsigned w[8];
#pragma unroll
    for (int q = 0; q < 8; ++q) w[q] = pk2(t[r * 65 + cch + 2 * q], t[r * 65 + cch + 2 * q + 1]);
    uint4* dp = (uint4*)(Wt + (long)(n0 + r) * 1024 + k0 + cch);
    dp[0] = make_uint4(w[0], w[1], w[2], w[3]);
    dp[1] = make_uint4(w[4], w[5], w[6], w[7]);
  }
}

static __device__ __forceinline__ void p0_weights(const Params& p, char* smem) {
  wt_transpose_items(p.gla_w_in, p.wt_gla_in0, 3104, 3200, 0, smem);
  wt_transpose_items(p.gla_w_out, p.wt_gla_out0, 1024, 1024, 288, smem);
  wt_transpose_items(p.fn_w_in, p.wt_fn_in, 2048, 2048, 32, smem);
  wt_transpose_items(p.fn_w_out, p.wt_fn_out, 1024, 1024, 32, smem);
  wt_transpose_items(p.hy_w_in, p.wt_hy_in, 4096, 4096, 288, smem);
  wt_transpose_items(p.hy_w_out, p.wt_hy_out, 1024, 1024, 288, smem);
  wt_transpose_items(p.gla_w_in + (long)1024 * 3104, p.wt_gla_in1, 3104, 3200, 32, smem);
  wt_transpose_items(p.gla_w_out + (long)1024 * 1024, p.wt_gla_out1, 1024, 1024, 288, smem);
}

static __device__ __forceinline__ void phase_norm(const Params& p, int layer) {
  const int tid = opaque_tid(); const int bid = opaque_bid(); (void)tid; (void)bid;
  const int lane = tid & 63, wave = tid >> 6;
  const float* g = p.norm_g + layer * 1024;
  const int stride = gridDim.x * 4;
  for (int t0 = bid * 4 + wave; t0 < NTOK; t0 += 2 * stride) {
    float4 v[2][4];
#pragma unroll
    for (int u = 0; u < 2; ++u) {
      const int t = t0 + u * stride;
      if (t < NTOK) {
        const float* xr;
        if (layer == 0) xr = (t < NCTX) ? (p.x_prompt + (long)t * 1024) : (p.x_sample + (long)(t - NCTX) * 1024);
        else xr = p.out + (long)t * 1024;
#pragma unroll
        for (int i = 0; i < 4; ++i) v[u][i] = *(const float4*)(xr + lane * 4 + 256 * i);
      }
    }
#pragma unroll
    for (int u = 0; u < 2; ++u) {
      const int t = t0 + u * stride;
      if (t < NTOK) {
        const float* mv = p.modv + (layer * 3 + tok_which(t)) * 3072;
        float ss = 0.f;
#pragma unroll
        for (int i = 0; i < 4; ++i) ss += v[u][i].x * v[u][i].x + v[u][i].y * v[u][i].y + v[u][i].z * v[u][i].z + v[u][i].w * v[u][i].w;
#pragma unroll
        for (int o = 32; o > 0; o >>= 1) ss += __shfl_xor(ss, o);
        const float rstd = rsqrtf(ss * (1.0f / 1024.0f) + 1e-6f);
#pragma unroll
        for (int i = 0; i < 4; ++i) {
          const int c0 = lane * 4 + 256 * i;
          const float4 gg = *(const float4*)(g + c0);
          const float4 sh = *(const float4*)(mv + c0);
          const float4 sc = *(const float4*)(mv + 1024 + c0);
          uint2 w;
          w.x = pk2((v[u][i].x * rstd * gg.x) * (1.f + sc.x) + sh.x, (v[u][i].y * rstd * gg.y) * (1.f + sc.y) + sh.y);
          w.y = pk2((v[u][i].z * rstd * gg.z) * (1.f + sc.z) + sh.z, (v[u][i].w * rstd * gg.w) * (1.f + sc.w) + sh.w);
          *(uint2*)(p.h + (long)t * 1024 + c0) = w;
        }
      }
    }
  }
}

static __device__ __forceinline__ void phase_final_norm(const Params& p) {
  const int tid = opaque_tid(); const int bid = opaque_bid(); (void)tid; (void)bid;
  const int lane = tid & 63, wave = tid >> 6;
  for (int t = bid * 4 + wave; t < NTOK; t += gridDim.x * 4) {
    float* xr = p.out + (long)t * 1024;
    float4 v[4];
    float ss = 0.f;
#pragma unroll
    for (int i = 0; i < 4; ++i) {
      v[i] = *(const float4*)(xr + lane * 4 + 256 * i);
      ss += v[i].x * v[i].x + v[i].y * v[i].y + v[i].z * v[i].z + v[i].w * v[i].w;
    }
#pragma unroll
    for (int o = 32; o > 0; o >>= 1) ss += __shfl_xor(ss, o);
    const float rstd = rsqrtf(ss * (1.0f / 1024.0f) + 1e-6f);
#pragma unroll
    for (int i = 0; i < 4; ++i) {
      const int c0 = lane * 4 + 256 * i;
      float4 gg = *(const float4*)(p.final_norm_g + c0);
      float4 o;
      o.x = v[i].x * rstd * gg.x; o.y = v[i].y * rstd * gg.y; o.z = v[i].z * rstd * gg.z; o.w = v[i].w * rstd * gg.w;
      *(float4*)(xr + c0) = o;
    }
  }
}

static __device__ __forceinline__ void phase_gemm_out(const Params& p, int layer, const bf16_t* Wt, char* smem, const int dummy) {
  const int tid = opaque_tid(); const int bid = opaque_bid(); (void)tid; (void)bid;
  bf16_t* sA = (bf16_t*)smem;
  float* outp = dummy ? (float*)p.big : p.out;
  const int n_tiles = 96 * 8;
  const int nfull = (gridDim.x == 512) ? 512 : n_tiles;
  const int n_items = nfull + 2 * (n_tiles - nfull);
  for (int item = bid; item < n_items; item += gridDim.x) {
    const bool is_half = item >= nfull;
    const int tile = is_half ? nfull + ((item - nfull) >> 1) : item;
    const int hsel = is_half ? ((item - nfull) & 1) : 0;
    const int mt = tile % 96, nt = tile / 96;
    const int m0 = mt * 128, n0 = nt * 128 + hsel * 64;
    const float* gate = p.modv + (layer * 3 + tok_which(m0)) * 3072 + 2048;
    const float* xsrc = (layer == 0) ? ((m0 < NCTX) ? p.x_prompt : (p.x_sample - (long)NCTX * 1024)) : p.out;
    const int e_lane = tid & 63, e_wave = tid >> 6;
    const int e_wm = e_wave >> 1, e_wn = e_wave & 1;
    if (!is_half) {
      f32x16 acc[2][2];
      gemm_tile(p.h + (long)m0 * 1024, 1024, Wt + (long)n0 * 1024, 1024, 1024, sA, acc, tid);
      float xo[2][2][16];
      const float* xb = xsrc + (long)m0 * 1024 + n0;
      float* ob = outp + (long)m0 * 1024 + n0;
      EPIS_BEGIN
        (void)val;
        const unsigned lo = 4u * (unsigned)(e_rowl * 1024 + e_coll);
        xo[e_i][e_j][e_r] = *(const float*)((const char*)(xb + e_rowu * 1024 + e_colu) + lo);
      EPI_END
      EPIS_BEGIN
        const unsigned lo = 4u * (unsigned)(e_rowl * 1024 + e_coll);
        *(float*)((char*)(ob + e_rowu * 1024 + e_colu) + lo) = xo[e_i][e_j][e_r] + gate[n0 + e_coll + e_colu] * val;
      EPI_END
    } else {
      f32x16 acc[2];
      gemm_tile_h(p.h + (long)m0 * 1024, 1024, Wt + (long)n0 * 1024, 1024, 1024, sA, acc, tid);
      const int n = n0 + e_wn * 32 + (e_lane & 31);
      const float gn = gate[n];
      float xo[2][16];
#pragma unroll
      for (int e_i = 0; e_i < 2; ++e_i)
#pragma unroll
        for (int e_r = 0; e_r < 16; ++e_r) {
          const int row = e_wm * 64 + e_i * 32 + 8 * (e_r >> 2) + 4 * (e_lane >> 5) + (e_r & 3);
          xo[e_i][e_r] = xsrc[(long)(m0 + row) * 1024 + n];
        }
#pragma unroll
      for (int e_i = 0; e_i < 2; ++e_i)
#pragma unroll
        for (int e_r = 0; e_r < 16; ++e_r) {
          const int row = e_wm * 64 + e_i * 32 + 8 * (e_r >> 2) + 4 * (e_lane >> 5) + (e_r & 3);
          outp[(long)(m0 + row) * 1024 + n] = xo[e_i][e_r] + gn * acc[e_i][e_r];
        }
    }
  }
}

#define GLA_PROJ(p) ((p).big)
#define GLA_LR(p) ((float*)((p).big + (long)NTOK * 3072))
#define GLA_OF(p) ((p).big + (long)NTOK * 3072 + (long)NTOK * 64)
#define GLA_OB(p) (GLA_OF(p) + (long)NTOK * 1024)

static __device__ __forceinline__ void phase_gla_in(const Params& p, const bf16_t* Wt, char* smem) {
  const int tid = opaque_tid(); const int bid = opaque_bid(); (void)tid; (void)bid;
  bf16_t* sA = (bf16_t*)smem;
  bf16_t* proj = GLA_PROJ(p);
  float* lrb = GLA_LR(p);
  const int n_tiles = 96 * 25;
  for (int tile = bid; tile < n_tiles; tile += gridDim.x) {
    const int mt = tile % 96, nt = tile / 96;
    const int m0 = mt * 128, n0 = nt * 128;
    f32x16 acc[2][2];
    gemm_tile(p.h + (long)m0 * 1024, 1024, Wt + (long)n0 * 1024, 1024, 1024, sA, acc, tid);
    if (n0 < 3072) {
      bf16_t* tb = proj + (long)m0 * 3072 + n0;
      EPIS_BEGIN
        const unsigned lo = 2u * (unsigned)(e_rowl * 3072 + e_coll);
        *(bf16_t*)((char*)(tb + e_rowu * 3072 + e_colu) + lo) = f2bf(val);
      EPI_END
    } else {
      EPI_BEGIN
        const int t = m0 + row, n = n0 + col;
        if (n < 3104) lrb[(long)t * 32 + (n - 3072)] = val;
      EPI_END
    }
  }
}

#define GLA_IMG1(p) (GLA_OB(p) + (long)NTOK * 1024)
#define GLA_BLAST(p) ((float*)(GLA_IMG1(p) + (long)NTOK * 1024))
static __device__ __forceinline__ void phase_gla_prep(const Params& p, int j, char* smem, const int dummy) {
  const int tid = opaque_tid(); const int bid = opaque_bid();
  float* sLR = (float*)smem;
  bf16_t* proj = GLA_PROJ(p);
  bf16_t* img1 = GLA_IMG1(p);
  const float* lrb = GLA_LR(p);
  float* blast = GLA_BLAST(p);
  const int dkl = tid & 127, dir = tid >> 7;
  for (int it = bid; it < (NTOK / 32) * 4; it += gridDim.x) {
    const int tb = it >> 2, hh = it & 3;
    const int dk = hh * 128 + dkl;
    __syncthreads();
    ((float4*)sLR)[tid] = *(const float4*)(lrb + ((long)tb * 32 + (tid >> 3)) * 32 + (tid & 7) * 4);
    unsigned rqk[32];
    {
      const bf16_t* rp = proj + ((long)tb * 32 + (dir ? 31 : 0)) * 3072 + dk;
      const long rstep = dir ? -3072 : 3072;
#pragma unroll
      for (int s_ = 0; s_ < 32; ++s_) {
        rqk[s_] = (unsigned)rp[0] | ((unsigned)rp[512] << 16);
        rp += rstep;
      }
    }
    float wd[16];
    const float* wdp = p.gla_w_dec + ((long)(j * 2 + dir) * 16) * 512 + dk;
#pragma unroll
    for (int r = 0; r < 16; ++r) wd[r] = wdp[r * 512];
    const float bd = p.gla_b_dec[(j * 2 + dir) * 512 + dk];
    __syncthreads();
    float* sC = sLR + 1024 + tid;
    float run = 0.f;
#pragma unroll
    for (int s_ = 0; s_ < 32; ++s_) {
      const int pos = dir ? 31 - s_ : s_;
      const float4* lp = (const float4*)(sLR + pos * 32 + dir * 16);
      float lg = bd;
#pragma unroll
      for (int r4 = 0; r4 < 4; ++r4) {
        const float4 l4 = lp[r4];
        lg += l4.x * wd[r4 * 4 + 0] + l4.y * wd[r4 * 4 + 1] + l4.z * wd[r4 * 4 + 2] + l4.w * wd[r4 * 4 + 3];
      }
      run += (fminf(lg, 0.f) - __logf(1.f + __expf(-fabsf(lg)))) * (1.0f / 16.0f);
      sC[s_ * 256] = run;
    }
    blast[((long)dir * (NTOK / 32) + tb) * 512 + dk] = run;
    bf16_t* dst = dir ? img1 : (dummy ? GLA_OF(p) : proj);
    const long dstr = (dir || dummy) ? 1024 : 3072;
#pragma unroll
    for (int s_ = 0; s_ < 32; ++s_) {
      const int pos = dir ? 31 - s_ : s_;
      const long tok = (long)tb * 32 + pos;
      const float e0 = sC[s_ * 256] - run;
      const float qs = 0.08838834764831845f * __expf(fminf(e0, 80.f));
      const float ks = __expf(-e0);
      const unsigned o2 = pk2(bf2f((bf16_t)(rqk[s_] & 0xffffu)) * qs, bf2f((bf16_t)(rqk[s_] >> 16)) * ks);
      dst[tok * dstr + dk] = (bf16_t)(o2 & 0xffffu);
      dst[tok * dstr + 512 + dk] = (bf16_t)(o2 >> 16);
    }
  }
}

#define QS 136
#define TS 40
#define GLA_SLOC(p) ((float*)((p).h))
#define GLA_GSEG(p) (((float*)((p).h)) + (long)128 * 128 * 256)
__device__ __forceinline__ int crow_(int r, int hf) { return (r & 3) + 8 * (r >> 2) + 4 * hf; }
__device__ __forceinline__ bf16x8 pack8(const f32x16& x, const int st) {
  union { unsigned u[4]; bf16x8 v; } c;
  c.u[0] = pk2(x[8 * st + 0], x[8 * st + 1]);
  c.u[1] = pk2(x[8 * st + 2], x[8 * st + 3]);
  c.u[2] = pk2(x[8 * st + 4], x[8 * st + 5]);
  c.u[3] = pk2(x[8 * st + 6], x[8 * st + 7]);
  return c.v;
}
__device__ __forceinline__ bf16x8 ld2x8(const bf16_t* a, const bf16_t* b) {
  union { uint2 d[2]; bf16x8 v; } c;
  c.d[0] = *(const uint2*)a;
  c.d[1] = *(const uint2*)b;
  return c.v;
}

static __device__ __forceinline__ void phase_gla_scan(const Params& p, int j, int pass, char* smem) {
  const int tid = opaque_tid(); const int bid = opaque_bid();
  bf16_t* sQ = (bf16_t*)smem;
  bf16_t* sK = sQ + 32 * QS;
  bf16_t* sKT = sK + 32 * QS;
  bf16_t* sVT = sKT + 128 * TS;
  float* sDec = (float*)(sVT + 64 * TS);
  float* sOp = sDec + 128;
  const bf16_t* proj = GLA_PROJ(p);
  const bf16_t* img1 = GLA_IMG1(p);
  const float* blast = GLA_BLAST(p);
  float* sloc = GLA_SLOC(p);
  float* gseg = GLA_GSEG(p);
  const int lane = tid & 63, wave = tid >> 6, l31 = lane & 31, hf = lane >> 5;
  const int kh = wave >> 1, nt = wave & 1;
  const int dk0 = (tid & 63) * 2, sg = tid >> 6;
  const int vp = tid & 31, sg8 = tid >> 5;
  const int irow = tid >> 3, icol = (tid & 7) * 16;
  const int n_items = pass == 0 ? (1024 + 512) : 512;
  for (int it = bid; it < n_items; it += gridDim.x) {
    int b, hh, dir, vt, sidx, L, tbase;
    bool full, lat;
    if (pass == 0 && it < 1024) {
      vt = it & 3; const int combo = it >> 2;
      dir = combo & 1; hh = (combo >> 1) & 3; b = combo >> 3; sidx = 0;
      L = LCTX; tbase = b * LCTX; full = true; lat = false;
    } else {
      const int i2 = pass == 0 ? it - 1024 : it;
      vt = i2 & 3; const int combo = i2 >> 2;
      dir = combo & 1; hh = (combo >> 1) & 3; sidx = (combo >> 3) & 7; b = combo >> 6;
      L = LLAT; tbase = NCTX + b * LLAT; full = (pass == 1); lat = true;
    }
    bf16_t* obuf = dir ? GLA_OB(p) : GLA_OF(p);
    const bf16_t* ib = dir ? img1 : proj;
    const long istr = dir ? 1024 : 3072;
    const int vcol = vt * 64 + nt * 32 + l31;
    const int sgn = dir ? -1 : 1;
    const int offq = (dir ? 31 - irow : irow) * (int)istr + icol;
    const int offk = (dir ? 31 - 8 * sg : 8 * sg) * (int)istr + dk0;
    const int offv = (dir ? 31 - 4 * sg8 : 4 * sg8) * 3072 + 2 * vp;
    const int offo = (dir ? 31 - 4 * hf : 4 * hf) * 1024 + vcol;
    f32x16 S0, S1;
    if (pass == 0) {
#pragma unroll
      for (int r = 0; r < 16; ++r) { S0[r] = 0.f; S1[r] = 0.f; }
    } else {
      const int rb = opq((kh * 64 + 4 * hf) * 256 + vcol);
      const float* s0 = p.state_gla + ((((long)b * 2 + j) * 2 + dir) * 4 + hh) * 128 * 256 + rb;
#pragma unroll
      for (int r = 0; r < 16; ++r) {
        S0[r] = s0[crow_(r, 0) * 256];
        S1[r] = s0[(32 + crow_(r, 0)) * 256];
      }
      for (int i = 0; i < sidx; ++i) {
        const int ci = (((b * 8 + i) * 4 + hh) * 2 + dir);
        const float* sl = sloc + (long)ci * 128 * 256 + rb;
        const float* gs = gseg + ci * 128 + opq(kh * 64 + 4 * hf);
#pragma unroll
        for (int r = 0; r < 16; ++r) {
          S0[r] = __expf(gs[crow_(r, 0)]) * S0[r] + sl[crow_(r, 0) * 256];
          S1[r] = __expf(gs[32 + crow_(r, 0)]) * S1[r] + sl[(32 + crow_(r, 0)) * 256];
        }
      }
    }
    float gsum = 0.f;
    struct GlaRegs { uint4 q0, q1, k0, k1; unsigned kc[8]; unsigned v[4]; float bl; };
    GlaRegs RA, RB;
    RA.q0 = make_uint4(0u, 0u, 0u, 0u); RA.q1 = RA.q0; RB.q0 = RA.q0; RB.q1 = RA.q0; RA.bl = 0.f; RB.bl = 0.f;
#define GLA_TOK(u_) ((long)tbase + (dir ? (L - 1 - (u_)) : (u_)))
    auto gla_load = [&](const int c_, GlaRegs& R) __attribute__((always_inline)) {
      const int ub = sidx * 256 + c_ * 32;
      const long TB = (long)tbase + (dir ? (L - 32 - ub) : ub);
      {
        const bf16_t* rp = ib + TB * istr + hh * 128 + offq;
        if (full) { R.q0 = *(const uint4*)rp; R.q1 = *(const uint4*)(rp + 8); }
        R.k0 = *(const uint4*)(rp + 512); R.k1 = *(const uint4*)(rp + 520);
      }
#pragma unroll
      for (int i = 0; i < 8; ++i) {
        const bf16_t* uk = ib + (TB + sgn * i) * istr + 512 + hh * 128;
        R.kc[i] = *(const unsigned*)(uk + offk);
      }
#pragma unroll
      for (int i = 0; i < 4; ++i) {
        const bf16_t* uv = proj + (TB + sgn * i) * 3072 + 1024 + hh * 256 + vt * 64;
        R.v[i] = *(const unsigned*)(uv + offv);
      }
      if (tid < 128) R.bl = blast[((long)dir * (NTOK / 32) + (TB >> 5)) * 512 + hh * 128 + tid];
    };
    auto gla_chunk = [&](const int c, GlaRegs& R) __attribute__((always_inline)) {
      if (full) {
        *(uint4*)(sQ + irow * QS + icol) = R.q0; *(uint4*)(sQ + irow * QS + icol + 8) = R.q1;
        *(uint4*)(sK + irow * QS + icol) = R.k0; *(uint4*)(sK + irow * QS + icol + 8) = R.k1;
      }
      {
        uint4 w0, w1;
        w0.x = (R.kc[0] & 0xffffu) | (R.kc[1] << 16); w1.x = (R.kc[0] >> 16) | (R.kc[1] & 0xffff0000u);
        w0.y = (R.kc[2] & 0xffffu) | (R.kc[3] << 16); w1.y = (R.kc[2] >> 16) | (R.kc[3] & 0xffff0000u);
        w0.z = (R.kc[4] & 0xffffu) | (R.kc[5] << 16); w1.z = (R.kc[4] >> 16) | (R.kc[5] & 0xffff0000u);
        w0.w = (R.kc[6] & 0xffffu) | (R.kc[7] << 16); w1.w = (R.kc[6] >> 16) | (R.kc[7] & 0xffff0000u);
        *(uint4*)(sKT + dk0 * TS + 8 * sg) = w0;
        *(uint4*)(sKT + (dk0 + 1) * TS + 8 * sg) = w1;
        uint2 pe, po;
        pe.x = (R.v[0] & 0xffffu) | (R.v[1] << 16); po.x = (R.v[0] >> 16) | (R.v[1] & 0xffff0000u);
        pe.y = (R.v[2] & 0xffffu) | (R.v[3] << 16); po.y = (R.v[2] >> 16) | (R.v[3] & 0xffff0000u);
        *(uint2*)(sVT + (2 * vp) * TS + 4 * sg8) = pe;
        *(uint2*)(sVT + (2 * vp + 1) * TS + 4 * sg8) = po;
      }
      if (tid < 128) { sDec[tid] = __expf(R.bl); gsum += R.bl; }
      __syncthreads();
      if (c + 2 < 8) gla_load(c + 2, R);
#pragma unroll
      for (int r = 0; r < 16; ++r) {
        S0[r] *= sDec[kh * 64 + crow_(r, hf)];
        S1[r] *= sDec[kh * 64 + 32 + crow_(r, hf)];
      }
      f32x16 o;
      if (full) {
        f32x16 att;
#pragma unroll
        for (int r = 0; r < 16; ++r) { att[r] = 0.f; o[r] = 0.f; }
#pragma unroll
        for (int kk = 0; kk < 8; ++kk) {
          const bf16x8 a = *(const bf16x8*)(sK + l31 * QS + kk * 16 + 8 * hf);
          const bf16x8 bq = *(const bf16x8*)(sQ + l31 * QS + kk * 16 + 8 * hf);
          att = __builtin_amdgcn_mfma_f32_32x32x16_bf16(a, bq, att, 0, 0, 0);
        }
#pragma unroll
        for (int r = 0; r < 16; ++r) if (crow_(r, hf) > l31) att[r] = 0.f;
#pragma unroll
        for (int st = 0; st < 2; ++st) {
          {
            const bf16_t* qa = sQ + l31 * QS + kh * 64 + 16 * st + 4 * hf;
            o = __builtin_amdgcn_mfma_f32_32x32x16_bf16(ld2x8(qa, qa + 8), pack8(S0, st), o, 0, 0, 0);
          }
          {
            const bf16_t* qa = sQ + l31 * QS + kh * 64 + 32 + 16 * st + 4 * hf;
            o = __builtin_amdgcn_mfma_f32_32x32x16_bf16(ld2x8(qa, qa + 8), pack8(S1, st), o, 0, 0, 0);
          }
        }
        {
          const bf16x8 pa0 = pack8(att, 0), pa1 = pack8(att, 1);
          const bf16x8 pa = kh ? pa1 : pa0;
          const bf16_t* va = sVT + (nt * 32 + l31) * TS + 16 * kh + 4 * hf;
          o = __builtin_amdgcn_mfma_f32_32x32x16_bf16(pa, ld2x8(va, va + 8), o, 0, 0, 0);
        }
        if (kh == 1) {
#pragma unroll
          for (int r = 0; r < 16; ++r) sOp[(nt * 32 + crow_(r, hf)) * 32 + l31] = o[r];
        }
      }
#pragma unroll
      for (int st = 0; st < 2; ++st) {
        const bf16x8 bv = *(const bf16x8*)(sVT + (nt * 32 + l31) * TS + st * 16 + 8 * hf);
        const bf16x8 a0 = *(const bf16x8*)(sKT + (kh * 64 + l31) * TS + st * 16 + 8 * hf);
        const bf16x8 a1 = *(const bf16x8*)(sKT + (kh * 64 + 32 + l31) * TS + st * 16 + 8 * hf);
        S0 = __builtin_amdgcn_mfma_f32_32x32x16_bf16(a0, bv, S0, 0, 0, 0);
        S1 = __builtin_amdgcn_mfma_f32_32x32x16_bf16(a1, bv, S1, 0, 0, 0);
      }
      __syncthreads();
      if (full && kh == 0) {
        const int ub = sidx * 256 + c * 32;
        const long TB = (long)tbase + (dir ? (L - 32 - ub) : ub);
#pragma unroll
        for (int r = 0; r < 16; ++r) {
          const int srow = crow_(r, hf);
          const float val = o[r] + sOp[(nt * 32 + srow) * 32 + l31];
          bf16_t* uo = obuf + (TB + sgn * (8 * (r >> 2) + (r & 3))) * 1024 + hh * 256;
          uo[offo] = f2bf(val);
        }
      }
    };
    gla_load(0, RA);
    gla_load(1, RB);
    __syncthreads();
    for (int c = 0; c < 8; c += 2) {
      gla_chunk(c, RA);
      gla_chunk(c + 1, RB);
    }
    const int rbo = opq((kh * 64 + 4 * hf) * 256 + vcol);
    if (!lat) {
      float* so = p.out + (long)NTOK * 1024 + ((((long)b * 2 + j) * 2 + dir) * 4 + hh) * 128 * 256 + rbo;
#pragma unroll
      for (int r = 0; r < 16; ++r) {
        so[crow_(r, 0) * 256] = S0[r];
        so[(32 + crow_(r, 0)) * 256] = S1[r];
      }
    } else if (pass == 0) {
      const int ci = (((b * 8 + sidx) * 4 + hh) * 2 + dir);
      float* sl = sloc + (long)ci * 128 * 256 + rbo;
#pragma unroll
      for (int r = 0; r < 16; ++r) {
        sl[crow_(r, 0) * 256] = S0[r];
        sl[(32 + crow_(r, 0)) * 256] = S1[r];
      }
      if (vt == 0 && tid < 128) gseg[ci * 128 + tid] = gsum;
    }
    __syncthreads();
  }
}

static __device__ __forceinline__ void phase_gla_combine(const Params& p, int j) {
  const int tid = opaque_tid(); const int bid = opaque_bid(); (void)tid; (void)bid;
  const int lane = tid & 63, wave = tid >> 6;
  const bf16_t* proj = GLA_PROJ(p);
  const bf16_t* of = GLA_OF(p);
  const bf16_t* ob = GLA_OB(p);
  const float* og = p.gla_onorm_g + j * 256;
  const float4 gg = *(const float4*)(og + lane * 4);
  const int stride = gridDim.x * 4;
  for (int it0 = bid * 4 + wave; it0 < NTOK * 4; it0 += 4 * stride) {
    uint2 a[4], b[4], r[4];
#pragma unroll
    for (int u = 0; u < 4; ++u) {
      const int it = it0 + u * stride;
      if (it < NTOK * 4) {
        const int t = it >> 2, hh = it & 3;
        const long base = (long)t * 1024 + hh * 256 + lane * 4;
        a[u] = *(const uint2*)(of + base);
        b[u] = *(const uint2*)(ob + base);
        r[u] = *(const uint2*)(proj + (long)t * 3072 + 2048 + hh * 256 + lane * 4);
      }
    }
#pragma unroll
    for (int u = 0; u < 4; ++u) {
      const int it = it0 + u * stride;
      if (it < NTOK * 4) {
        const int t = it >> 2, hh = it & 3;
        const long base = (long)t * 1024 + hh * 256 + lane * 4;
        float o[4];
        o[0] = bf2f(a[u].x & 0xffff) + bf2f(b[u].x & 0xffff);
        o[1] = bf2f(a[u].x >> 16) + bf2f(b[u].x >> 16);
        o[2] = bf2f(a[u].y & 0xffff) + bf2f(b[u].y & 0xffff);
        o[3] = bf2f(a[u].y >> 16) + bf2f(b[u].y >> 16);
        const float r0 = bf2f(r[u].x & 0xffff), r1 = bf2f(r[u].x >> 16), r2 = bf2f(r[u].y & 0xffff), r3 = bf2f(r[u].y >> 16);
        float ss = o[0] * o[0] + o[1] * o[1] + o[2] * o[2] + o[3] * o[3];
#pragma unroll
        for (int sft = 32; sft > 0; sft >>= 1) ss += __shfl_xor(ss, sft);
        const float rstd = rsqrtf(ss * (1.0f / 256.0f) + 1e-6f);
        uint2 w;
        w.x = pk2(o[0] * rstd * gg.x * siluf(r0), o[1] * rstd * gg.y * siluf(r1));
        w.y = pk2(o[2] * rstd * gg.z * siluf(r2), o[3] * rstd * gg.w * siluf(r3));
        *(uint2*)(p.h + base) = w;
      }
    }
  }
}

#define FN_PROJ(p) ((p).big)
#define FN_XCS_CTX(p) ((p).big + (long)NTOK * 2048)
#define FN_XCS_LAT(p) (FN_XCS_CTX(p) + (long)NCTX * 2048)

static __device__ __forceinline__ void phase_fn_in(const Params& p, char* smem) {
  const int tid = opaque_tid(); const int bid = opaque_bid(); (void)tid; (void)bid;
  bf16_t* sA = (bf16_t*)smem;
  bf16_t* proj = FN_PROJ(p);
  const int n_tiles = 96 * 16;
  for (int tile = bid; tile < n_tiles; tile += gridDim.x) {
    const int mt = tile % 96, nt = tile / 96;
    const int m0 = mt * 128, n0 = nt * 128;
    f32x16 acc[2][2];
    gemm_tile(p.h + (long)m0 * 1024, 1024, p.wt_fn_in + (long)n0 * 1024, 1024, 1024, sA, acc, tid);
    {
      bf16_t* tb = proj + (long)m0 * 2048 + n0;
      EPIS_BEGIN
        const unsigned lo = 2u * (unsigned)(e_rowl * 2048 + e_coll);
        *(bf16_t*)((char*)(tb + e_rowu * 2048 + e_colu) + lo) = f2bf(val);
      EPI_END
    }
  }
}

static __device__ __forceinline__ void phase_fn_a(const Params& p, char* smem) {
  const int tid = opaque_tid(); const int bid = opaque_bid(); (void)tid; (void)bid;
  bf16_t* sA = (bf16_t*)smem;
  const bf16_t* proj = FN_PROJ(p);
  const int n_tiles = 4 * 96 * 4;
  for (int tile = bid; tile < n_tiles; tile += gridDim.x) {
    const int mt = tile & 3, g = (tile >> 2) & 3, tt = tile >> 4;
    const int m0 = mt * 128, t0 = tt * 128;
    f32x16 acc[2][2];
    gemm_tile(p.tabA + (long)m0 * 256, 256, proj + (long)t0 * 2048 + g * 256, 2048, 256, sA, acc, tid);
    const bool lat = t0 >= NCTX;
    const int L = lat ? LLAT : LCTX;
    const int b = lat ? ((t0 - NCTX) >> 11) : (t0 >> 8);
    const int pos0 = lat ? ((t0 - NCTX) & 2047) : (t0 & 255);
    bf16_t* dst = lat ? FN_XCS_LAT(p) : FN_XCS_CTX(p);
    {
      const int cs = m0 >> 8, co0 = m0 & 255;
      const int ld2 = 2 * L;
      bf16_t* tb = dst + ((long)((b * 4 + g) * 256 + co0)) * ld2 + cs * L + pos0;
      EPIS_BEGIN
        const unsigned lo = 2u * (unsigned)(e_rowl * ld2 + e_coll);
        *(bf16_t*)((char*)(tb + e_rowu * ld2 + e_colu) + lo) = f2bf(val);
      EPI_END
    }
  }
}

static __device__ __forceinline__ void phase_fn_b(const Params& p, char* smem) {
  const int tid = opaque_tid(); const int bid = opaque_bid(); (void)tid; (void)bid;
  bf16_t* sA = (bf16_t*)smem;
  const bf16_t* proj = FN_PROJ(p);
  const int n_lat = 2 * 4 * 16 * 2;
  const int n_ctx = 32 * 4 * 2 * 2;
  const bool rebal = (gridDim.x == 512);
  for (int it_ = bid; it_ < (rebal ? 1024 : n_lat + n_ctx); it_ += gridDim.x) {
    int tile = it_;
    if (rebal) {
      if (it_ < 512) tile = (it_ < 256) ? it_ : (256 + 2 * (it_ - 256));
      else tile = (it_ - 512 < 256) ? -1 : (256 + 2 * (it_ - 768) + 1);
      if (tile < 0) continue;
    }
    int b, g, mt, nt, L, tbase;
    const bf16_t *tab, *xcs;
    if (tile < n_lat) {
      nt = tile & 1; mt = (tile >> 1) & 15; g = (tile >> 5) & 3; b = tile >> 7;
      L = LLAT; tbase = NCTX + b * LLAT; tab = p.tabB_lat; xcs = FN_XCS_LAT(p);
    } else {
      int t2 = tile - n_lat;
      nt = t2 & 1; mt = (t2 >> 1) & 1; g = (t2 >> 2) & 3; b = t2 >> 4;
      L = LCTX; tbase = b * LCTX; tab = p.tabB_ctx; xcs = FN_XCS_CTX(p);
    }
    const int m0 = mt * 128, n0 = nt * 128;
    f32x16 acc[2][2];
    gemm_tile(tab + (long)m0 * (2 * L), 2 * L, xcs + ((long)((b * 4 + g) * 256 + n0)) * (2 * L), 2 * L, 2 * L, sA, acc, tid);
    const float scale = rsqrtf((float)L * 256.0f);
    {
      const int e_lane = tid & 63, e_wave = tid >> 6;
      const int e_wm = e_wave >> 1, e_wn = e_wave & 1;
#pragma unroll
      for (int e_i = 0; e_i < 2; ++e_i)
#pragma unroll
        for (int e_j = 0; e_j < 2; ++e_j) {
          const int rowb = opq(e_wm * 64 + e_i * 32 + 4 * (e_lane >> 5));
          const int ch = g * 256 + n0 + e_wn * 64 + e_j * 32 + (e_lane & 31);
          bf16_t zr[16];
#pragma unroll
          for (int e_r = 0; e_r < 16; ++e_r) zr[e_r] = proj[(long)(tbase + m0 + rowb + 8 * (e_r >> 2) + (e_r & 3)) * 2048 + 1024 + ch];
#pragma unroll
          for (int e_r = 0; e_r < 16; ++e_r)
            p.h[(long)(tbase + m0 + rowb + 8 * (e_r >> 2) + (e_r & 3)) * 1024 + ch] = f2bf(acc[e_i][e_j][e_r] * scale * siluf(bf2f(zr[e_r])));
        }
    }
  }
}

#define HY_UT(p) ((p).big)
#define HY_YT(p) ((p).big + (long)4096 * NTOK)

static __device__ __forceinline__ void phase_hy_in(const Params& p, char* smem) {
  const int tid = opaque_tid(); const int bid = opaque_bid(); (void)tid; (void)bid;
  bf16_t* sA = (bf16_t*)smem;
  bf16_t* uT = HY_UT(p);
  const int n_tiles = 32 * 96;
  for (int tile = bid; tile < n_tiles; tile += gridDim.x) {
    const int nt = tile % 96, mt = tile / 96;
    const int m0 = mt * 128, n0 = nt * 128;
    f32x16 acc[2][2];
    gemm_tile(p.wt_hy_in + (long)m0 * 1024, 1024, p.h + (long)n0 * 1024, 1024, 1024, sA, acc, tid);
    {
      bf16_t* tb = uT + (long)m0 * NTOK + n0;
      EPIS_BEGIN
        const unsigned lo = 2u * (unsigned)(e_rowl * NTOK + e_coll);
        *(bf16_t*)((char*)(tb + e_rowu * NTOK + e_colu) + lo) = f2bf(val);
      EPI_END
    }
  }
}

__device__ __forceinline__ int upad(int pos) { return pos + 8 * (pos >> 5); }
static __device__ __forceinline__ void phase_hy_conv(const Params& p, char* smem) {
  const int tid = opaque_tid(); const int bid = opaque_bid();
  bf16_t* sU = (bf16_t*)smem;
  bf16_t* sX1 = sU + 10240;
  bf16_t* sX2 = sX1 + 8192;
  bf16_t* sR0 = sX2 + 8192;
  bf16_t* sR1 = sR0 + 4128;
  const bf16_t* uT = HY_UT(p);
  bf16_t* yT = HY_YT(p);
  const int lane = tid & 63, wave = tid >> 6, l31 = lane & 31, hf = lane >> 5;
  const int n_items = 1024 + 1024;
  for (int it = bid; it < n_items; it += gridDim.x) {
    const bool lat = it < 1024;
    const int ch = lat ? it : (it - 1024);
    const int L = lat ? LLAT : LCTX;
    const int nb = L >> 5;
    const int tok0 = lat ? NCTX : 0;
    const int ntw = lat ? 1 : 2;
    const bf16_t* filt = (lat ? p.filt_lat : p.filt_ctx);
    __syncthreads();
    for (int pc = 0; pc < ntw; ++pc) {
      const int p0 = pc * 4096 + tid * 16;
      const bool has_l = (p0 & (L - 1)) != 0, has_r = ((p0 + 16) & (L - 1)) != 0;
#pragma unroll
      for (int g = 0; g < 3; ++g) {
        const int f = g * 1024 + ch;
        const bf16_t* row = uT + (long)f * NTOK + tok0 + p0;
        const uint4 v0 = *(const uint4*)row, v1 = *(const uint4*)(row + 8);
        float e[18];
        e[0] = has_l ? bf2f(row[-1]) : 0.f;
        e[17] = has_r ? bf2f(row[16]) : 0.f;
        const unsigned vv[8] = {v0.x, v0.y, v0.z, v0.w, v1.x, v1.y, v1.z, v1.w};
#pragma unroll
        for (int q = 0; q < 8; ++q) { e[1 + 2 * q] = bf2f((bf16_t)(vv[q] & 0xffffu)); e[2 + 2 * q] = bf2f((bf16_t)(vv[q] >> 16)); }
        const float w0 = p.hy_conv_w[f], w1 = p.hy_conv_w[3072 + f], w2 = p.hy_conv_w[6144 + f], bb = p.hy_conv_b[f];
        unsigned o[8];
#pragma unroll
        for (int q = 0; q < 8; ++q) {
          const float a0 = e[2 * q] * w0 + e[2 * q + 1] * w1 + e[2 * q + 2] * w2 + bb;
          const float a1 = e[2 * q + 1] * w0 + e[2 * q + 2] * w1 + e[2 * q + 3] * w2 + bb;
          o[q] = pk2(a0, a1);
        }
        bf16_t* dst = (g == 0) ? (sX1 + p0) : (g == 1) ? (sX2 + p0) : (sU + upad(p0));
        uint4 o0, o1;
        o0.x = o[0]; o0.y = o[1]; o0.z = o[2]; o0.w = o[3];
        o1.x = o[4]; o1.y = o[5]; o1.z = o[6]; o1.w = o[7];
        *(uint4*)dst = o0;
        *(uint4*)(dst + 8) = o1;
      }
    }
    const int xa = (L - 1) - l31 + 8 * hf;
    const bf16_t* Rp = (xa & 1) ? (sR1 - 1) : sR0;
    float y1r[2][16];
    for (int order = 0; order < 2; ++order) {
      const bf16_t* fsrc = filt + ((long)(order * 1024 + ch)) * (2 * L);
      for (int x8 = tid; x8 < (2 * L) / 8; x8 += NTHR) {
        const uint4 v = *(const uint4*)(fsrc + 8 * x8);
        *(uint4*)(sR0 + 8 * x8) = v;
        const unsigned vv[4] = {v.x, v.y, v.z, v.w};
#pragma unroll
        for (int q = 0; q < 4; ++q) {
          if (8 * x8 + 2 * q >= 1) sR1[8 * x8 + 2 * q - 1] = (bf16_t)(vv[q] & 0xffffu);
          sR1[8 * x8 + 2 * q] = (bf16_t)(vv[q] >> 16);
        }
      }
      __syncthreads();
      const float dsk = p.hy_d[order * 1024 + ch];
      const bf16_t* gate = order ? sX2 : sX1;
#pragma unroll
      for (int tt = 0; tt < 2; ++tt) {
        if (tt < ntw) {
          int bt, i_blk, dlo, dhi;
          if (lat) { bt = wave >> 1; const int i0 = 32 * (wave & 1); i_blk = i0 + l31; dlo = i0 - 63; dhi = i0 + 31; }
          else { bt = 4 * (2 * wave + tt) + (l31 >> 3); i_blk = l31 & 7; dlo = -7; dhi = 7; }
          const bf16_t* ubase = sU + upad(bt * L);
          const int pos_base = bt * L + 32 * i_blk + 4 * hf;
          f32x16 acc;
#pragma unroll
          for (int r = 0; r < 16; ++r) acc[r] = 0.f;
          for (int d = dlo; d <= dhi; ++d) {
            const int jb = i_blk - d;
            const bool valid = (unsigned)jb < (unsigned)nb;
            const int jc = valid ? jb : 0;
            const bf16_t* bp = ubase + 40 * jc + 8 * hf;
            const unsigned* ap = (const unsigned*)(Rp + (xa - 32 * d));
#pragma unroll
            for (int ks2 = 0; ks2 < 2; ++ks2) {
              union { unsigned u[4]; bf16x8 v; } A;
              A.u[0] = ap[8 * ks2 + 0]; A.u[1] = ap[8 * ks2 + 1]; A.u[2] = ap[8 * ks2 + 2]; A.u[3] = ap[8 * ks2 + 3];
              union { uint4 q; bf16x8 v; } B;
              B.q = *(const uint4*)(bp + 16 * ks2);
              if (!valid) { B.q.x = 0u; B.q.y = 0u; B.q.z = 0u; B.q.w = 0u; }
              acc = __builtin_amdgcn_mfma_f32_32x32x16_bf16(A.v, B.v, acc, 0, 0, 0);
            }
          }
#pragma unroll
          for (int g = 0; g < 4; ++g) {
            const int pos = pos_base + 8 * g;
            const uint2 gg = *(const uint2*)(gate + pos);
            const uint2 uo = *(const uint2*)(sU + upad(pos));
            const float g0 = bf2f((bf16_t)(gg.x & 0xffffu)), g1 = bf2f((bf16_t)(gg.x >> 16)), g2 = bf2f((bf16_t)(gg.y & 0xffffu)), g3 = bf2f((bf16_t)(gg.y >> 16));
            const float u0 = bf2f((bf16_t)(uo.x & 0xffffu)), u1 = bf2f((bf16_t)(uo.x >> 16)), u2 = bf2f((bf16_t)(uo.y & 0xffffu)), u3 = bf2f((bf16_t)(uo.y >> 16));
            y1r[tt][4 * g + 0] = g0 * (acc[4 * g + 0] + dsk * u0);
            y1r[tt][4 * g + 1] = g1 * (acc[4 * g + 1] + dsk * u1);
            y1r[tt][4 * g + 2] = g2 * (acc[4 * g + 2] + dsk * u2);
            y1r[tt][4 * g + 3] = g3 * (acc[4 * g + 3] + dsk * u3);
          }
        }
      }
      __syncthreads();
#pragma unroll
      for (int tt = 0; tt < 2; ++tt) {
        if (tt < ntw) {
          int bt, i_blk;
          if (lat) { bt = wave >> 1; i_blk = 32 * (wave & 1) + l31; }
          else { bt = 4 * (2 * wave + tt) + (l31 >> 3); i_blk = l31 & 7; }
          const int pos_base = bt * L + 32 * i_blk + 4 * hf;
          if (order == 0) {
#pragma unroll
            for (int g = 0; g < 4; ++g) {
              uint2 w;
              w.x = pk2(y1r[tt][4 * g + 0], y1r[tt][4 * g + 1]);
              w.y = pk2(y1r[tt][4 * g + 2], y1r[tt][4 * g + 3]);
              *(uint2*)(sU + upad(pos_base + 8 * g)) = w;
            }
          } else {
            uint2 zz[4];
#pragma unroll
            for (int g = 0; g < 4; ++g) zz[g] = *(const uint2*)(uT + (long)(3072 + ch) * NTOK + tok0 + pos_base + 8 * g);
#pragma unroll
            for (int g = 0; g < 4; ++g) {
              const long gp = (long)tok0 + pos_base + 8 * g;
              const float z0 = bf2f((bf16_t)(zz[g].x & 0xffffu)), z1 = bf2f((bf16_t)(zz[g].x >> 16)), z2 = bf2f((bf16_t)(zz[g].y & 0xffffu)), z3 = bf2f((bf16_t)(zz[g].y >> 16));
              uint2 w;
              w.x = pk2(y1r[tt][4 * g + 0] * siluf(z0), y1r[tt][4 * g + 1] * siluf(z1));
              w.y = pk2(y1r[tt][4 * g + 2] * siluf(z2), y1r[tt][4 * g + 3] * siluf(z3));
              *(uint2*)(yT + (long)ch * NTOK + gp) = w;
            }
          }
        }
      }
    }
  }
}

static __device__ __forceinline__ void phase_hy_transpose(const Params& p, char* smem) {
  const int tid = opaque_tid(); const int bid = opaque_bid(); (void)tid; (void)bid;
  bf16_t* t = (bf16_t*)smem;
  const bf16_t* yT = HY_YT(p);
  const int n_items = 16 * 192;
  for (int it = bid; it < n_items; it += gridDim.x) {
    const int ct = it & 15, tt = it >> 4;
    const int c0 = ct * 64, t0 = tt * 64;
    __syncthreads();
    for (int i = tid; i < 64 * 64; i += NTHR) {
      int r = i >> 6, cc = i & 63;
      t[cc * 66 + r] = yT[(long)(c0 + r) * NTOK + t0 + cc];
    }
    __syncthreads();
    for (int i = tid; i < 64 * 64; i += NTHR) {
      int r = i >> 6, cc = i & 63;
      p.h[(long)(t0 + r) * 1024 + c0 + cc] = t[r * 66 + cc];
    }
  }
}

#define XB_TMO      128
#define XB_XCNT(j)  (256  + 64 * (j))
#define XB_XSUB(j)  (1280 + 64 * (j))
#define XB_XGEN(j)  (2304 + 64 * (j))
#define XB_TOP      3328
#define XB_TOPGEN   3392
#define XCD_BAR_WORDS 3456
#define XB_SPIN_CAP (1u << 18)
#define LAS __attribute__((address_space(3)))
__device__ __forceinline__ unsigned xb_ld(unsigned* p)              { return __hip_atomic_load(p, __ATOMIC_RELAXED, __HIP_MEMORY_SCOPE_AGENT); }
__device__ __forceinline__ unsigned xb_add(unsigned* p, unsigned v) { return __hip_atomic_fetch_add(p, v, __ATOMIC_RELAXED, __HIP_MEMORY_SCOPE_AGENT); }
__device__ __forceinline__ unsigned xb_xcc_id() { return (unsigned)__builtin_amdgcn_s_getreg((3 << 11) | 20) & 0xFu; }
#define XB_SPIN(cond, bar) do { unsigned _sp = 0; while (cond) { __builtin_amdgcn_s_sleep(1); \
    if ((++_sp & 255u) == 0u) { if (xb_ld(&(bar)[XB_TMO])) break; if (_sp > XB_SPIN_CAP) { atomicAdd(&(bar)[XB_TMO], 1u); break; } } } } while (0)
struct XcdBarrier { unsigned* bar; unsigned x; volatile LAS unsigned* st; };
__device__ __forceinline__ XcdBarrier xcd_barrier_post(unsigned* bar, volatile LAS unsigned* st) {
    XcdBarrier b; b.bar = bar; b.x = xb_xcc_id(); b.st = st;
    if (threadIdx.x == 0) (void)xb_add(&bar[XB_XCNT(b.x)], 1u);
    return b;
}
__device__ __forceinline__ void xcd_barrier_complete(unsigned* bar, unsigned x, unsigned& nloc, unsigned& nx) {
    const unsigned G = gridDim.x * gridDim.y * gridDim.z;
    unsigned sum, cnt, mine, sp = 0u;
    for (;;) {
        sum = 0u; cnt = 0u; mine = 0u;
#pragma unroll
        for (unsigned j = 0; j < 16; ++j) { const unsigned c = xb_ld(&bar[XB_XCNT(j)]); sum += c; cnt += (c > 0u) ? 1u : 0u; mine = (j == x) ? c : mine; }
        if (sum == G) break;
        __builtin_amdgcn_s_sleep(1);
        if ((++sp & 255u) == 0u) { if (xb_ld(&bar[XB_TMO])) break; if (sp > XB_SPIN_CAP) { atomicAdd(&bar[XB_TMO], 1u); break; } }
    }
    nloc = mine > 0u ? mine : 1u; nx = cnt > 0u ? cnt : 1u;
}
__device__ __forceinline__ void xcd_barrier(const XcdBarrier& b) {
    asm volatile("s_waitcnt vmcnt(0)" ::: "memory");
    __syncthreads();
    if (threadIdx.x == 0) {
        unsigned* bar = b.bar;
        __builtin_amdgcn_s_waitcnt(0);
        unsigned nloc = b.st[0], nx = b.st[1];
        if (nloc == 0u) { xcd_barrier_complete(bar, b.x, nloc, nx); b.st[0] = nloc; b.st[1] = nx; }
        const unsigned old = xb_add(&bar[XB_XSUB(b.x)], 1u);
        const unsigned gen = old / nloc;
        if (old + 1u == (gen + 1u) * nloc) {
            __builtin_amdgcn_fence(__ATOMIC_RELEASE, "agent");
            asm volatile("s_waitcnt vmcnt(0)" ::: "memory");
            const unsigned og = xb_add(&bar[XB_TOP], 1u);
            const unsigned tg = og / nx;
            if (og + 1u == (tg + 1u) * nx) xb_add(&bar[XB_TOPGEN], 1u);
            else XB_SPIN(xb_ld(&bar[XB_TOPGEN]) == tg, bar);
            __builtin_amdgcn_fence(__ATOMIC_ACQUIRE, "agent");
            xb_add(&bar[XB_XGEN(b.x)], 1u);
            asm volatile("s_waitcnt vmcnt(0)" ::: "memory");
        } else {
            XB_SPIN(xb_ld(&bar[XB_XGEN(b.x)]) == gen, bar);
            __builtin_amdgcn_fence(__ATOMIC_ACQUIRE, "agent");
            asm volatile("s_waitcnt vmcnt(0)" ::: "memory");
        }
    }
    __syncthreads();
}

__global__ void __launch_bounds__(NTHR, 2) mega(Params p) {
  cg::grid_group grid = cg::this_grid();
  __shared__ __attribute__((aligned(16))) char smem[SMEM_BYTES];
  __shared__ uint4 xb_words;
  if (threadIdx.x == 0) xb_words = make_uint4(0u, 0u, 0u, 0u);
  __syncthreads();
  const XcdBarrier xb = xcd_barrier_post(p.bar, (volatile LAS unsigned*)&xb_words);
  if (p.use_cg) grid.sync();
#define GSYNC() xcd_barrier(xb)
#define REP(id) for (int rep##id = 0; rep##id < (PROBE == (id) ? 3 : 1); ++rep##id)
  REP(19) {
  REP(1) { p0_mod(p, smem); }
  REP(2) { p0_filt_mlp(p, smem); }
  REP(3) { p0_tables(p, smem); }
  REP(4) { p0_weights(p, smem); }
  GSYNC();
  }
  if (PROBE == 5) { for (int rep = 0; rep < 40; ++rep) GSYNC(); }
  for (int layer = 0; layer < 4; ++layer) {
    const int kind = layer % 3, j = layer / 3;
    REP(6) { phase_norm(p, layer); if (layer == 1) phase_filt_main(p, smem); GSYNC(); }
    const bf16_t* wt_out;
    if (kind == 0) {
      REP(7) { phase_gla_in(p, j ? p.wt_gla_in1 : p.wt_gla_in0, smem); GSYNC(); }
      for (int rep = 0; rep < (PROBE == 17 ? 3 : 1); ++rep) { phase_gla_prep(p, j, smem, rep + 1 < (PROBE == 17 ? 3 : 1)); GSYNC(); }
      REP(8) { phase_gla_scan(p, j, 0, smem); GSYNC(); }
      REP(9) { phase_gla_scan(p, j, 1, smem); GSYNC(); }
      REP(10) { phase_gla_combine(p, j); GSYNC(); }
      wt_out = j ? p.wt_gla_out1 : p.wt_gla_out0;
    } else if (kind == 1) {
      REP(11) { phase_fn_in(p, smem); GSYNC(); }
      REP(12) { phase_fn_a(p, smem); GSYNC(); }
      REP(13) { phase_fn_b(p, smem); GSYNC(); }
      wt_out = p.wt_fn_out;
    } else {
      REP(14) { phase_hy_in(p, smem); GSYNC(); }
      REP(15) { phase_hy_conv(p, smem); GSYNC(); }
      REP(16) { phase_hy_transpose(p, smem); GSYNC(); }
      wt_out = p.wt_hy_out;
    }
    for (int rep = 0; rep < (PROBE == 18 ? 3 : 1); ++rep) { phase_gemm_out(p, layer, wt_out, smem, rep + 1 < (PROBE == 18 ? 3 : 1)); GSYNC(); }
  }
  phase_final_norm(p);
}

static inline size_t align_up(size_t x) { return (x + 255) & ~(size_t)255; }

extern "C" void kernel_launch(void* const* d_in, const int* in_sizes, int n_in, void* d_out,
                              int out_size, void* d_ws, size_t ws_size, hipStream_t stream) {
  static int grid_blocks = 0;
  if (!grid_blocks) {
    int dev = 0, cus = 0, per_cu = 0;
    hipGetDevice(&dev);
    hipDeviceGetAttribute(&cus, hipDeviceAttributeMultiprocessorCount, dev);
    hipOccupancyMaxActiveBlocksPerMultiprocessor(&per_cu, mega, NTHR, 0);
    if (per_cu > 2) per_cu = 2;
    if (per_cu < 1) per_cu = 1;
    grid_blocks = cus * per_cu;
  }
  Params p{};
  const float* const* in = (const float* const*)d_in;
  p.x_prompt = in[0]; p.x_sample = in[1]; p.state_gla = in[2]; p.c = in[3]; p.c_ctx = in[4];
  p.mod_w = in[5]; p.mod_b = in[6]; p.norm_g = in[7]; p.final_norm_g = in[8];
  p.gla_w_in = in[9]; p.gla_w_dec = in[10]; p.gla_b_dec = in[11]; p.gla_onorm_g = in[12]; p.gla_w_out = in[13];
  p.fn_w_in = in[14]; p.fn_w_out = in[15];
  p.hy_w_in = in[16]; p.hy_conv_w = in[17]; p.hy_conv_b = in[18];
  p.hy_w1 = in[19]; p.hy_b1 = in[20]; p.hy_w2 = in[21]; p.hy_b2 = in[22]; p.hy_w3 = in[23]; p.hy_b3 = in[24];
  p.hy_w4 = in[25]; p.hy_freq = in[26]; p.hy_d = in[27]; p.hy_w_out = in[28];
  p.out = (float*)d_out;
  char* w = (char*)d_ws;
  size_t off = 0;
  auto take = [&](size_t bytes) { char* r = w + off; off = align_up(off + bytes); return r; };
  p.h = (bf16_t*)take((size_t)NTOK * 1024 * 2);
  p.big = (bf16_t*)take((size_t)156 * 1024 * 1024);
  p.wt_gla_in0 = (bf16_t*)take((size_t)3200 * 1024 * 2);
  p.wt_gla_in1 = (bf16_t*)take((size_t)3200 * 1024 * 2);
  p.wt_gla_out0 = (bf16_t*)take((size_t)1024 * 1024 * 2);
  p.wt_gla_out1 = (bf16_t*)take((size_t)1024 * 1024 * 2);
  p.wt_fn_in = (bf16_t*)take((size_t)2048 * 1024 * 2);
  p.wt_fn_out = (bf16_t*)take((size_t)1024 * 1024 * 2);
  p.wt_hy_in = (bf16_t*)take((size_t)4096 * 1024 * 2);
  p.wt_hy_out = (bf16_t*)take((size_t)1024 * 1024 * 2);
  p.tabA = (bf16_t*)take((size_t)512 * 256 * 2);
  p.tabB_ctx = (bf16_t*)take((size_t)256 * 512 * 2);
  p.tabB_lat = (bf16_t*)take((size_t)2048 * 4096 * 2);
  p.filt_ctx = (bf16_t*)take((size_t)2 * 1024 * 512 * 2);
  p.filt_lat = (bf16_t*)take((size_t)2 * 1024 * 4096 * 2);
  p.filt_a3 = (float*)take((size_t)2304 * 64 * 4);
  p.bar = (unsigned*)take((size_t)XCD_BAR_WORDS * 4 + (size_t)4 * 3 * 3072 * 4);
  p.modv = (float*)(p.bar + XCD_BAR_WORDS);
  p.use_cg = 0; p.pad = 0;
  hipMemsetAsync(p.bar, 0, (size_t)XCD_BAR_WORDS * 4 + (size_t)4 * 3 * 3072 * 4, stream);
  void* args[] = {&p};
  hipError_t e = hipLaunchCooperativeKernel((void*)mega, dim3(grid_blocks), dim3(NTHR), args, 0, stream);
  if (e != hipSuccess) fprintf(stderr, "cooperative launch failed: %s (grid %d, ws %zu need %zu)\n", hipGetErrorString(e), grid_blocks, ws_size, off);
}
```

```cpp
#include <hip/hip_runtime.h>
#include <hip/hip_cooperative_groups.h>
#include <cstdio>
namespace cg = cooperative_groups;

typedef unsigned short bf16_t;
typedef short bf16x8 __attribute__((ext_vector_type(8)));
typedef float f32x16 __attribute__((ext_vector_type(16)));

#ifndef PROBE
#define PROBE 0
#endif
#define NTOK 12288
#define NCTX 8192
#define DM 1024
#define LCTX 256
#define LLAT 2048
#define NTHR 256
#define SMEM_BYTES 73728
#define LDSS 72
#define TWO_PI 6.283185307179586f

struct Params {
  const float *x_prompt, *x_sample, *state_gla, *c, *c_ctx, *mod_w, *mod_b, *norm_g, *final_norm_g;
  const float *gla_w_in, *gla_w_dec, *gla_b_dec, *gla_onorm_g, *gla_w_out;
  const float *fn_w_in, *fn_w_out;
  const float *hy_w_in, *hy_conv_w, *hy_conv_b, *hy_w1, *hy_b1, *hy_w2, *hy_b2, *hy_w3, *hy_b3, *hy_w4, *hy_freq, *hy_d, *hy_w_out;
  float* out;
  bf16_t* h;
  bf16_t* big;
  float* modv;
  bf16_t* wt_gla_in0; bf16_t* wt_gla_in1; bf16_t* wt_gla_out0; bf16_t* wt_gla_out1;
  bf16_t* wt_fn_in; bf16_t* wt_fn_out; bf16_t* wt_hy_in; bf16_t* wt_hy_out;
  bf16_t* tabA; bf16_t* tabB_ctx; bf16_t* tabB_lat;
  bf16_t* filt_ctx; bf16_t* filt_lat;
  float* filt_a3;
  unsigned* bar;
  int use_cg; int pad;
};

typedef __bf16 bf16n2 __attribute__((ext_vector_type(2)));
typedef float f32n2 __attribute__((ext_vector_type(2)));
__device__ __forceinline__ unsigned pk2(float a, float b) {
  f32n2 v = {a, b};
  return __builtin_bit_cast(unsigned, __builtin_convertvector(v, bf16n2));
}
__device__ __forceinline__ bf16_t f2bf(float x) { return (bf16_t)(pk2(x, 0.f) & 0xffffu); }
__device__ __forceinline__ float bf2f(bf16_t b) { return __uint_as_float(((unsigned)b) << 16); }
__device__ __forceinline__ float siluf(float x) { return x / (1.f + expf(-x)); }
__device__ __forceinline__ float logsigf(float x) { return fminf(x, 0.f) - log1pf(expf(-fabsf(x))); }
__device__ __forceinline__ int opaque_tid() { int t = threadIdx.x; asm volatile("" : "+v"(t)); return t; }
__device__ __forceinline__ int opq(int t) { asm volatile("" : "+v"(t)); return t; }
__device__ __forceinline__ int opaque_bid() { int b = blockIdx.x; asm volatile("" : "+s"(b)); return b; }
__device__ __forceinline__ int first_item_(int bid, int off) {
  int G = gridDim.x;
  return (int)((bid + G - (off % G)) % G);
}
#define first_item(off) first_item_(bid, off)

#define GEMM_BUF (2 * 128 * LDSS)
#define GEMM_STAGE_DECL uint4 g_xa0, g_xa1, g_xa2, g_xa3, g_xb0, g_xb1, g_xb2, g_xb3, g_ya0, g_ya1, g_ya2, g_ya3, g_yb0, g_yb1, g_yb2, g_yb3;
#define GEMM_STAGE_ARGS g_xa0, g_xa1, g_xa2, g_xa3, g_xb0, g_xb1, g_xb2, g_xb3, g_ya0, g_ya1, g_ya2, g_ya3, g_yb0, g_yb1, g_yb2, g_yb3
__device__ __forceinline__ void gemm_tile(const bf16_t* __restrict__ A, long lda, const bf16_t* __restrict__ B, long ldb,
                                          int K, bf16_t* sbase, f32x16 (&acc)[2][2], const int tid,
                                          uint4& xa0, uint4& xa1, uint4& xa2, uint4& xa3, uint4& xb0, uint4& xb1, uint4& xb2, uint4& xb3, uint4& ya0, uint4& ya1, uint4& ya2, uint4& ya3, uint4& yb0, uint4& yb1, uint4& yb2, uint4& yb3,
                                          const bool preloaded, const bf16_t* An, const bf16_t* Bn) {
  const int lane = tid & 63, wave = tid >> 6;
  const int wm = wave >> 1, wn = wave & 1;
  const int lr = tid >> 3, lc = (tid & 7) * 8;
#pragma unroll
  for (int i = 0; i < 2; ++i)
#pragma unroll
    for (int j = 0; j < 2; ++j)
#pragma unroll
      for (int r = 0; r < 16; ++r) acc[i][j][r] = 0.f;
  const bf16_t* pa = A + (long)lr * lda + lc;
  const bf16_t* pb = B + (long)lr * ldb + lc;
  const bf16_t* pan = An + (long)lr * lda + lc;
  const bf16_t* pbn = Bn + (long)lr * ldb + lc;
#define GEMM_GLOAD_(S, PA, PB, ko)                            \
  S##a0 = *(const uint4*)(PA + (ko));                      \
  S##a1 = *(const uint4*)(PA + 32 * lda + (ko));           \
  S##a2 = *(const uint4*)(PA + 64 * lda + (ko));           \
  S##a3 = *(const uint4*)(PA + 96 * lda + (ko));           \
  S##b0 = *(const uint4*)(PB + (ko));                      \
  S##b1 = *(const uint4*)(PB + 32 * ldb + (ko));           \
  S##b2 = *(const uint4*)(PB + 64 * ldb + (ko));           \
  S##b3 = *(const uint4*)(PB + 96 * ldb + (ko));
#define GEMM_GLOAD(S, ko) GEMM_GLOAD_(S, pa, pb, ko)
#define GEMM_GLOADN(S, ko) GEMM_GLOAD_(S, pan, pbn, ko)
#define GEMM_LSTORE(S, buf)                                                                      \
  { bf16_t* wa = sbase + (buf) * GEMM_BUF + lr * LDSS + lc; bf16_t* wb = wa + 128 * LDSS;         \
    *(uint4*)(wa) = S##a0; *(uint4*)(wa + 32 * LDSS) = S##a1; *(uint4*)(wa + 64 * LDSS) = S##a2; *(uint4*)(wa + 96 * LDSS) = S##a3; \
    *(uint4*)(wb) = S##b0; *(uint4*)(wb + 32 * LDSS) = S##b1; *(uint4*)(wb + 64 * LDSS) = S##b2; *(uint4*)(wb + 96 * LDSS) = S##b3; }
#define GEMM_COMPUTE(buf)                                                                         \
  { __builtin_amdgcn_s_setprio(1); const bf16_t* ra = sbase + (buf) * GEMM_BUF + (wm * 64 + (lane & 31)) * LDSS + (lane >> 5) * 8; \
    const bf16_t* rb = sbase + (buf) * GEMM_BUF + 128 * LDSS + (wn * 64 + (lane & 31)) * LDSS + (lane >> 5) * 8; \
    _Pragma("unroll") for (int kk = 0; kk < 4; ++kk) {                                            \
      const bf16x8 af0 = *(const bf16x8*)(ra + kk * 16), af1 = *(const bf16x8*)(ra + 32 * LDSS + kk * 16); \
      const bf16x8 bf0 = *(const bf16x8*)(rb + kk * 16), bf1 = *(const bf16x8*)(rb + 32 * LDSS + kk * 16); \
      acc[0][0] = __builtin_amdgcn_mfma_f32_32x32x16_bf16(af0, bf0, acc[0][0], 0, 0, 0);         \
      acc[0][1] = __builtin_amdgcn_mfma_f32_32x32x16_bf16(af0, bf1, acc[0][1], 0, 0, 0);         \
      acc[1][0] = __builtin_amdgcn_mfma_f32_32x32x16_bf16(af1, bf0, acc[1][0], 0, 0, 0);         \
      acc[1][1] = __builtin_amdgcn_mfma_f32_32x32x16_bf16(af1, bf1, acc[1][1], 0, 0, 0);         \
    } __builtin_amdgcn_s_setprio(0); }
  const int nk = K >> 6;
  const bool hasn = (An != nullptr);
  if (!preloaded) {
    GEMM_GLOAD(x, 0)
    if (nk > 1) { GEMM_GLOAD(y, 64) }
  }
  __syncthreads();
  GEMM_LSTORE(x, 0)
  if (nk > 2) { GEMM_GLOAD(x, 128) }
  __syncthreads();
  for (int kt = 0; kt < nk; kt += 2) {
    GEMM_COMPUTE(0)
    if (kt + 1 < nk) { GEMM_LSTORE(y, 1) }
    if (kt + 3 < nk) { GEMM_GLOAD(y, (kt + 3) * 64) }
    else if (hasn && kt + 3 == nk + 1) { GEMM_GLOADN(y, 64) }
    __syncthreads();
    if (kt + 1 < nk) {
      GEMM_COMPUTE(1)
      if (kt + 2 < nk) { GEMM_LSTORE(x, 0) }
      if (kt + 4 < nk) { GEMM_GLOAD(x, (kt + 4) * 64) }
      else if (hasn && kt + 4 == nk) { GEMM_GLOADN(x, 0) }
      __syncthreads();
    }
  }
}

__device__ __forceinline__ void gemm_tile_h(const bf16_t* __restrict__ A, long lda, const bf16_t* __restrict__ B, long ldb,
                                            int K, bf16_t* sbase, f32x16 (&acc)[2], const int tid) {
  const int lane = tid & 63, wave = tid >> 6;
  const int wm = wave >> 1, wn = wave & 1;
  const int lr = tid >> 3, lc = (tid & 7) * 8;
#pragma unroll
  for (int i = 0; i < 2; ++i)
#pragma unroll
    for (int r = 0; r < 16; ++r) acc[i][r] = 0.f;
  const bf16_t* pa = A + (long)lr * lda + lc;
  const bf16_t* pb = B + (long)lr * ldb + lc;
  uint4 xa0, xa1, xa2, xa3, xb0, xb1;
  uint4 ya0, ya1, ya2, ya3, yb0, yb1;
#define GEMMH_GLOAD(S, ko)                                 \
  S##a0 = *(const uint4*)(pa + (ko));                      \
  S##a1 = *(const uint4*)(pa + 32 * lda + (ko));           \
  S##a2 = *(const uint4*)(pa + 64 * lda + (ko));           \
  S##a3 = *(const uint4*)(pa + 96 * lda + (ko));           \
  S##b0 = *(const uint4*)(pb + (ko));                      \
  S##b1 = *(const uint4*)(pb + 32 * ldb + (ko));
#define GEMMH_LSTORE(S, buf)                                                                     \
  { bf16_t* wa = sbase + (buf) * GEMM_BUF + lr * LDSS + lc; bf16_t* wb = wa + 128 * LDSS;         \
    *(uint4*)(wa) = S##a0; *(uint4*)(wa + 32 * LDSS) = S##a1; *(uint4*)(wa + 64 * LDSS) = S##a2; *(uint4*)(wa + 96 * LDSS) = S##a3; \
    *(uint4*)(wb) = S##b0; *(uint4*)(wb + 32 * LDSS) = S##b1; }
#define GEMMH_COMPUTE(buf)                                                                        \
  { const bf16_t* ra = sbase + (buf) * GEMM_BUF + (wm * 64 + (lane & 31)) * LDSS + (lane >> 5) * 8; \
    const bf16_t* rb = sbase + (buf) * GEMM_BUF + 128 * LDSS + (wn * 32 + (lane & 31)) * LDSS + (lane >> 5) * 8; \
    _Pragma("unroll") for (int kk = 0; kk < 4; ++kk) {                                            \
      const bf16x8 af0 = *(const bf16x8*)(ra + kk * 16), af1 = *(const bf16x8*)(ra + 32 * LDSS + kk * 16); \
      const bf16x8 bf0 = *(const bf16x8*)(rb + kk * 16);                                          \
      acc[0] = __builtin_amdgcn_mfma_f32_32x32x16_bf16(af0, bf0, acc[0], 0, 0, 0);               \
      acc[1] = __builtin_amdgcn_mfma_f32_32x32x16_bf16(af1, bf0, acc[1], 0, 0, 0);               \
    } }
  const int nk = K >> 6;
  GEMMH_GLOAD(x, 0)
  if (nk > 1) { GEMMH_GLOAD(y, 64) }
  __syncthreads();
  GEMMH_LSTORE(x, 0)
  if (nk > 2) { GEMMH_GLOAD(x, 128) }
  __syncthreads();
  for (int kt = 0; kt < nk; kt += 2) {
    if (kt + 1 < nk) { GEMMH_LSTORE(y, 1) }
    if (kt + 3 < nk) { GEMMH_GLOAD(y, (kt + 3) * 64) }
    GEMMH_COMPUTE(0)
    __syncthreads();
    if (kt + 1 < nk) {
      if (kt + 2 < nk) { GEMMH_LSTORE(x, 0) }
      if (kt + 4 < nk) { GEMMH_GLOAD(x, (kt + 4) * 64) }
      GEMMH_COMPUTE(1)
      __syncthreads();
    }
  }
}

#define EPI_BEGIN_(ROWEXPR)                                                        \
  {                                                                                \
    const int e_lane = tid & 63, e_wave = tid >> 6;                                \
    const int e_wm = e_wave >> 1, e_wn = e_wave & 1;                               \
    _Pragma("unroll") for (int e_i = 0; e_i < 2; ++e_i)                            \
    _Pragma("unroll") for (int e_j = 0; e_j < 2; ++e_j)                            \
    _Pragma("unroll") for (int e_r = 0; e_r < 16; ++e_r) {                         \
      const int row = ROWEXPR;                                                     \
      const int col = e_wn * 64 + e_j * 32 + (e_lane & 31);                        \
      const float val = acc[e_i][e_j][e_r];
#define EPI_BEGIN EPI_BEGIN_(e_wm * 64 + e_i * 32 + 8 * (e_r >> 2) + 4 * (e_lane >> 5) + (e_r & 3))
#define EPI_BEGIN_OPQ EPI_BEGIN_(opq(e_wm * 64 + e_i * 32 + 8 * (e_r >> 2) + 4 * (e_lane >> 5)) + (e_r & 3))
#define EPI_END }}
#define EPIS_BEGIN                                                                 \
  {                                                                                \
    const int e_lane = tid & 63, e_wave = tid >> 6;                                \
    const int e_rowl = (e_wave >> 1) * 64 + 4 * (e_lane >> 5);                     \
    const int e_coll = (e_wave & 1) * 64 + (e_lane & 31);                          \
    _Pragma("unroll") for (int e_i = 0; e_i < 2; ++e_i)                            \
    _Pragma("unroll") for (int e_j = 0; e_j < 2; ++e_j)                            \
    _Pragma("unroll") for (int e_r = 0; e_r < 16; ++e_r) {                         \
      const int e_rowu = e_i * 32 + 8 * (e_r >> 2) + (e_r & 3);                    \
      const int e_colu = e_j * 32;                                                 \
      const float val = acc[e_i][e_j][e_r];

__device__ __forceinline__ int tok_which(int t) { return t < NCTX ? 0 : 1 + ((t - NCTX) >> 11); }

static __device__ __forceinline__ void p0_mod(const Params& p, char* smem) {
  const int tid = opaque_tid(); const int bid = opaque_bid(); (void)tid; (void)bid;
  float* sc = (float*)smem;
  float* red = sc + 3 * 1024;
  for (int it = first_item(0); it < 192; it += gridDim.x) {
    __syncthreads();
    for (int i = tid; i < 3 * 1024; i += NTHR) {
      const int w = i >> 10, d = i & 1023;
      sc[i] = siluf((w == 0) ? p.c_ctx[d] : p.c[(w - 1) * 1024 + d]);
    }
    __syncthreads();
    const int l = it / 48, e0 = (it % 48) * 64;
    const int col = tid & 63, dq = tid >> 6;
    float a0 = 0.f, a1 = 0.f, a2 = 0.f;
    const float* wp = p.mod_w + ((long)l * 1024 + dq * 256) * 3072 + e0 + col;
    for (int db = 0; db < 256; db += 16) {
      float wv[16];
#pragma unroll
      for (int d = 0; d < 16; ++d) wv[d] = wp[(long)(db + d) * 3072];
#pragma unroll
      for (int d = 0; d < 16; ++d) {
        a0 += sc[dq * 256 + db + d] * wv[d];
        a1 += sc[1024 + dq * 256 + db + d] * wv[d];
        a2 += sc[2048 + dq * 256 + db + d] * wv[d];
      }
    }
    red[(dq * 3 + 0) * 64 + col] = a0;
    red[(dq * 3 + 1) * 64 + col] = a1;
    red[(dq * 3 + 2) * 64 + col] = a2;
    __syncthreads();
    if (tid < 192) {
      const int w = tid >> 6, cc = tid & 63;
      const float sum = red[(0 * 3 + w) * 64 + cc] + red[(1 * 3 + w) * 64 + cc] + red[(2 * 3 + w) * 64 + cc] + red[(3 * 3 + w) * 64 + cc];
      p.modv[(l * 3 + w) * 3072 + e0 + cc] = sum + p.mod_b[l * 3072 + e0 + cc];
    }
  }
}

static __device__ __forceinline__ void p0_filt_mlp(const Params& p, char* smem) {
  const int tid = opaque_tid(); const int bid = opaque_bid(); (void)tid; (void)bid;
  float* z = (float*)smem;
  float* a = z + 16 * 33;
  float* b = a + 1024;
  float* wS = b + 1024;
  for (int it = first_item(192); it < 144; it += gridDim.x) {
    const int lt = (it < 128) ? 1 : 0;
    const int L = lt ? LLAT : LCTX;
    const int p0 = (lt ? it : (it - 128)) * 16;
    float* a3 = p.filt_a3 + (long)(lt ? 256 : 0) * 64;
    __syncthreads();
    for (int i = tid; i < 16 * 33; i += NTHR) {
      const int pp = i / 33, j = i % 33;
      const int l = p0 + pp;
      const float t = (float)l / (float)(L - 1);
      const float w = TWO_PI * (float)l / (float)L;
      float v;
      if (j == 0) v = t;
      else {
        const int bi = (j - 1) & 15;
        const float f = 1e-4f + (float)bi * ((15.0f - 1e-4f) / 15.0f);
        v = (j <= 16) ? cosf(f * w) : -sinf(f * w);
      }
      z[i] = v;
    }
    const int n = opq(tid & 63), pg = opq(tid >> 6);
    const float fr = p.hy_freq[n];
    for (int i = tid; i < 2112; i += NTHR) wS[i] = p.hy_w1[i];
    __syncthreads();
    {
      float acc[4];
#pragma unroll
      for (int q = 0; q < 4; ++q) acc[q] = p.hy_b1[n];
#pragma unroll 3
      for (int jn = 0; jn < 33; ++jn) {
        const float w = wS[jn * 64 + n];
#pragma unroll
        for (int q = 0; q < 4; ++q) acc[q] += z[(pg * 4 + q) * 33 + jn] * w;
      }
#pragma unroll
      for (int q = 0; q < 4; ++q) a[(pg * 4 + q) * 64 + n] = sinf(fr * acc[q]);
    }
    __syncthreads();
    for (int i = tid; i < 4096; i += NTHR) wS[i] = p.hy_w2[i];
    __syncthreads();
    {
      float acc[4];
#pragma unroll
      for (int q = 0; q < 4; ++q) acc[q] = p.hy_b2[n];
#pragma unroll 4
      for (int jn = 0; jn < 64; ++jn) {
        const float w = wS[jn * 64 + n];
#pragma unroll
        for (int q = 0; q < 4; ++q) acc[q] += a[(pg * 4 + q) * 64 + jn] * w;
      }
#pragma unroll
      for (int q = 0; q < 4; ++q) b[(pg * 4 + q) * 64 + n] = sinf(fr * acc[q]);
    }
    __syncthreads();
    for (int i = tid; i < 4096; i += NTHR) wS[i] = p.hy_w3[i];
    __syncthreads();
    {
      float acc[4];
#pragma unroll
      for (int q = 0; q < 4; ++q) acc[q] = p.hy_b3[n];
#pragma unroll 4
      for (int jn = 0; jn < 64; ++jn) {
        const float w = wS[jn * 64 + n];
#pragma unroll
        for (int q = 0; q < 4; ++q) acc[q] += b[(pg * 4 + q) * 64 + jn] * w;
      }
#pragma unroll
      for (int q = 0; q < 4; ++q) a3[(long)(p0 + pg * 4 + q) * 64 + n] = sinf(fr * acc[q]);
    }
  }
}

static __device__ __forceinline__ void phase_filt_main(const Params& p, char* smem) {
  const int tid = opaque_tid(); const int bid = opaque_bid(); (void)tid; (void)bid;
  float* a = (float*)smem;
  const float dmin = -3.0701134573253945f;
  const float dmax = -15.350567286626973f;
  for (int it = bid; it < 36 * 16; it += gridDim.x) {
    const int pc = it >> 4, cb = it & 15;
    const int lt = (pc < 32) ? 1 : 0;
    const int L = lt ? LLAT : LCTX;
    const int p0 = (lt ? pc : (pc - 32)) * 64;
    bf16_t* filt = lt ? p.filt_lat : p.filt_ctx;
    const float* a3 = p.filt_a3 + ((long)(lt ? 256 : 0) + p0) * 64;
    __syncthreads();
    for (int i = tid; i < 1024; i += NTHR) ((float4*)a)[i] = ((const float4*)a3)[i];
    const int cidx = cb * 256 + opq(tid);
    float w4[64];
#pragma unroll
    for (int k = 0; k < 64; ++k) w4[k] = p.hy_w4[k * 4096 + cidx];
    __syncthreads();
    const int ch = cidx & 1023, od = cidx >> 10, order = od >> 1, dir = od & 1;
    const float delta = fabsf(dmin + (float)ch * ((dmax - dmin) / 1023.0f));
    bf16_t* dst = filt + ((long)(order * 1024 + ch)) * (2 * L);
#pragma unroll 1
    for (int pp = 0; pp < 64; ++pp) {
      const float4* ap = (const float4*)(a + pp * 64);
      float acc = 0.f;
#pragma unroll
      for (int k4 = 0; k4 < 16; ++k4) {
        const float4 av = ap[k4];
        acc += av.x * w4[4 * k4 + 0] + av.y * w4[4 * k4 + 1] + av.z * w4[4 * k4 + 2] + av.w * w4[4 * k4 + 3];
      }
      const int l = p0 + pp;
      const float t = (float)l / (float)(L - 1);
      const float v = acc * expf(-t * delta);
      if (dir == 0) dst[L - 1 - l] = f2bf(v);
      else { if (l == 0) dst[2 * L - 1] = 0; else dst[L - 1 + l] = f2bf(v); }
    }
  }
}

static __device__ __forceinline__ void p0_tables(const Params& p, char* smem) {
  const int tid = opaque_tid(); const int bid = opaque_bid(); (void)tid; (void)bid;
  float2* T = (float2*)smem;
  __syncthreads();
  for (int m = tid; m < 2048; m += NTHR) {
    float sv, cv;
    sincosf(TWO_PI * (float)m / 2048.0f, &sv, &cv);
    T[m] = make_float2(cv, sv);
  }
  __syncthreads();
  const int n_items = 64 + 64 + 4096;
  for (int it = first_item(320); it < n_items; it += gridDim.x) {
    unsigned short vals[8];
    if (it < 64) {
#pragma unroll
      for (int q = 0; q < 8; ++q) {
        const int e = it * 2048 + tid * 8 + q;
        const int m = e >> 8, k = e & 255;
        const int cs = m >> 8, co = m & 255;
        const float2 tv = T[((co * k) & 255) * 8];
        vals[q] = f2bf(cs ? tv.y : tv.x);
      }
      *(uint4*)(p.tabA + (long)it * 2048 + tid * 8) = make_uint4(vals[0] | (vals[1] << 16), vals[2] | (vals[3] << 16), vals[4] | (vals[5] << 16), vals[6] | (vals[7] << 16));
    } else if (it < 128) {
#pragma unroll
      for (int q = 0; q < 8; ++q) {
        const int e = (it - 64) * 2048 + tid * 8 + q;
        const int pp = e >> 9, k = e & 511;
        const int cs = k >> 8, pi = k & 255;
        const float2 tv = T[((pp * pi) & 255) * 8];
        vals[q] = f2bf(cs ? -tv.y : tv.x);
      }
      *(uint4*)(p.tabB_ctx + (long)(it - 64) * 2048 + tid * 8) = make_uint4(vals[0] | (vals[1] << 16), vals[2] | (vals[3] << 16), vals[4] | (vals[5] << 16), vals[6] | (vals[7] << 16));
    } else {
#pragma unroll
      for (int q = 0; q < 8; ++q) {
        const int e = (it - 128) * 2048 + tid * 8 + q;
        const int pp = e >> 12, k = e & 4095;
        const int cs = k >> 11, pi = k & 2047;
        const float2 tv = T[(pp * pi) & 2047];
        vals[q] = f2bf(cs ? -tv.y : tv.x);
      }
      *(uint4*)(p.tabB_lat + (long)(it - 128) * 2048 + tid * 8) = make_uint4(vals[0] | (vals[1] << 16), vals[2] | (vals[3] << 16), vals[4] | (vals[5] << 16), vals[6] | (vals[7] << 16));
    }
  }
}

static __device__ __forceinline__ void wt_transpose_items(const float* __restrict__ W, bf16_t* __restrict__ Wt, int N, int Npad, int off, char* smem) {
  const int tid = opaque_tid(); const int bid = opaque_bid(); (void)tid; (void)bid;
  float* t = (float*)smem;
  const int ntn = Npad / 64;
  const int n_items = ntn * 16;
  for (int it = first_item(off); it < n_items; it += gridDim.x) {
    const int nt = it % ntn, kt = it / ntn;
    const int n0 = nt * 64, k0 = kt * 64;
    __syncthreads();
    const int tx = tid & 63, ty = tid >> 6;
    float v[16];
#pragma unroll
    for (int i = 0; i < 16; ++i) v[i] = (n0 + tx < N) ? W[(long)(k0 + ty + 4 * i) * N + n0 + tx] : 0.f;
#pragma unroll
    for (int i = 0; i < 16; ++i) t[tx * 65 + ty + 4 * i] = v[i];
    __syncthreads();
    const int r = tid >> 2, cch = (tid & 3) * 16;
    unsigned w[8];
#pragma unroll
    for (int q = 0; q < 8; ++q) w[q] = pk2(t[r * 65 + cch + 2 * q], t[r * 65 + cch + 2 * q + 1]);
    uint4* dp = (uint4*)(Wt + (long)(n0 + r) * 1024 + k0 + cch);
    dp[0] = make_uint4(w[0], w[1], w[2], w[3]);
    dp[1] = make_uint4(w[4], w[5], w[6], w[7]);
  }
}

static __device__ __forceinline__ void p0_weights(const Params& p, char* smem) {
  wt_transpose_items(p.gla_w_in, p.wt_gla_in0, 3104, 3200, 0, smem);
  wt_transpose_items(p.gla_w_out, p.wt_gla_out0, 1024, 1024, 288, smem);
  wt_transpose_items(p.fn_w_in, p.wt_fn_in, 2048, 2048, 32, smem);
  wt_transpose_items(p.fn_w_out, p.wt_fn_out, 1024, 1024, 32, smem);
  wt_transpose_items(p.hy_w_in, p.wt_hy_in, 4096, 4096, 288, smem);
  wt_transpose_items(p.hy_w_out, p.wt_hy_out, 1024, 1024, 288, smem);
  wt_transpose_items(p.gla_w_in + (long)1024 * 3104, p.wt_gla_in1, 3104, 3200, 32, smem);
  wt_transpose_items(p.gla_w_out + (long)1024 * 1024, p.wt_gla_out1, 1024, 1024, 288, smem);
}

static __device__ __forceinline__ void phase_norm(const Params& p, int layer) {
  const int tid = opaque_tid(); const int bid = opaque_bid(); (void)tid; (void)bid;
  const int lane = tid & 63, wave = tid >> 6;
  const float* g = p.norm_g + layer * 1024;
  const int stride = gridDim.x * 4;
  for (int t0 = bid * 4 + wave; t0 < NTOK; t0 += 2 * stride) {
    float4 v[2][4];
#pragma unroll
    for (int u = 0; u < 2; ++u) {
      const int t = t0 + u * stride;
      if (t < NTOK) {
        const float* xr;
        if (layer == 0) xr = (t < NCTX) ? (p.x_prompt + (long)t * 1024) : (p.x_sample + (long)(t - NCTX) * 1024);
        else xr = p.out + (long)t * 1024;
#pragma unroll
        for (int i = 0; i < 4; ++i) v[u][i] = *(const float4*)(xr + lane * 4 + 256 * i);
      }
    }
#pragma unroll
    for (int u = 0; u < 2; ++u) {
      const int t = t0 + u * stride;
      if (t < NTOK) {
        const float* mv = p.modv + (layer * 3 + tok_which(t)) * 3072;
        float ss = 0.f;
#pragma unroll
        for (int i = 0; i < 4; ++i) ss += v[u][i].x * v[u][i].x + v[u][i].y * v[u][i].y + v[u][i].z * v[u][i].z + v[u][i].w * v[u][i].w;
#pragma unroll
        for (int o = 32; o > 0; o >>= 1) ss += __shfl_xor(ss, o);
        const float rstd = rsqrtf(ss * (1.0f / 1024.0f) + 1e-6f);
#pragma unroll
        for (int i = 0; i < 4; ++i) {
          const int c0 = lane * 4 + 256 * i;
          const float4 gg = *(const float4*)(g + c0);
          const float4 sh = *(const float4*)(mv + c0);
          const float4 sc = *(const float4*)(mv + 1024 + c0);
          uint2 w;
          w.x = pk2((v[u][i].x * rstd * gg.x) * (1.f + sc.x) + sh.x, (v[u][i].y * rstd * gg.y) * (1.f + sc.y) + sh.y);
          w.y = pk2((v[u][i].z * rstd * gg.z) * (1.f + sc.z) + sh.z, (v[u][i].w * rstd * gg.w) * (1.f + sc.w) + sh.w);
          *(uint2*)(p.h + (long)t * 1024 + c0) = w;
        }
      }
    }
  }
}

static __device__ __forceinline__ void phase_final_norm(const Params& p) {
  const int tid = opaque_tid(); const int bid = opaque_bid(); (void)tid; (void)bid;
  const int lane = tid & 63, wave = tid >> 6;
  for (int t = bid * 4 + wave; t < NTOK; t += gridDim.x * 4) {
    float* xr = p.out + (long)t * 1024;
    float4 v[4];
    float ss = 0.f;
#pragma unroll
    for (int i = 0; i < 4; ++i) {
      v[i] = *(const float4*)(xr + lane * 4 + 256 * i);
      ss += v[i].x * v[i].x + v[i].y * v[i].y + v[i].z * v[i].z + v[i].w * v[i].w;
    }
#pragma unroll
    for (int o = 32; o > 0; o >>= 1) ss += __shfl_xor(ss, o);
    const float rstd = rsqrtf(ss * (1.0f / 1024.0f) + 1e-6f);
#pragma unroll
    for (int i = 0; i < 4; ++i) {
      const int c0 = lane * 4 + 256 * i;
      float4 gg = *(const float4*)(p.final_norm_g + c0);
      float4 o;
      o.x = v[i].x * rstd * gg.x; o.y = v[i].y * rstd * gg.y; o.z = v[i].z * rstd * gg.z; o.w = v[i].w * rstd * gg.w;
      *(float4*)(xr + c0) = o;
    }
  }
}

static __device__ __forceinline__ void phase_gemm_out(const Params& p, int layer, const bf16_t* Wt, char* smem, const int dummy) {
  const int tid = opaque_tid(); const int bid = opaque_bid(); (void)tid; (void)bid;
  bf16_t* sA = (bf16_t*)smem;
  GEMM_STAGE_DECL
  float* outp = dummy ? (float*)p.big : p.out;
  const int n_tiles = 96 * 8;
  const int nfull = (gridDim.x == 512) ? 512 : n_tiles;
  const int n_items = nfull + 2 * (n_tiles - nfull);
  for (int item = bid; item < n_items; item += gridDim.x) {
    const bool is_half = item >= nfull;
    const int tile = is_half ? nfull + ((item - nfull) >> 1) : item;
    const int hsel = is_half ? ((item - nfull) & 1) : 0;
    const int mt = tile % 96, nt = tile / 96;
    const int m0 = mt * 128, n0 = nt * 128 + hsel * 64;
    const float* gate = p.modv + (layer * 3 + tok_which(m0)) * 3072 + 2048;
    const float* xsrc = (layer == 0) ? ((m0 < NCTX) ? p.x_prompt : (p.x_sample - (long)NCTX * 1024)) : p.out;
    const int e_lane = tid & 63, e_wave = tid >> 6;
    const int e_wm = e_wave >> 1, e_wn = e_wave & 1;
    if (!is_half) {
      f32x16 acc[2][2];
      gemm_tile(p.h + (long)m0 * 1024, 1024, Wt + (long)n0 * 1024, 1024, 1024, sA, acc, tid, GEMM_STAGE_ARGS, false, nullptr, nullptr);
      float xo[2][2][16];
      const float* xb = xsrc + (long)m0 * 1024 + n0;
      float* ob = outp + (long)m0 * 1024 + n0;
      EPIS_BEGIN
        (void)val;
        const unsigned lo = 4u * (unsigned)(e_rowl * 1024 + e_coll);
        xo[e_i][e_j][e_r] = *(const float*)((const char*)(xb + e_rowu * 1024 + e_colu) + lo);
      EPI_END
      EPIS_BEGIN
        const unsigned lo = 4u * (unsigned)(e_rowl * 1024 + e_coll);
        *(float*)((char*)(ob + e_rowu * 1024 + e_colu) + lo) = xo[e_i][e_j][e_r] + gate[n0 + e_coll + e_colu] * val;
      EPI_END
    } else {
      f32x16 acc[2];
      gemm_tile_h(p.h + (long)m0 * 1024, 1024, Wt + (long)n0 * 1024, 1024, 1024, sA, acc, tid);
      const int n = n0 + e_wn * 32 + (e_lane & 31);
      const float gn = gate[n];
      float xo[2][16];
#pragma unroll
      for (int e_i = 0; e_i < 2; ++e_i)
#pragma unroll
        for (int e_r = 0; e_r < 16; ++e_r) {
          const int row = e_wm * 64 + e_i * 32 + 8 * (e_r >> 2) + 4 * (e_lane >> 5) + (e_r & 3);
          xo[e_i][e_r] = xsrc[(long)(m0 + row) * 1024 + n];
        }
#pragma unroll
      for (int e_i = 0; e_i < 2; ++e_i)
#pragma unroll
        for (int e_r = 0; e_r < 16; ++e_r) {
          const int row = e_wm * 64 + e_i * 32 + 8 * (e_r >> 2) + 4 * (e_lane >> 5) + (e_r & 3);
          outp[(long)(m0 + row) * 1024 + n] = xo[e_i][e_r] + gn * acc[e_i][e_r];
        }
    }
  }
}

#define GLA_PROJ(p) ((p).big)
#define GLA_LR(p) ((float*)((p).big + (long)NTOK * 3072))
#define GLA_OF(p) ((p).big + (long)NTOK * 3072 + (long)NTOK * 64)
#define GLA_OB(p) (GLA_OF(p) + (long)NTOK * 1024)

static __device__ __forceinline__ void phase_gla_in(const Params& p, const bf16_t* Wt, char* smem) {
  const int tid = opaque_tid(); const int bid = opaque_bid(); (void)tid; (void)bid;
  bf16_t* sA = (bf16_t*)smem;
  GEMM_STAGE_DECL
  bool pre = false;
  bf16_t* proj = GLA_PROJ(p);
  float* lrb = GLA_LR(p);
  const int n_tiles = 96 * 25;
  for (int tile = bid; tile < n_tiles; tile += gridDim.x) {
    const int mt = tile % 96, nt = tile / 96;
    const int m0 = mt * 128, n0 = nt * 128;
    f32x16 acc[2][2];
    {
      const int tn = tile + gridDim.x;
      const bool hn = tn < n_tiles;
      gemm_tile(p.h + (long)m0 * 1024, 1024, Wt + (long)n0 * 1024, 1024, 1024, sA, acc, tid, GEMM_STAGE_ARGS, pre,
                hn ? p.h + (long)((tn % 96) * 128) * 1024 : nullptr, hn ? Wt + (long)((tn / 96) * 128) * 1024 : nullptr);
      pre = hn;
    }
    if (n0 < 3072) {
      bf16_t* tb = proj + (long)m0 * 3072 + n0;
      EPIS_BEGIN
        const unsigned lo = 2u * (unsigned)(e_rowl * 3072 + e_coll);
        *(bf16_t*)((char*)(tb + e_rowu * 3072 + e_colu) + lo) = f2bf(val);
      EPI_END
    } else {
      EPI_BEGIN
        const int t = m0 + row, n = n0 + col;
        if (n < 3104) lrb[(long)t * 32 + (n - 3072)] = val;
      EPI_END
    }
  }
}

#define GLA_IMG1(p) (GLA_OB(p) + (long)NTOK * 1024)
#define GLA_BLAST(p) ((float*)(GLA_IMG1(p) + (long)NTOK * 1024))
static __device__ __forceinline__ void phase_gla_prep(const Params& p, int j, char* smem, const int dummy) {
  const int tid = opaque_tid(); const int bid = opaque_bid();
  float* sLR = (float*)smem;
  bf16_t* proj = GLA_PROJ(p);
  bf16_t* img1 = GLA_IMG1(p);
  const float* lrb = GLA_LR(p);
  float* blast = GLA_BLAST(p);
  const int dkl = tid & 127, dir = tid >> 7;
  for (int it = bid; it < (NTOK / 32) * 4; it += gridDim.x) {
    const int tb = it >> 2, hh = it & 3;
    const int dk = hh * 128 + dkl;
    __syncthreads();
    ((float4*)sLR)[tid] = *(const float4*)(lrb + ((long)tb * 32 + (tid >> 3)) * 32 + (tid & 7) * 4);
    unsigned rqk[32];
    {
      const bf16_t* rp = proj + ((long)tb * 32 + (dir ? 31 : 0)) * 3072 + dk;
      const long rstep = dir ? -3072 : 3072;
#pragma unroll
      for (int s_ = 0; s_ < 32; ++s_) {
        rqk[s_] = (unsigned)rp[0] | ((unsigned)rp[512] << 16);
        rp += rstep;
      }
    }
    float wd[16];
    const float* wdp = p.gla_w_dec + ((long)(j * 2 + dir) * 16) * 512 + dk;
#pragma unroll
    for (int r = 0; r < 16; ++r) wd[r] = wdp[r * 512];
    const float bd = p.gla_b_dec[(j * 2 + dir) * 512 + dk];
    __syncthreads();
    float* sC = sLR + 1024 + tid;
    float run = 0.f;
#pragma unroll
    for (int s_ = 0; s_ < 32; ++s_) {
      const int pos = dir ? 31 - s_ : s_;
      const float4* lp = (const float4*)(sLR + pos * 32 + dir * 16);
      float lg = bd;
#pragma unroll
      for (int r4 = 0; r4 < 4; ++r4) {
        const float4 l4 = lp[r4];
        lg += l4.x * wd[r4 * 4 + 0] + l4.y * wd[r4 * 4 + 1] + l4.z * wd[r4 * 4 + 2] + l4.w * wd[r4 * 4 + 3];
      }
      run += (fminf(lg, 0.f) - __logf(1.f + __expf(-fabsf(lg)))) * (1.0f / 16.0f);
      sC[s_ * 256] = run;
    }
    blast[((long)dir * (NTOK / 32) + tb) * 512 + dk] = run;
    bf16_t* dst = dir ? img1 : (dummy ? GLA_OF(p) : proj);
    const long dstr = (dir || dummy) ? 1024 : 3072;
#pragma unroll
    for (int s_ = 0; s_ < 32; ++s_) {
      const int pos = dir ? 31 - s_ : s_;
      const long tok = (long)tb * 32 + pos;
      const float e0 = sC[s_ * 256] - run;
      const float qs = 0.08838834764831845f * __expf(fminf(e0, 80.f));
      const float ks = __expf(-e0);
      const unsigned o2 = pk2(bf2f((bf16_t)(rqk[s_] & 0xffffu)) * qs, bf2f((bf16_t)(rqk[s_] >> 16)) * ks);
      dst[tok * dstr + dk] = (bf16_t)(o2 & 0xffffu);
      dst[tok * dstr + 512 + dk] = (bf16_t)(o2 >> 16);
    }
  }
}

#define QS 136
#define TS 40
#define GLA_SLOC(p) ((float*)((p).h))
#define GLA_GSEG(p) (((float*)((p).h)) + (long)128 * 128 * 256)
__device__ __forceinline__ int crow_(int r, int hf) { return (r & 3) + 8 * (r >> 2) + 4 * hf; }
__device__ __forceinline__ bf16x8 pack8(const f32x16& x, const int st) {
  union { unsigned u[4]; bf16x8 v; } c;
  c.u[0] = pk2(x[8 * st + 0], x[8 * st + 1]);
  c.u[1] = pk2(x[8 * st + 2], x[8 * st + 3]);
  c.u[2] = pk2(x[8 * st + 4], x[8 * st + 5]);
  c.u[3] = pk2(x[8 * st + 6], x[8 * st + 7]);
  return c.v;
}
__device__ __forceinline__ bf16x8 ld2x8(const bf16_t* a, const bf16_t* b) {
  union { uint2 d[2]; bf16x8 v; } c;
  c.d[0] = *(const uint2*)a;
  c.d[1] = *(const uint2*)b;
  return c.v;
}

static __device__ __forceinline__ void phase_gla_scan(const Params& p, int j, int pass, char* smem) {
  const int tid = opaque_tid(); const int bid = opaque_bid();
  bf16_t* sQ = (bf16_t*)smem;
  bf16_t* sK = sQ + 32 * QS;
  bf16_t* sKT = sK + 32 * QS;
  bf16_t* sVT = sKT + 128 * TS;
  float* sDec = (float*)(sVT + 64 * TS);
  float* sOp = sDec + 128;
  const bf16_t* proj = GLA_PROJ(p);
  const bf16_t* img1 = GLA_IMG1(p);
  const float* blast = GLA_BLAST(p);
  float* sloc = GLA_SLOC(p);
  float* gseg = GLA_GSEG(p);
  const int lane = tid & 63, wave = tid >> 6, l31 = lane & 31, hf = lane >> 5;
  const int kh = wave >> 1, nt = wave & 1;
  const int dk0 = (tid & 63) * 2, sg = tid >> 6;
  const int vp = tid & 31, sg8 = tid >> 5;
  const int irow = tid >> 3, icol = (tid & 7) * 16;
  const int n_items = pass == 0 ? (1024 + 512) : 512;
  for (int it = bid; it < n_items; it += gridDim.x) {
    int b, hh, dir, vt, sidx, L, tbase;
    bool full, lat;
    if (pass == 0 && it < 1024) {
      vt = it & 3; const int combo = it >> 2;
      dir = combo & 1; hh = (combo >> 1) & 3; b = combo >> 3; sidx = 0;
      L = LCTX; tbase = b * LCTX; full = true; lat = false;
    } else {
      const int i2 = pass == 0 ? it - 1024 : it;
      vt = i2 & 3; const int combo = i2 >> 2;
      dir = combo & 1; hh = (combo >> 1) & 3; sidx = (combo >> 3) & 7; b = combo >> 6;
      L = LLAT; tbase = NCTX + b * LLAT; full = (pass == 1); lat = true;
    }
    bf16_t* obuf = dir ? GLA_OB(p) : GLA_OF(p);
    const bf16_t* ib = dir ? img1 : proj;
    const long istr = dir ? 1024 : 3072;
    const int vcol = vt * 64 + nt * 32 + l31;
    const int sgn = dir ? -1 : 1;
    const int offq = (dir ? 31 - irow : irow) * (int)istr + icol;
    const int offk = (dir ? 31 - 8 * sg : 8 * sg) * (int)istr + dk0;
    const int offv = (dir ? 31 - 4 * sg8 : 4 * sg8) * 3072 + 2 * vp;
    const int offo = (dir ? 31 - 4 * hf : 4 * hf) * 1024 + vcol;
    f32x16 S0, S1;
    if (pass == 0) {
#pragma unroll
      for (int r = 0; r < 16; ++r) { S0[r] = 0.f; S1[r] = 0.f; }
    } else {
      const int rb = opq((kh * 64 + 4 * hf) * 256 + vcol);
      const float* s0 = p.state_gla + ((((long)b * 2 + j) * 2 + dir) * 4 + hh) * 128 * 256 + rb;
#pragma unroll
      for (int r = 0; r < 16; ++r) {
        S0[r] = s0[crow_(r, 0) * 256];
        S1[r] = s0[(32 + crow_(r, 0)) * 256];
      }
      for (int i = 0; i < sidx; ++i) {
        const int ci = (((b * 8 + i) * 4 + hh) * 2 + dir);
        const float* sl = sloc + (long)ci * 128 * 256 + rb;
        const float* gs = gseg + ci * 128 + opq(kh * 64 + 4 * hf);
#pragma unroll
        for (int r = 0; r < 16; ++r) {
          S0[r] = __expf(gs[crow_(r, 0)]) * S0[r] + sl[crow_(r, 0) * 256];
          S1[r] = __expf(gs[32 + crow_(r, 0)]) * S1[r] + sl[(32 + crow_(r, 0)) * 256];
        }
      }
    }
    float gsum = 0.f;
    struct GlaRegs { uint4 q0, q1, k0, k1; unsigned kc[8]; unsigned v[4]; float bl; };
    GlaRegs RA, RB;
    RA.q0 = make_uint4(0u, 0u, 0u, 0u); RA.q1 = RA.q0; RB.q0 = RA.q0; RB.q1 = RA.q0; RA.bl = 0.f; RB.bl = 0.f;
#define GLA_TOK(u_) ((long)tbase + (dir ? (L - 1 - (u_)) : (u_)))
    auto gla_load = [&](const int c_, GlaRegs& R) __attribute__((always_inline)) {
      const int ub = sidx * 256 + c_ * 32;
      const long TB = (long)tbase + (dir ? (L - 32 - ub) : ub);
      {
        const bf16_t* rp = ib + TB * istr + hh * 128 + offq;
        if (full) { R.q0 = *(const uint4*)rp; R.q1 = *(const uint4*)(rp + 8); }
        R.k0 = *(const uint4*)(rp + 512); R.k1 = *(const uint4*)(rp + 520);
      }
#pragma unroll
      for (int i = 0; i < 8; ++i) {
        const bf16_t* uk = ib + (TB + sgn * i) * istr + 512 + hh * 128;
        R.kc[i] = *(const unsigned*)(uk + offk);
      }
#pragma unroll
      for (int i = 0; i < 4; ++i) {
        const bf16_t* uv = proj + (TB + sgn * i) * 3072 + 1024 + hh * 256 + vt * 64;
        R.v[i] = *(const unsigned*)(uv + offv);
      }
      if (tid < 128) R.bl = blast[((long)dir * (NTOK / 32) + (TB >> 5)) * 512 + hh * 128 + tid];
    };
    auto gla_chunk = [&](const int c, GlaRegs& R) __attribute__((always_inline)) {
      if (full) {
        *(uint4*)(sQ + irow * QS + icol) = R.q0; *(uint4*)(sQ + irow * QS + icol + 8) = R.q1;
        *(uint4*)(sK + irow * QS + icol) = R.k0; *(uint4*)(sK + irow * QS + icol + 8) = R.k1;
      }
      {
        uint4 w0, w1;
        w0.x = (R.kc[0] & 0xffffu) | (R.kc[1] << 16); w1.x = (R.kc[0] >> 16) | (R.kc[1] & 0xffff0000u);
        w0.y = (R.kc[2] & 0xffffu) | (R.kc[3] << 16); w1.y = (R.kc[2] >> 16) | (R.kc[3] & 0xffff0000u);
        w0.z = (R.kc[4] & 0xffffu) | (R.kc[5] << 16); w1.z = (R.kc[4] >> 16) | (R.kc[5] & 0xffff0000u);
        w0.w = (R.kc[6] & 0xffffu) | (R.kc[7] << 16); w1.w = (R.kc[6] >> 16) | (R.kc[7] & 0xffff0000u);
        *(uint4*)(sKT + dk0 * TS + 8 * sg) = w0;
        *(uint4*)(sKT + (dk0 + 1) * TS + 8 * sg) = w1;
        uint2 pe, po;
        pe.x = (R.v[0] & 0xffffu) | (R.v[1] << 16); po.x = (R.v[0] >> 16) | (R.v[1] & 0xffff0000u);
        pe.y = (R.v[2] & 0xffffu) | (R.v[3] << 16); po.y = (R.v[2] >> 16) | (R.v[3] & 0xffff0000u);
        *(uint2*)(sVT + (2 * vp) * TS + 4 * sg8) = pe;
        *(uint2*)(sVT + (2 * vp + 1) * TS + 4 * sg8) = po;
      }
      if (tid < 128) { sDec[tid] = __expf(R.bl); gsum += R.bl; }
      __syncthreads();
      if (c + 2 < 8) gla_load(c + 2, R);
#pragma unroll
      for (int r = 0; r < 16; ++r) {
        S0[r] *= sDec[kh * 64 + crow_(r, hf)];
        S1[r] *= sDec[kh * 64 + 32 + crow_(r, hf)];
      }
      f32x16 o;
      if (full) {
        f32x16 att;
#pragma unroll
        for (int r = 0; r < 16; ++r) { att[r] = 0.f; o[r] = 0.f; }
#pragma unroll
        for (int kk = 0; kk < 8; ++kk) {
          const bf16x8 a = *(const bf16x8*)(sK + l31 * QS + kk * 16 + 8 * hf);
          const bf16x8 bq = *(const bf16x8*)(sQ + l31 * QS + kk * 16 + 8 * hf);
          att = __builtin_amdgcn_mfma_f32_32x32x16_bf16(a, bq, att, 0, 0, 0);
        }
#pragma unroll
        for (int r = 0; r < 16; ++r) if (crow_(r, hf) > l31) att[r] = 0.f;
#pragma unroll
        for (int st = 0; st < 2; ++st) {
          {
            const bf16_t* qa = sQ + l31 * QS + kh * 64 + 16 * st + 4 * hf;
            o = __builtin_amdgcn_mfma_f32_32x32x16_bf16(ld2x8(qa, qa + 8), pack8(S0, st), o, 0, 0, 0);
          }
          {
            const bf16_t* qa = sQ + l31 * QS + kh * 64 + 32 + 16 * st + 4 * hf;
            o = __builtin_amdgcn_mfma_f32_32x32x16_bf16(ld2x8(qa, qa + 8), pack8(S1, st), o, 0, 0, 0);
          }
        }
        {
          const bf16x8 pa0 = pack8(att, 0), pa1 = pack8(att, 1);
          const bf16x8 pa = kh ? pa1 : pa0;
          const bf16_t* va = sVT + (nt * 32 + l31) * TS + 16 * kh + 4 * hf;
          o = __builtin_amdgcn_mfma_f32_32x32x16_bf16(pa, ld2x8(va, va + 8), o, 0, 0, 0);
        }
        if (kh == 1) {
#pragma unroll
          for (int r = 0; r < 16; ++r) sOp[(nt * 32 + crow_(r, hf)) * 32 + l31] = o[r];
        }
      }
#pragma unroll
      for (int st = 0; st < 2; ++st) {
        const bf16x8 bv = *(const bf16x8*)(sVT + (nt * 32 + l31) * TS + st * 16 + 8 * hf);
        const bf16x8 a0 = *(const bf16x8*)(sKT + (kh * 64 + l31) * TS + st * 16 + 8 * hf);
        const bf16x8 a1 = *(const bf16x8*)(sKT + (kh * 64 + 32 + l31) * TS + st * 16 + 8 * hf);
        S0 = __builtin_amdgcn_mfma_f32_32x32x16_bf16(a0, bv, S0, 0, 0, 0);
        S1 = __builtin_amdgcn_mfma_f32_32x32x16_bf16(a1, bv, S1, 0, 0, 0);
      }
      __syncthreads();
      if (full && kh == 0) {
        const int ub = sidx * 256 + c * 32;
        const long TB = (long)tbase + (dir ? (L - 32 - ub) : ub);
#pragma unroll
        for (int r = 0; r < 16; ++r) {
          const int srow = crow_(r, hf);
          const float val = o[r] + sOp[(nt * 32 + srow) * 32 + l31];
          bf16_t* uo = obuf + (TB + sgn * (8 * (r >> 2) + (r & 3))) * 1024 + hh * 256;
          uo[offo] = f2bf(val);
        }
      }
    };
    gla_load(0, RA);
    gla_load(1, RB);
    __syncthreads();
    for (int c = 0; c < 8; c += 2) {
      gla_chunk(c, RA);
      gla_chunk(c + 1, RB);
    }
    const int rbo = opq((kh * 64 + 4 * hf) * 256 + vcol);
    if (!lat) {
      float* so = p.out + (long)NTOK * 1024 + ((((long)b * 2 + j) * 2 + dir) * 4 + hh) * 128 * 256 + rbo;
#pragma unroll
      for (int r = 0; r < 16; ++r) {
        so[crow_(r, 0) * 256] = S0[r];
        so[(32 + crow_(r, 0)) * 256] = S1[r];
      }
    } else if (pass == 0) {
      const int ci = (((b * 8 + sidx) * 4 + hh) * 2 + dir);
      float* sl = sloc + (long)ci * 128 * 256 + rbo;
#pragma unroll
      for (int r = 0; r < 16; ++r) {
        sl[crow_(r, 0) * 256] = S0[r];
        sl[(32 + crow_(r, 0)) * 256] = S1[r];
      }
      if (vt == 0 && tid < 128) gseg[ci * 128 + tid] = gsum;
    }
    __syncthreads();
  }
}

static __device__ __forceinline__ void phase_gla_combine(const Params& p, int j) {
  const int tid = opaque_tid(); const int bid = opaque_bid(); (void)tid; (void)bid;
  const int lane = tid & 63, wave = tid >> 6;
  const bf16_t* proj = GLA_PROJ(p);
  const bf16_t* of = GLA_OF(p);
  const bf16_t* ob = GLA_OB(p);
  const float* og = p.gla_onorm_g + j * 256;
  const float4 gg = *(const float4*)(og + lane * 4);
  const int stride = gridDim.x * 4;
  for (int it0 = bid * 4 + wave; it0 < NTOK * 4; it0 += 4 * stride) {
    uint2 a[4], b[4], r[4];
#pragma unroll
    for (int u = 0; u < 4; ++u) {
      const int it = it0 + u * stride;
      if (it < NTOK * 4) {
        const int t = it >> 2, hh = it & 3;
        const long base = (long)t * 1024 + hh * 256 + lane * 4;
        a[u] = *(const uint2*)(of + base);
        b[u] = *(const uint2*)(ob + base);
        r[u] = *(const uint2*)(proj + (long)t * 3072 + 2048 + hh * 256 + lane * 4);
      }
    }
#pragma unroll
    for (int u = 0; u < 4; ++u) {
      const int it = it0 + u * stride;
      if (it < NTOK * 4) {
        const int t = it >> 2, hh = it & 3;
        const long base = (long)t * 1024 + hh * 256 + lane * 4;
        float o[4];
        o[0] = bf2f(a[u].x & 0xffff) + bf2f(b[u].x & 0xffff);
        o[1] = bf2f(a[u].x >> 16) + bf2f(b[u].x >> 16);
        o[2] = bf2f(a[u].y & 0xffff) + bf2f(b[u].y & 0xffff);
        o[3] = bf2f(a[u].y >> 16) + bf2f(b[u].y >> 16);
        const float r0 = bf2f(r[u].x & 0xffff), r1 = bf2f(r[u].x >> 16), r2 = bf2f(r[u].y & 0xffff), r3 = bf2f(r[u].y >> 16);
        float ss = o[0] * o[0] + o[1] * o[1] + o[2] * o[2] + o[3] * o[3];
#pragma unroll
        for (int sft = 32; sft > 0; sft >>= 1) ss += __shfl_xor(ss, sft);
        const float rstd = rsqrtf(ss * (1.0f / 256.0f) + 1e-6f);
        uint2 w;
        w.x = pk2(o[0] * rstd * gg.x * siluf(r0), o[1] * rstd * gg.y * siluf(r1));
        w.y = pk2(o[2] * rstd * gg.z * siluf(r2), o[3] * rstd * gg.w * siluf(r3));
        *(uint2*)(p.h + base) = w;
      }
    }
  }
}

#define FN_PROJ(p) ((p).big)
#define FN_XCS_CTX(p) ((p).big + (long)NTOK * 2048)
#define FN_XCS_LAT(p) (FN_XCS_CTX(p) + (long)NCTX * 2048)

static __device__ __forceinline__ void phase_fn_in(const Params& p, char* smem) {
  const int tid = opaque_tid(); const int bid = opaque_bid(); (void)tid; (void)bid;
  bf16_t* sA = (bf16_t*)smem;
  GEMM_STAGE_DECL
  bool pre = false;
  bf16_t* proj = FN_PROJ(p);
  const int n_tiles = 96 * 16;
  for (int tile = bid; tile < n_tiles; tile += gridDim.x) {
    const int mt = tile % 96, nt = tile / 96;
    const int m0 = mt * 128, n0 = nt * 128;
    f32x16 acc[2][2];
    {
      const int tn = tile + gridDim.x;
      const bool hn = tn < n_tiles;
      gemm_tile(p.h + (long)m0 * 1024, 1024, p.wt_fn_in + (long)n0 * 1024, 1024, 1024, sA, acc, tid, GEMM_STAGE_ARGS, pre,
                hn ? p.h + (long)((tn % 96) * 128) * 1024 : nullptr, hn ? p.wt_fn_in + (long)((tn / 96) * 128) * 1024 : nullptr);
      pre = hn;
    }
    {
      bf16_t* tb = proj + (long)m0 * 2048 + n0;
      EPIS_BEGIN
        const unsigned lo = 2u * (unsigned)(e_rowl * 2048 + e_coll);
        *(bf16_t*)((char*)(tb + e_rowu * 2048 + e_colu) + lo) = f2bf(val);
      EPI_END
    }
  }
}

static __device__ __forceinline__ void phase_fn_a(const Params& p, char* smem) {
  const int tid = opaque_tid(); const int bid = opaque_bid(); (void)tid; (void)bid;
  bf16_t* sA = (bf16_t*)smem;
  GEMM_STAGE_DECL
  const bf16_t* proj = FN_PROJ(p);
  const int n_tiles = 4 * 96 * 4;
  for (int tile = bid; tile < n_tiles; tile += gridDim.x) {
    const int mt = tile & 3, g = (tile >> 2) & 3, tt = tile >> 4;
    const int m0 = mt * 128, t0 = tt * 128;
    f32x16 acc[2][2];
    gemm_tile(p.tabA + (long)m0 * 256, 256, proj + (long)t0 * 2048 + g * 256, 2048, 256, sA, acc, tid, GEMM_STAGE_ARGS, false, nullptr, nullptr);
    const bool lat = t0 >= NCTX;
    const int L = lat ? LLAT : LCTX;
    const int b = lat ? ((t0 - NCTX) >> 11) : (t0 >> 8);
    const int pos0 = lat ? ((t0 - NCTX) & 2047) : (t0 & 255);
    bf16_t* dst = lat ? FN_XCS_LAT(p) : FN_XCS_CTX(p);
    EPI_BEGIN_OPQ
      const int m = m0 + row;
      const int cs = m >> 8, co = m & 255;
      dst[((long)((b * 4 + g) * 256 + co)) * (2 * L) + cs * L + pos0 + col] = f2bf(val);
    EPI_END
  }
}

static __device__ __forceinline__ void phase_fn_b(const Params& p, char* smem) {
  const int tid = opaque_tid(); const int bid = opaque_bid(); (void)tid; (void)bid;
  bf16_t* sA = (bf16_t*)smem;
  GEMM_STAGE_DECL
  const bf16_t* proj = FN_PROJ(p);
  const int n_lat = 2 * 4 * 16 * 2;
  const int n_ctx = 32 * 4 * 2 * 2;
  const bool rebal = (gridDim.x == 512);
  for (int it_ = bid; it_ < (rebal ? 1024 : n_lat + n_ctx); it_ += gridDim.x) {
    int tile = it_;
    if (rebal) {
      if (it_ < 512) tile = (it_ < 256) ? it_ : (256 + 2 * (it_ - 256));
      else tile = (it_ - 512 < 256) ? -1 : (256 + 2 * (it_ - 768) + 1);
      if (tile < 0) continue;
    }
    int b, g, mt, nt, L, tbase;
    const bf16_t *tab, *xcs;
    if (tile < n_lat) {
      nt = tile & 1; mt = (tile >> 1) & 15; g = (tile >> 5) & 3; b = tile >> 7;
      L = LLAT; tbase = NCTX + b * LLAT; tab = p.tabB_lat; xcs = FN_XCS_LAT(p);
    } else {
      int t2 = tile - n_lat;
      nt = t2 & 1; mt = (t2 >> 1) & 1; g = (t2 >> 2) & 3; b = t2 >> 4;
      L = LCTX; tbase = b * LCTX; tab = p.tabB_ctx; xcs = FN_XCS_CTX(p);
    }
    const int m0 = mt * 128, n0 = nt * 128;
    f32x16 acc[2][2];
    gemm_tile(tab + (long)m0 * (2 * L), 2 * L, xcs + ((long)((b * 4 + g) * 256 + n0)) * (2 * L), 2 * L, 2 * L, sA, acc, tid, GEMM_STAGE_ARGS, false, nullptr, nullptr);
    const float scale = rsqrtf((float)L * 256.0f);
    {
      const int e_lane = tid & 63, e_wave = tid >> 6;
      const int e_wm = e_wave >> 1, e_wn = e_wave & 1;
#pragma unroll
      for (int e_i = 0; e_i < 2; ++e_i)
#pragma unroll
        for (int e_j = 0; e_j < 2; ++e_j) {
          const int rowb = opq(e_wm * 64 + e_i * 32 + 4 * (e_lane >> 5));
          const int ch = g * 256 + n0 + e_wn * 64 + e_j * 32 + (e_lane & 31);
          bf16_t zr[16];
#pragma unroll
          for (int e_r = 0; e_r < 16; ++e_r) zr[e_r] = proj[(long)(tbase + m0 + rowb + 8 * (e_r >> 2) + (e_r & 3)) * 2048 + 1024 + ch];
#pragma unroll
          for (int e_r = 0; e_r < 16; ++e_r)
            p.h[(long)(tbase + m0 + rowb + 8 * (e_r >> 2) + (e_r & 3)) * 1024 + ch] = f2bf(acc[e_i][e_j][e_r] * scale * siluf(bf2f(zr[e_r])));
        }
    }
  }
}

#define HY_UT(p) ((p).big)
#define HY_YT(p) ((p).big + (long)4096 * NTOK)

static __device__ __forceinline__ void phase_hy_in(const Params& p, char* smem) {
  const int tid = opaque_tid(); const int bid = opaque_bid(); (void)tid; (void)bid;
  bf16_t* sA = (bf16_t*)smem;
  GEMM_STAGE_DECL
  bool pre = false;
  bf16_t* uT = HY_UT(p);
  const int n_tiles = 32 * 96;
  for (int tile = bid; tile < n_tiles; tile += gridDim.x) {
    const int nt = tile % 96, mt = tile / 96;
    const int m0 = mt * 128, n0 = nt * 128;
    f32x16 acc[2][2];
    {
      const int tn = tile + gridDim.x;
      const bool hn = tn < n_tiles;
      gemm_tile(p.wt_hy_in + (long)m0 * 1024, 1024, p.h + (long)n0 * 1024, 1024, 1024, sA, acc, tid, GEMM_STAGE_ARGS, pre,
                hn ? p.wt_hy_in + (long)((tn / 96) * 128) * 1024 : nullptr, hn ? p.h + (long)((tn % 96) * 128) * 1024 : nullptr);
      pre = hn;
    }
    {
      bf16_t* tb = uT + (long)m0 * NTOK + n0;
      EPIS_BEGIN
        const unsigned lo = 2u * (unsigned)(e_rowl * NTOK + e_coll);
        *(bf16_t*)((char*)(tb + e_rowu * NTOK + e_colu) + lo) = f2bf(val);
      EPI_END
    }
  }
}

__device__ __forceinline__ int upad(int pos) { return pos + 8 * (pos >> 5); }
static __device__ __forceinline__ void phase_hy_conv(const Params& p, char* smem) {
  const int tid = opaque_tid(); const int bid = opaque_bid();
  bf16_t* sU = (bf16_t*)smem;
  bf16_t* sX1 = sU + 10240;
  bf16_t* sX2 = sX1 + 8192;
  bf16_t* sR0 = sX2 + 8192;
  bf16_t* sR1 = sR0 + 4128;
  const bf16_t* uT = HY_UT(p);
  bf16_t* yT = HY_YT(p);
  const int lane = tid & 63, wave = tid >> 6, l31 = lane & 31, hf = lane >> 5;
  const int n_items = 1024 + 1024;
  for (int it = bid; it < n_items; it += gridDim.x) {
    const bool lat = it < 1024;
    const int ch = lat ? it : (it - 1024);
    const int L = lat ? LLAT : LCTX;
    const int nb = L >> 5;
    const int tok0 = lat ? NCTX : 0;
    const int ntw = lat ? 1 : 2;
    const bf16_t* filt = (lat ? p.filt_lat : p.filt_ctx);
    __syncthreads();
    for (int pc = 0; pc < ntw; ++pc) {
      const int p0 = pc * 4096 + tid * 16;
      const bool has_l = (p0 & (L - 1)) != 0, has_r = ((p0 + 16) & (L - 1)) != 0;
#pragma unroll
      for (int g = 0; g < 3; ++g) {
        const int f = g * 1024 + ch;
        const bf16_t* row = uT + (long)f * NTOK + tok0 + p0;
        const uint4 v0 = *(const uint4*)row, v1 = *(const uint4*)(row + 8);
        float e[18];
        e[0] = has_l ? bf2f(row[-1]) : 0.f;
        e[17] = has_r ? bf2f(row[16]) : 0.f;
        const unsigned vv[8] = {v0.x, v0.y, v0.z, v0.w, v1.x, v1.y, v1.z, v1.w};
#pragma unroll
        for (int q = 0; q < 8; ++q) { e[1 + 2 * q] = bf2f((bf16_t)(vv[q] & 0xffffu)); e[2 + 2 * q] = bf2f((bf16_t)(vv[q] >> 16)); }
        const float w0 = p.hy_conv_w[f], w1 = p.hy_conv_w[3072 + f], w2 = p.hy_conv_w[6144 + f], bb = p.hy_conv_b[f];
        unsigned o[8];
#pragma unroll
        for (int q = 0; q < 8; ++q) {
          const float a0 = e[2 * q] * w0 + e[2 * q + 1] * w1 + e[2 * q + 2] * w2 + bb;
          const float a1 = e[2 * q + 1] * w0 + e[2 * q + 2] * w1 + e[2 * q + 3] * w2 + bb;
          o[q] = pk2(a0, a1);
        }
        bf16_t* dst = (g == 0) ? (sX1 + p0) : (g == 1) ? (sX2 + p0) : (sU + upad(p0));
        uint4 o0, o1;
        o0.x = o[0]; o0.y = o[1]; o0.z = o[2]; o0.w = o[3];
        o1.x = o[4]; o1.y = o[5]; o1.z = o[6]; o1.w = o[7];
        *(uint4*)dst = o0;
        *(uint4*)(dst + 8) = o1;
      }
    }
    const int xa = (L - 1) - l31 + 8 * hf;
    const bf16_t* Rp = (xa & 1) ? (sR1 - 1) : sR0;
    float y1r[2][16];
    for (int order = 0; order < 2; ++order) {
      const bf16_t* fsrc = filt + ((long)(order * 1024 + ch)) * (2 * L);
      for (int x8 = tid; x8 < (2 * L) / 8; x8 += NTHR) {
        const uint4 v = *(const uint4*)(fsrc + 8 * x8);
        *(uint4*)(sR0 + 8 * x8) = v;
        const unsigned vv[4] = {v.x, v.y, v.z, v.w};
#pragma unroll
        for (int q = 0; q < 4; ++q) {
          if (8 * x8 + 2 * q >= 1) sR1[8 * x8 + 2 * q - 1] = (bf16_t)(vv[q] & 0xffffu);
          sR1[8 * x8 + 2 * q] = (bf16_t)(vv[q] >> 16);
        }
      }
      __syncthreads();
      const float dsk = p.hy_d[order * 1024 + ch];
      const bf16_t* gate = order ? sX2 : sX1;
#pragma unroll
      for (int tt = 0; tt < 2; ++tt) {
        if (tt < ntw) {
          int bt, i_blk, dlo, dhi;
          if (lat) { bt = wave >> 1; const int i0 = 32 * (wave & 1); i_blk = i0 + l31; dlo = i0 - 63; dhi = i0 + 31; }
          else { bt = 4 * (2 * wave + tt) + (l31 >> 3); i_blk = l31 & 7; dlo = -7; dhi = 7; }
          const bf16_t* ubase = sU + upad(bt * L);
          const int pos_base = bt * L + 32 * i_blk + 4 * hf;
          f32x16 acc;
#pragma unroll
          for (int r = 0; r < 16; ++r) acc[r] = 0.f;
          for (int d = dlo; d <= dhi; ++d) {
            const int jb = i_blk - d;
            const bool valid = (unsigned)jb < (unsigned)nb;
            const int jc = valid ? jb : 0;
            const bf16_t* bp = ubase + 40 * jc + 8 * hf;
            const unsigned* ap = (const unsigned*)(Rp + (xa - 32 * d));
#pragma unroll
            for (int ks2 = 0; ks2 < 2; ++ks2) {
              union { unsigned u[4]; bf16x8 v; } A;
              A.u[0] = ap[8 * ks2 + 0]; A.u[1] = ap[8 * ks2 + 1]; A.u[2] = ap[8 * ks2 + 2]; A.u[3] = ap[8 * ks2 + 3];
              union { uint4 q; bf16x8 v; } B;
              B.q = *(const uint4*)(bp + 16 * ks2);
              if (!valid) { B.q.x = 0u; B.q.y = 0u; B.q.z = 0u; B.q.w = 0u; }
              acc = __builtin_amdgcn_mfma_f32_32x32x16_bf16(A.v, B.v, acc, 0, 0, 0);
            }
          }
#pragma unroll
          for (int g = 0; g < 4; ++g) {
            const int pos = pos_base + 8 * g;
            const uint2 gg = *(const uint2*)(gate + pos);
            const uint2 uo = *(const uint2*)(sU + upad(pos));
            const float g0 = bf2f((bf16_t)(gg.x & 0xffffu)), g1 = bf2f((bf16_t)(gg.x >> 16)), g2 = bf2f((bf16_t)(gg.y & 0xffffu)), g3 = bf2f((bf16_t)(gg.y >> 16));
            const float u0 = bf2f((bf16_t)(uo.x & 0xffffu)), u1 = bf2f((bf16_t)(uo.x >> 16)), u2 = bf2f((bf16_t)(uo.y & 0xffffu)), u3 = bf2f((bf16_t)(uo.y >> 16));
            y1r[tt][4 * g + 0] = g0 * (acc[4 * g + 0] + dsk * u0);
            y1r[tt][4 * g + 1] = g1 * (acc[4 * g + 1] + dsk * u1);
            y1r[tt][4 * g + 2] = g2 * (acc[4 * g + 2] + dsk * u2);
            y1r[tt][4 * g + 3] = g3 * (acc[4 * g + 3] + dsk * u3);
          }
        }
      }
      __syncthreads();
#pragma unroll
      for (int tt = 0; tt < 2; ++tt) {
        if (tt < ntw) {
          int bt, i_blk;
          if (lat) { bt = wave >> 1; i_blk = 32 * (wave & 1) + l31; }
          else { bt = 4 * (2 * wave + tt) + (l31 >> 3); i_blk = l31 & 7; }
          const int pos_base = bt * L + 32 * i_blk + 4 * hf;
          if (order == 0) {
#pragma unroll
            for (int g = 0; g < 4; ++g) {
              uint2 w;
              w.x = pk2(y1r[tt][4 * g + 0], y1r[tt][4 * g + 1]);
              w.y = pk2(y1r[tt][4 * g + 2], y1r[tt][4 * g + 3]);
              *(uint2*)(sU + upad(pos_base + 8 * g)) = w;
            }
          } else {
            uint2 zz[4];
#pragma unroll
            for (int g = 0; g < 4; ++g) zz[g] = *(const uint2*)(uT + (long)(3072 + ch) * NTOK + tok0 + pos_base + 8 * g);
#pragma unroll
            for (int g = 0; g < 4; ++g) {
              const long gp = (long)tok0 + pos_base + 8 * g;
              const float z0 = bf2f((bf16_t)(zz[g].x & 0xffffu)), z1 = bf2f((bf16_t)(zz[g].x >> 16)), z2 = bf2f((bf16_t)(zz[g].y & 0xffffu)), z3 = bf2f((bf16_t)(zz[g].y >> 16));
              uint2 w;
              w.x = pk2(y1r[tt][4 * g + 0] * siluf(z0), y1r[tt][4 * g + 1] * siluf(z1));
              w.y = pk2(y1r[tt][4 * g + 2] * siluf(z2), y1r[tt][4 * g + 3] * siluf(z3));
              *(uint2*)(yT + (long)ch * NTOK + gp) = w;
            }
          }
        }
      }
    }
  }
}

static __device__ __forceinline__ void phase_hy_transpose(const Params& p, char* smem) {
  const int tid = opaque_tid(); const int bid = opaque_bid(); (void)tid; (void)bid;
  bf16_t* t = (bf16_t*)smem;
  const bf16_t* yT = HY_YT(p);
  const int n_items = 16 * 192;
  for (int it = bid; it < n_items; it += gridDim.x) {
    const int ct = it & 15, tt = it >> 4;
    const int c0 = ct * 64, t0 = tt * 64;
    __syncthreads();
    for (int i = tid; i < 64 * 64; i += NTHR) {
      int r = i >> 6, cc = i & 63;
      t[cc * 66 + r] = yT[(long)(c0 + r) * NTOK + t0 + cc];
    }
    __syncthreads();
    for (int i = tid; i < 64 * 64; i += NTHR) {
      int r = i >> 6, cc = i & 63;
      p.h[(long)(t0 + r) * 1024 + c0 + cc] = t[r * 66 + cc];
    }
  }
}

#define XB_TMO      128
#define XB_XCNT(j)  (256  + 64 * (j))
#define XB_XSUB(j)  (1280 + 64 * (j))
#define XB_XGEN(j)  (2304 + 64 * (j))
#define XB_TOP      3328
#define XB_TOPGEN   3392
#define XCD_BAR_WORDS 3456
#define XB_SPIN_CAP (1u << 18)
#define LAS __attribute__((address_space(3)))
__device__ __forceinline__ unsigned xb_ld(unsigned* p)              { return __hip_atomic_load(p, __ATOMIC_RELAXED, __HIP_MEMORY_SCOPE_AGENT); }
__device__ __forceinline__ unsigned xb_add(unsigned* p, unsigned v) { return __hip_atomic_fetch_add(p, v, __ATOMIC_RELAXED, __HIP_MEMORY_SCOPE_AGENT); }
__device__ __forceinline__ unsigned xb_xcc_id() { return (unsigned)__builtin_amdgcn_s_getreg((3 << 11) | 20) & 0xFu; }
#define XB_SPIN(cond, bar) do { unsigned _sp = 0; while (cond) { __builtin_amdgcn_s_sleep(1); \
    if ((++_sp & 255u) == 0u) { if (xb_ld(&(bar)[XB_TMO])) break; if (_sp > XB_SPIN_CAP) { atomicAdd(&(bar)[XB_TMO], 1u); break; } } } } while (0)
struct XcdBarrier { unsigned* bar; unsigned x; volatile LAS unsigned* st; };
__device__ __forceinline__ XcdBarrier xcd_barrier_post(unsigned* bar, volatile LAS unsigned* st) {
    XcdBarrier b; b.bar = bar; b.x = xb_xcc_id(); b.st = st;
    if (threadIdx.x == 0) (void)xb_add(&bar[XB_XCNT(b.x)], 1u);
    return b;
}
__device__ __forceinline__ void xcd_barrier_complete(unsigned* bar, unsigned x, unsigned& nloc, unsigned& nx) {
    const unsigned G = gridDim.x * gridDim.y * gridDim.z;
    unsigned sum, cnt, mine, sp = 0u;
    for (;;) {
        sum = 0u; cnt = 0u; mine = 0u;
#pragma unroll
        for (unsigned j = 0; j < 16; ++j) { const unsigned c = xb_ld(&bar[XB_XCNT(j)]); sum += c; cnt += (c > 0u) ? 1u : 0u; mine = (j == x) ? c : mine; }
        if (sum == G) break;
        __builtin_amdgcn_s_sleep(1);
        if ((++sp & 255u) == 0u) { if (xb_ld(&bar[XB_TMO])) break; if (sp > XB_SPIN_CAP) { atomicAdd(&bar[XB_TMO], 1u); break; } }
    }
    nloc = mine > 0u ? mine : 1u; nx = cnt > 0u ? cnt : 1u;
}
__device__ __forceinline__ void xcd_barrier(const XcdBarrier& b) {
    asm volatile("s_waitcnt vmcnt(0)" ::: "memory");
    __syncthreads();
    if (threadIdx.x == 0) {
        unsigned* bar = b.bar;
        __builtin_amdgcn_s_waitcnt(0);
        unsigned nloc = b.st[0], nx = b.st[1];
        if (nloc == 0u) { xcd_barrier_complete(bar, b.x, nloc, nx); b.st[0] = nloc; b.st[1] = nx; }
        const unsigned old = xb_add(&bar[XB_XSUB(b.x)], 1u);
        const unsigned gen = old / nloc;
        if (old + 1u == (gen + 1u) * nloc) {
            __builtin_amdgcn_fence(__ATOMIC_RELEASE, "agent");
            asm volatile("s_waitcnt vmcnt(0)" ::: "memory");
            const unsigned og = xb_add(&bar[XB_TOP], 1u);
            const unsigned tg = og / nx;
            if (og + 1u == (tg + 1u) * nx) xb_add(&bar[XB_TOPGEN], 1u);
            else XB_SPIN(xb_ld(&bar[XB_TOPGEN]) == tg, bar);
            __builtin_amdgcn_fence(__ATOMIC_ACQUIRE, "agent");
            xb_add(&bar[XB_XGEN(b.x)], 1u);
            asm volatile("s_waitcnt vmcnt(0)" ::: "memory");
        } else {
            XB_SPIN(xb_ld(&bar[XB_XGEN(b.x)]) == gen, bar);
            __builtin_amdgcn_fence(__ATOMIC_ACQUIRE, "agent");
            asm volatile("s_waitcnt vmcnt(0)" ::: "memory");
        }
    }
    __syncthreads();
}

__global__ void __launch_bounds__(NTHR, 2) mega(Params p) {
  cg::grid_group grid = cg::this_grid();
  __shared__ __attribute__((aligned(16))) char smem[SMEM_BYTES];
  __shared__ uint4 xb_words;
  if (threadIdx.x == 0) xb_words = make_uint4(0u, 0u, 0u, 0u);
  __syncthreads();
  const XcdBarrier xb = xcd_barrier_post(p.bar, (volatile LAS unsigned*)&xb_words);
  if (p.use_cg) grid.sync();
#define GSYNC() xcd_barrier(xb)
#define REP(id) for (int rep##id = 0; rep##id < (PROBE == (id) ? 3 : 1); ++rep##id)
  REP(19) {
  REP(1) { p0_mod(p, smem); }
  REP(2) { p0_filt_mlp(p, smem); }
  REP(3) { p0_tables(p, smem); }
  REP(4) { p0_weights(p, smem); }
  GSYNC();
  }
  if (PROBE == 5) { for (int rep = 0; rep < 40; ++rep) GSYNC(); }
  for (int layer = 0; layer < 4; ++layer) {
    const int kind = layer % 3, j = layer / 3;
    REP(6) { phase_norm(p, layer); if (layer == 1) phase_filt_main(p, smem); GSYNC(); }
    const bf16_t* wt_out;
    if (kind == 0) {
      REP(7) { phase_gla_in(p, j ? p.wt_gla_in1 : p.wt_gla_in0, smem); GSYNC(); }
      for (int rep = 0; rep < (PROBE == 17 ? 3 : 1); ++rep) { phase_gla_prep(p, j, smem, rep + 1 < (PROBE == 17 ? 3 : 1)); GSYNC(); }
      REP(8) { phase_gla_scan(p, j, 0, smem); GSYNC(); }
      REP(9) { phase_gla_scan(p, j, 1, smem); GSYNC(); }
      REP(10) { phase_gla_combine(p, j); GSYNC(); }
      wt_out = j ? p.wt_gla_out1 : p.wt_gla_out0;
    } else if (kind == 1) {
      REP(11) { phase_fn_in(p, smem); GSYNC(); }
      REP(12) { phase_fn_a(p, smem); GSYNC(); }
      REP(13) { phase_fn_b(p, smem); GSYNC(); }
      wt_out = p.wt_fn_out;
    } else {
      REP(14) { phase_hy_in(p, smem); GSYNC(); }
      REP(15) { phase_hy_conv(p, smem); GSYNC(); }
      REP(16) { phase_hy_transpose(p, smem); GSYNC(); }
      wt_out = p.wt_hy_out;
    }
    for (int rep = 0; rep < (PROBE == 18 ? 3 : 1); ++rep) { phase_gemm_out(p, layer, wt_out, smem, rep + 1 < (PROBE == 18 ? 3 : 1)); GSYNC(); }
  }
  phase_final_norm(p);
}

static inline size_t align_up(size_t x) { return (x + 255) & ~(size_t)255; }

extern "C" void kernel_launch(void* const* d_in, const int* in_sizes, int n_in, void* d_out,
                              int out_size, void* d_ws, size_t ws_size, hipStream_t stream) {
  static int grid_blocks = 0;
  if (!grid_blocks) {
    int dev = 0, cus = 0, per_cu = 0;
    hipGetDevice(&dev);
    hipDeviceGetAttribute(&cus, hipDeviceAttributeMultiprocessorCount, dev);
    hipOccupancyMaxActiveBlocksPerMultiprocessor(&per_cu, mega, NTHR, 0);
    if (per_cu > 2) per_cu = 2;
    if (per_cu < 1) per_cu = 1;
    grid_blocks = cus * per_cu;
  }
  Params p{};
  const float* const* in = (const float* const*)d_in;
  p.x_prompt = in[0]; p.x_sample = in[1]; p.state_gla = in[2]; p.c = in[3]; p.c_ctx = in[4];
  p.mod_w = in[5]; p.mod_b = in[6]; p.norm_g = in[7]; p.final_norm_g = in[8];
  p.gla_w_in = in[9]; p.gla_w_dec = in[10]; p.gla_b_dec = in[11]; p.gla_onorm_g = in[12]; p.gla_w_out = in[13];
  p.fn_w_in = in[14]; p.fn_w_out = in[15];
  p.hy_w_in = in[16]; p.hy_conv_w = in[17]; p.hy_conv_b = in[18];
  p.hy_w1 = in[19]; p.hy_b1 = in[20]; p.hy_w2 = in[21]; p.hy_b2 = in[22]; p.hy_w3 = in[23]; p.hy_b3 = in[24];
  p.hy_w4 = in[25]; p.hy_freq = in[26]; p.hy_d = in[27]; p.hy_w_out = in[28];
  p.out = (float*)d_out;
  char* w = (char*)d_ws;
  size_t off = 0;
  auto take = [&](size_t bytes) { char* r = w + off; off = align_up(off + bytes); return r; };
  p.h = (bf16_t*)take((size_t)NTOK * 1024 * 2);
  p.big = (bf16_t*)take((size_t)156 * 1024 * 1024);
  p.wt_gla_in0 = (bf16_t*)take((size_t)3200 * 1024 * 2);
  p.wt_gla_in1 = (bf16_t*)take((size_t)3200 * 1024 * 2);
  p.wt_gla_out0 = (bf16_t*)take((size_t)1024 * 1024 * 2);
  p.wt_gla_out1 = (bf16_t*)take((size_t)1024 * 1024 * 2);
  p.wt_fn_in = (bf16_t*)take((size_t)2048 * 1024 * 2);
  p.wt_fn_out = (bf16_t*)take((size_t)1024 * 1024 * 2);
  p.wt_hy_in = (bf16_t*)take((size_t)4096 * 1024 * 2);
  p.wt_hy_out = (bf16_t*)take((size_t)1024 * 1024 * 2);
  p.tabA = (bf16_t*)take((size_t)512 * 256 * 2);
  p.tabB_ctx = (bf16_t*)take((size_t)256 * 512 * 2);
  p.tabB_lat = (bf16_t*)take((size_t)2048 * 4096 * 2);
  p.filt_ctx = (bf16_t*)take((size_t)2 * 1024 * 512 * 2);
  p.filt_lat = (bf16_t*)take((size_t)2 * 1024 * 4096 * 2);
  p.filt_a3 = (float*)take((size_t)2304 * 64 * 4);
  p.bar = (unsigned*)take((size_t)XCD_BAR_WORDS * 4 + (size_t)4 * 3 * 3072 * 4);
  p.modv = (float*)(p.bar + XCD_BAR_WORDS);
  p.use_cg = 0; p.pad = 0;
  hipMemsetAsync(p.bar, 0, (size_t)XCD_BAR_WORDS * 4 + (size_t)4 * 3 * 3072 * 4, stream);
  void* args[] = {&p};
  hipError_t e = hipLaunchCooperativeKernel((void*)mega, dim3(grid_blocks), dim3(NTHR), args, 0, stream);
  if (e != hipSuccess) fprintf(stderr, "cooperative launch failed: %s (grid %d, ws %zu need %zu)\n", hipGetErrorString(e), grid_blocks, ws_size, off);
}
```

```cpp
#include <hip/hip_runtime.h>
#include <hip/hip_cooperative_groups.h>
#include <cstdio>
namespace cg = cooperative_groups;

typedef unsigned short bf16_t;
typedef short bf16x8 __attribute__((ext_vector_type(8)));
typedef float f32x16 __attribute__((ext_vector_type(16)));

#ifndef PROBE
#define PROBE 0
#endif
#define NTOK 12288
#define NCTX 8192
#define DM 1024
#define LCTX 256
#define LLAT 2048
#define NTHR 256
#define SMEM_BYTES 73728
#define LDSS 72
#define TWO_PI 6.283185307179586f

struct Params {
  const float *x_prompt, *x_sample, *state_gla, *c, *c_ctx, *mod_w, *mod_b, *norm_g, *final_norm_g;
  const float *gla_w_in, *gla_w_dec, *gla_b_dec, *gla_onorm_g, *gla_w_out;
  const float *fn_w_in, *fn_w_out;
  const float *hy_w_in, *hy_conv_w, *hy_conv_b, *hy_w1, *hy_b1, *hy_w2, *hy_b2, *hy_w3, *hy_b3, *hy_w4, *hy_freq, *hy_d, *hy_w_out;
  float* out;
  bf16_t* h;
  bf16_t* big;
  float* modv;
  bf16_t* wt_gla_in0; bf16_t* wt_gla_in1; bf16_t* wt_gla_out0; bf16_t* wt_gla_out1;
  bf16_t* wt_fn_in; bf16_t* wt_fn_out; bf16_t* wt_hy_in; bf16_t* wt_hy_out;
  bf16_t* tabA; bf16_t* tabB_ctx; bf16_t* tabB_lat;
  bf16_t* filt_ctx; bf16_t* filt_lat;
  float* filt_a3;
  unsigned* bar;
  int use_cg; int pad;
};

typedef __bf16 bf16n2 __attribute__((ext_vector_type(2)));
typedef float f32n2 __attribute__((ext_vector_type(2)));
__device__ __forceinline__ unsigned pk2(float a, float b) {
  f32n2 v = {a, b};
  return __builtin_bit_cast(unsigned, __builtin_convertvector(v, bf16n2));
}
__device__ __forceinline__ bf16_t f2bf(float x) { return (bf16_t)(pk2(x, 0.f) & 0xffffu); }
__device__ __forceinline__ float bf2f(bf16_t b) { return __uint_as_float(((unsigned)b) << 16); }
__device__ __forceinline__ float siluf(float x) { return x / (1.f + expf(-x)); }
__device__ __forceinline__ float logsigf(float x) { return fminf(x, 0.f) - log1pf(expf(-fabsf(x))); }
__device__ __forceinline__ int opaque_tid() { int t = threadIdx.x; asm volatile("" : "+v"(t)); return t; }
__device__ __forceinline__ int opq(int t) { asm volatile("" : "+v"(t)); return t; }
__device__ __forceinline__ int opaque_bid() { int b = blockIdx.x; asm volatile("" : "+s"(b)); return b; }
__device__ __forceinline__ int first_item_(int bid, int off) {
  int G = gridDim.x;
  return (int)((bid + G - (off % G)) % G);
}
#define first_item(off) first_item_(bid, off)

#define GEMM_BUF (2 * 128 * LDSS)
#define GEMM_STAGE_DECL uint4 g_xa0, g_xa1, g_xa2, g_xa3, g_xb0, g_xb1, g_xb2, g_xb3, g_ya0, g_ya1, g_ya2, g_ya3, g_yb0, g_yb1, g_yb2, g_yb3;
#define GEMM_STAGE_ARGS g_xa0, g_xa1, g_xa2, g_xa3, g_xb0, g_xb1, g_xb2, g_xb3, g_ya0, g_ya1, g_ya2, g_ya3, g_yb0, g_yb1, g_yb2, g_yb3
__device__ __forceinline__ void gemm_tile(const bf16_t* __restrict__ A, long lda, const bf16_t* __restrict__ B, long ldb,
                                          int K, bf16_t* sbase, f32x16 (&acc)[2][2], const int tid,
                                          uint4& xa0, uint4& xa1, uint4& xa2, uint4& xa3, uint4& xb0, uint4& xb1, uint4& xb2, uint4& xb3, uint4& ya0, uint4& ya1, uint4& ya2, uint4& ya3, uint4& yb0, uint4& yb1, uint4& yb2, uint4& yb3,
                                          const bool preloaded, const bf16_t* An, const bf16_t* Bn) {
  const int lane = tid & 63, wave = tid >> 6;
  const int wm = wave >> 1, wn = wave & 1;
  const int lr = tid >> 3, lc = (tid & 7) * 8;
#pragma unroll
  for (int i = 0; i < 2; ++i)
#pragma unroll
    for (int j = 0; j < 2; ++j)
#pragma unroll
      for (int r = 0; r < 16; ++r) acc[i][j][r] = 0.f;
  const bf16_t* pa = A + (long)lr * lda + lc;
  const bf16_t* pb = B + (long)lr * ldb + lc;
  const bf16_t* pan = An + (long)lr * lda + lc;
  const bf16_t* pbn = Bn + (long)lr * ldb + lc;
#define GEMM_GLOAD_(S, PA, PB, ko)                            \
  S##a0 = *(const uint4*)(PA + (ko));                      \
  S##a1 = *(const uint4*)(PA + 32 * lda + (ko));           \
  S##a2 = *(const uint4*)(PA + 64 * lda + (ko));           \
  S##a3 = *(const uint4*)(PA + 96 * lda + (ko));           \
  S##b0 = *(const uint4*)(PB + (ko));                      \
  S##b1 = *(const uint4*)(PB + 32 * ldb + (ko));           \
  S##b2 = *(const uint4*)(PB + 64 * ldb + (ko));           \
  S##b3 = *(const uint4*)(PB + 96 * ldb + (ko));
#define GEMM_GLOAD(S, ko) GEMM_GLOAD_(S, pa, pb, ko)
#define GEMM_GLOADN(S, ko) GEMM_GLOAD_(S, pan, pbn, ko)
#define GEMM_LSTORE(S, buf)                                                                      \
  { bf16_t* wa = sbase + (buf) * GEMM_BUF + lr * LDSS + lc; bf16_t* wb = wa + 128 * LDSS;         \
    *(uint4*)(wa) = S##a0; *(uint4*)(wa + 32 * LDSS) = S##a1; *(uint4*)(wa + 64 * LDSS) = S##a2; *(uint4*)(wa + 96 * LDSS) = S##a3; \
    *(uint4*)(wb) = S##b0; *(uint4*)(wb + 32 * LDSS) = S##b1; *(uint4*)(wb + 64 * LDSS) = S##b2; *(uint4*)(wb + 96 * LDSS) = S##b3; }
#define GEMM_COMPUTE(buf)                                                                         \
  { __builtin_amdgcn_s_setprio(1); const bf16_t* ra = sbase + (buf) * GEMM_BUF + (wm * 64 + (lane & 31)) * LDSS + (lane >> 5) * 8; \
    const bf16_t* rb = sbase + (buf) * GEMM_BUF + 128 * LDSS + (wn * 64 + (lane & 31)) * LDSS + (lane >> 5) * 8; \
    _Pragma("unroll") for (int kk = 0; kk < 4; ++kk) {                                            \
      const bf16x8 af0 = *(const bf16x8*)(ra + kk * 16), af1 = *(const bf16x8*)(ra + 32 * LDSS + kk * 16); \
      const bf16x8 bf0 = *(const bf16x8*)(rb + kk * 16), bf1 = *(const bf16x8*)(rb + 32 * LDSS + kk * 16); \
      acc[0][0] = __builtin_amdgcn_mfma_f32_32x32x16_bf16(af0, bf0, acc[0][0], 0, 0, 0);         \
      acc[0][1] = __builtin_amdgcn_mfma_f32_32x32x16_bf16(af0, bf1, acc[0][1], 0, 0, 0);         \
      acc[1][0] = __builtin_amdgcn_mfma_f32_32x32x16_bf16(af1, bf0, acc[1][0], 0, 0, 0);         \
      acc[1][1] = __builtin_amdgcn_mfma_f32_32x32x16_bf16(af1, bf1, acc[1][1], 0, 0, 0);         \
    } __builtin_amdgcn_s_setprio(0); }
  const int nk = K >> 6;
  const bool hasn = (An != nullptr);
  if (!preloaded) {
    GEMM_GLOAD(x, 0)
    if (nk > 1) { GEMM_GLOAD(y, 64) }
  }
  __syncthreads();
  GEMM_LSTORE(x, 0)
  if (nk > 2) { GEMM_GLOAD(x, 128) }
  __syncthreads();
  for (int kt = 0; kt < nk; kt += 2) {
    GEMM_COMPUTE(0)
    if (kt + 1 < nk) { GEMM_LSTORE(y, 1) }
    if (kt + 3 < nk) { GEMM_GLOAD(y, (kt + 3) * 64) }
    else if (hasn && kt + 3 == nk + 1) { GEMM_GLOADN(y, 64) }
    __syncthreads();
    if (kt + 1 < nk) {
      GEMM_COMPUTE(1)
      if (kt + 2 < nk) { GEMM_LSTORE(x, 0) }
      if (kt + 4 < nk) { GEMM_GLOAD(x, (kt + 4) * 64) }
      else if (hasn && kt + 4 == nk) { GEMM_GLOADN(x, 0) }
      __syncthreads();
    }
  }
}

__device__ __forceinline__ void gemm_tile_h(const bf16_t* __restrict__ A, long lda, const bf16_t* __restrict__ B, long ldb,
                                            int K, bf16_t* sbase, f32x16 (&acc)[2], const int tid) {
  const int lane = tid & 63, wave = tid >> 6;
  const int wm = wave >> 1, wn = wave & 1;
  const int lr = tid >> 3, lc = (tid & 7) * 8;
#pragma unroll
  for (int i = 0; i < 2; ++i)
#pragma unroll
    for (int r = 0; r < 16; ++r) acc[i][r] = 0.f;
  const bf16_t* pa = A + (long)lr * lda + lc;
  const bf16_t* pb = B + (long)lr * ldb + lc;
  uint4 xa0, xa1, xa2, xa3, xb0, xb1;
  uint4 ya0, ya1, ya2, ya3, yb0, yb1;
#define GEMMH_GLOAD(S, ko)                                 \
  S##a0 = *(const uint4*)(pa + (ko));                      \
  S##a1 = *(const uint4*)(pa + 32 * lda + (ko));           \
  S##a2 = *(const uint4*)(pa + 64 * lda + (ko));           \
  S##a3 = *(const uint4*)(pa + 96 * lda + (ko));           \
  S##b0 = *(const uint4*)(pb + (ko));                      \
  S##b1 = *(const uint4*)(pb + 32 * ldb + (ko));
#define GEMMH_LSTORE(S, buf)                                                                     \
  { bf16_t* wa = sbase + (buf) * GEMM_BUF + lr * LDSS + lc; bf16_t* wb = wa + 128 * LDSS;         \
    *(uint4*)(wa) = S##a0; *(uint4*)(wa + 32 * LDSS) = S##a1; *(uint4*)(wa + 64 * LDSS) = S##a2; *(uint4*)(wa + 96 * LDSS) = S##a3; \
    *(uint4*)(wb) = S##b0; *(uint4*)(wb + 32 * LDSS) = S##b1; }
#define GEMMH_COMPUTE(buf)                                                                        \
  { const bf16_t* ra = sbase + (buf) * GEMM_BUF + (wm * 64 + (lane & 31)) * LDSS + (lane >> 5) * 8; \
    const bf16_t* rb = sbase + (buf) * GEMM_BUF + 128 * LDSS + (wn * 32 + (lane & 31)) * LDSS + (lane >> 5) * 8; \
    _Pragma("unroll") for (int kk = 0; kk < 4; ++kk) {                                            \
      const bf16x8 af0 = *(const bf16x8*)(ra + kk * 16), af1 = *(const bf16x8*)(ra + 32 * LDSS + kk * 16); \
      const bf16x8 bf0 = *(const bf16x8*)(rb + kk * 16);                                          \
      acc[0] = __builtin_amdgcn_mfma_f32_32x32x16_bf16(af0, bf0, acc[0], 0, 0, 0);               \
      acc[1] = __builtin_amdgcn_mfma_f32_32x32x16_bf16(af1, bf0, acc[1], 0, 0, 0);               \
    } }
  const int nk = K >> 6;
  GEMMH_GLOAD(x, 0)
  if (nk > 1) { GEMMH_GLOAD(y, 64) }
  __syncthreads();
  GEMMH_LSTORE(x, 0)
  if (nk > 2) { GEMMH_GLOAD(x, 128) }
  __syncthreads();
  for (int kt = 0; kt < nk; kt += 2) {
    if (kt + 1 < nk) { GEMMH_LSTORE(y, 1) }
    if (kt + 3 < nk) { GEMMH_GLOAD(y, (kt + 3) * 64) }
    GEMMH_COMPUTE(0)
    __syncthreads();
    if (kt + 1 < nk) {
      if (kt + 2 < nk) { GEMMH_LSTORE(x, 0) }
      if (kt + 4 < nk) { GEMMH_GLOAD(x, (kt + 4) * 64) }
      GEMMH_COMPUTE(1)
      __syncthreads();
    }
  }
}

#define EPI_BEGIN_(ROWEXPR)                                                        \
  {                                                                                \
    const int e_lane = tid & 63, e_wave = tid >> 6;                                \
    const int e_wm = e_wave >> 1, e_wn = e_wave & 1;                               \
    _Pragma("unroll") for (int e_i = 0; e_i < 2; ++e_i)                            \
    _Pragma("unroll") for (int e_j = 0; e_j < 2; ++e_j)                            \
    _Pragma("unroll") for (int e_r = 0; e_r < 16; ++e_r) {                         \
      const int row = ROWEXPR;                                                     \
      const int col = e_wn * 64 + e_j * 32 + (e_lane & 31);                        \
      const float val = acc[e_i][e_j][e_r];
#define EPI_BEGIN EPI_BEGIN_(e_wm * 64 + e_i * 32 + 8 * (e_r >> 2) + 4 * (e_lane >> 5) + (e_r & 3))
#define EPI_BEGIN_OPQ EPI_BEGIN_(opq(e_wm * 64 + e_i * 32 + 8 * (e_r >> 2) + 4 * (e_lane >> 5)) + (e_r & 3))
#define EPI_END }}
#define EPIS_BEGIN                                                                 \
  {                                                                                \
    const int e_lane = tid & 63, e_wave = tid >> 6;                                \
    const int e_rowl = (e_wave >> 1) * 64 + 4 * (e_lane >> 5);                     \
    const int e_coll = (e_wave & 1) * 64 + (e_lane & 31);                          \
    _Pragma("unroll") for (int e_i = 0; e_i < 2; ++e_i)                            \
    _Pragma("unroll") for (int e_j = 0; e_j < 2; ++e_j)                            \
    _Pragma("unroll") for (int e_r = 0; e_r < 16; ++e_r) {                         \
      const int e_rowu = e_i * 32 + 8 * (e_r >> 2) + (e_r & 3);                    \
      const int e_colu = e_j * 32;                                                 \
      const float val = acc[e_i][e_j][e_r];

__device__ __forceinline__ int tok_which(int t) { return t < NCTX ? 0 : 1 + ((t - NCTX) >> 11); }

static __device__ __forceinline__ void p0_mod(const Params& p, char* smem) {
  const int tid = opaque_tid(); const int bid = opaque_bid(); (void)tid; (void)bid;
  float* sc = (float*)smem;
  float* red = sc + 3 * 1024;
  for (int it = first_item(0); it < 192; it += gridDim.x) {
    __syncthreads();
    for (int i = tid; i < 3 * 1024; i += NTHR) {
      const int w = i >> 10, d = i & 1023;
      sc[i] = siluf((w == 0) ? p.c_ctx[d] : p.c[(w - 1) * 1024 + d]);
    }
    __syncthreads();
    const int l = it / 48, e0 = (it % 48) * 64;
    const int col = tid & 63, dq = tid >> 6;
    float a0 = 0.f, a1 = 0.f, a2 = 0.f;
    const float* wp = p.mod_w + ((long)l * 1024 + dq * 256) * 3072 + e0 + col;
    for (int db = 0; db < 256; db += 16) {
      float wv[16];
#pragma unroll
      for (int d = 0; d < 16; ++d) wv[d] = wp[(long)(db + d) * 3072];
#pragma unroll
      for (int d = 0; d < 16; ++d) {
        a0 += sc[dq * 256 + db + d] * wv[d];
        a1 += sc[1024 + dq * 256 + db + d] * wv[d];
        a2 += sc[2048 + dq * 256 + db + d] * wv[d];
      }
    }
    red[(dq * 3 + 0) * 64 + col] = a0;
    red[(dq * 3 + 1) * 64 + col] = a1;
    red[(dq * 3 + 2) * 64 + col] = a2;
    __syncthreads();
    if (tid < 192) {
      const int w = tid >> 6, cc = tid & 63;
      const float sum = red[(0 * 3 + w) * 64 + cc] + red[(1 * 3 + w) * 64 + cc] + red[(2 * 3 + w) * 64 + cc] + red[(3 * 3 + w) * 64 + cc];
      p.modv[(l * 3 + w) * 3072 + e0 + cc] = sum + p.mod_b[l * 3072 + e0 + cc];
    }
  }
}

static __device__ __forceinline__ void p0_filt_mlp(const Params& p, char* smem) {
  const int tid = opaque_tid(); const int bid = opaque_bid(); (void)tid; (void)bid;
  float* z = (float*)smem;
  float* a = z + 16 * 33;
  float* b = a + 1024;
  float* wS = b + 1024;
  for (int it = first_item(192); it < 144; it += gridDim.x) {
    const int lt = (it < 128) ? 1 : 0;
    const int L = lt ? LLAT : LCTX;
    const int p0 = (lt ? it : (it - 128)) * 16;
    float* a3 = p.filt_a3 + (long)(lt ? 256 : 0) * 64;
    __syncthreads();
    for (int i = tid; i < 16 * 33; i += NTHR) {
      const int pp = i / 33, j = i % 33;
      const int l = p0 + pp;
      const float t = (float)l / (float)(L - 1);
      const float w = TWO_PI * (float)l / (float)L;
      float v;
      if (j == 0) v = t;
      else {
        const int bi = (j - 1) & 15;
        const float f = 1e-4f + (float)bi * ((15.0f - 1e-4f) / 15.0f);
        v = (j <= 16) ? cosf(f * w) : -sinf(f * w);
      }
      z[i] = v;
    }
    const int n = opq(tid & 63), pg = opq(tid >> 6);
    const float fr = p.hy_freq[n];
    for (int i = tid; i < 2112; i += NTHR) wS[i] = p.hy_w1[i];
    __syncthreads();
    {
      float acc[4];
#pragma unroll
      for (int q = 0; q < 4; ++q) acc[q] = p.hy_b1[n];
#pragma unroll 3
      for (int jn = 0; jn < 33; ++jn) {
        const float w = wS[jn * 64 + n];
#pragma unroll
        for (int q = 0; q < 4; ++q) acc[q] += z[(pg * 4 + q) * 33 + jn] * w;
      }
#pragma unroll
      for (int q = 0; q < 4; ++q) a[(pg * 4 + q) * 64 + n] = sinf(fr * acc[q]);
    }
    __syncthreads();
    for (int i = tid; i < 4096; i += NTHR) wS[i] = p.hy_w2[i];
    __syncthreads();
    {
      float acc[4];
#pragma unroll
      for (int q = 0; q < 4; ++q) acc[q] = p.hy_b2[n];
#pragma unroll 4
      for (int jn = 0; jn < 64; ++jn) {
        const float w = wS[jn * 64 + n];
#pragma unroll
        for (int q = 0; q < 4; ++q) acc[q] += a[(pg * 4 + q) * 64 + jn] * w;
      }
#pragma unroll
      for (int q = 0; q < 4; ++q) b[(pg * 4 + q) * 64 + n] = sinf(fr * acc[q]);
    }
    __syncthreads();
    for (int i = tid; i < 4096; i += NTHR) wS[i] = p.hy_w3[i];
    __syncthreads();
    {
      float acc[4];
#pragma unroll
      for (int q = 0; q < 4; ++q) acc[q] = p.hy_b3[n];
#pragma unroll 4
      for (int jn = 0; jn < 64; ++jn) {
        const float w = wS[jn * 64 + n];
#pragma unroll
        for (int q = 0; q < 4; ++q) acc[q] += b[(pg * 4 + q) * 64 + jn] * w;
      }
#pragma unroll
      for (int q = 0; q < 4; ++q) a3[(long)(p0 + pg * 4 + q) * 64 + n] = sinf(fr * acc[q]);
    }
  }
}

static __device__ __forceinline__ void phase_filt_main(const Params& p, char* smem) {
  const int tid = opaque_tid(); const int bid = opaque_bid(); (void)tid; (void)bid;
  float* a = (float*)smem;
  const float dmin = -3.0701134573253945f;
  const float dmax = -15.350567286626973f;
  for (int it = bid; it < 36 * 16; it += gridDim.x) {
    const int pc = it >> 4, cb = it & 15;
    const int lt = (pc < 32) ? 1 : 0;
    const int L = lt ? LLAT : LCTX;
    const int p0 = (lt ? pc : (pc - 32)) * 64;
    bf16_t* filt = lt ? p.filt_lat : p.filt_ctx;
    const float* a3 = p.filt_a3 + ((long)(lt ? 256 : 0) + p0) * 64;
    __syncthreads();
    for (int i = tid; i < 1024; i += NTHR) ((float4*)a)[i] = ((const float4*)a3)[i];
    const int cidx = cb * 256 + opq(tid);
    float w4[64];
#pragma unroll
    for (int k = 0; k < 64; ++k) w4[k] = p.hy_w4[k * 4096 + cidx];
    __syncthreads();
    const int ch = cidx & 1023, od = cidx >> 10, order = od >> 1, dir = od & 1;
    const float delta = fabsf(dmin + (float)ch * ((dmax - dmin) / 1023.0f));
    bf16_t* dst = filt + ((long)(order * 1024 + ch)) * (2 * L);
#pragma unroll 1
    for (int pp = 0; pp < 64; ++pp) {
      const float4* ap = (const float4*)(a + pp * 64);
      float acc = 0.f;
#pragma unroll
      for (int k4 = 0; k4 < 16; ++k4) {
        const float4 av = ap[k4];
        acc += av.x * w4[4 * k4 + 0] + av.y * w4[4 * k4 + 1] + av.z * w4[4 * k4 + 2] + av.w * w4[4 * k4 + 3];
      }
      const int l = p0 + pp;
      const float t = (float)l / (float)(L - 1);
      const float v = acc * expf(-t * delta);
      if (dir == 0) dst[L - 1 - l] = f2bf(v);
      else { if (l == 0) dst[2 * L - 1] = 0; else dst[L - 1 + l] = f2bf(v); }
    }
  }
}

static __device__ __forceinline__ void p0_tables(const Params& p, char* smem) {
  const int tid = opaque_tid(); const int bid = opaque_bid(); (void)tid; (void)bid;
  float2* T = (float2*)smem;
  __syncthreads();
  for (int m = tid; m < 2048; m += NTHR) {
    float sv, cv;
    sincosf(TWO_PI * (float)m / 2048.0f, &sv, &cv);
    T[m] = make_float2(cv, sv);
  }
  __syncthreads();
  const int n_items = 64 + 64 + 4096;
  for (int it = first_item(320); it < n_items; it += gridDim.x) {
    unsigned short vals[8];
    if (it < 64) {
#pragma unroll
      for (int q = 0; q < 8; ++q) {
        const int e = it * 2048 + tid * 8 + q;
        const int m = e >> 8, k = e & 255;
        const int cs = m >> 8, co = m & 255;
        const float2 tv = T[((co * k) & 255) * 8];
        vals[q] = f2bf(cs ? tv.y : tv.x);
      }
      *(uint4*)(p.tabA + (long)it * 2048 + tid * 8) = make_uint4(vals[0] | (vals[1] << 16), vals[2] | (vals[3] << 16), vals[4] | (vals[5] << 16), vals[6] | (vals[7] << 16));
    } else if (it < 128) {
#pragma unroll
      for (int q = 0; q < 8; ++q) {
        const int e = (it - 64) * 2048 + tid * 8 + q;
        const int pp = e >> 9, k = e & 511;
        const int cs = k >> 8, pi = k & 255;
        const float2 tv = T[((pp * pi) & 255) * 8];
        vals[q] = f2bf(cs ? -tv.y : tv.x);
      }
      *(uint4*)(p.tabB_ctx + (long)(it - 64) * 2048 + tid * 8) = make_uint4(vals[0] | (vals[1] << 16), vals[2] | (vals[3] << 16), vals[4] | (vals[5] << 16), vals[6] | (vals[7] << 16));
    } else {
#pragma unroll
      for (int q = 0; q < 8; ++q) {
        const int e = (it - 128) * 2048 + tid * 8 + q;
        const int pp = e >> 12, k = e & 4095;
        const int cs = k >> 11, pi = k & 2047;
        const float2 tv = T[(pp * pi) & 2047];
        vals[q] = f2bf(cs ? -tv.y : tv.x);
      }
      *(uint4*)(p.tabB_lat + (long)(it - 128) * 2048 + tid * 8) = make_uint4(vals[0] | (vals[1] << 16), vals[2] | (vals[3] << 16), vals[4] | (vals[5] << 16), vals[6] | (vals[7] << 16));
    }
  }
}

static __device__ __forceinline__ void wt_transpose_items(const float* __restrict__ W, bf16_t* __restrict__ Wt, int N, int Npad, int off, char* smem) {
  const int tid = opaque_tid(); const int bid = opaque_bid(); (void)tid; (void)bid;
  float* t = (float*)smem;
  const int ntn = Npad / 64;
  const int n_items = ntn * 16;
  for (int it = first_item(off); it < n_items; it += gridDim.x) {
    const int nt = it % ntn, kt = it / ntn;
    const int n0 = nt * 64, k0 = kt * 64;
    __syncthreads();
    const int tx = tid & 63, ty = tid >> 6;
    float v[16];
#pragma unroll
    for (int i = 0; i < 16; ++i) v[i] = (n0 + tx < N) ? W[(long)(k0 + ty + 4 * i) * N + n0 + tx] : 0.f;
#pragma unroll
    for (int i = 0; i < 16; ++i) t[tx * 65 + ty + 4 * i] = v[i];
    __syncthreads();
    const int r = tid >> 2, cch = (tid & 3) * 16;
    unsigned w[8];
#pragma unroll
    for (int q = 0; q < 8; ++q) w[q] = pk2(t[r * 65 + cch + 2 * q], t[r * 65 + cch + 2 * q + 1]);
    uint4* dp = (uint4*)(Wt + (long)(n0 + r) * 1024 + k0 + cch);
    dp[0] = make_uint4(w[0], w[1], w[2], w[3]);
    dp[1] = make_uint4(w[4], w[5], w[6], w[7]);
  }
}

static __device__ __forceinline__ void p0_weights(const Params& p, char* smem) {
  wt_transpose_items(p.gla_w_in, p.wt_gla_in0, 3104, 3200, 0, smem);
  wt_transpose_items(p.gla_w_out, p.wt_gla_out0, 1024, 1024, 288, smem);
  wt_transpose_items(p.fn_w_in, p.wt_fn_in, 2048, 2048, 32, smem);
  wt_transpose_items(p.fn_w_out, p.wt_fn_out, 1024, 1024, 32, smem);
  wt_transpose_items(p.hy_w_in, p.wt_hy_in, 4096, 4096, 288, smem);
  wt_transpose_items(p.hy_w_out, p.wt_hy_out, 1024, 1024, 288, smem);
  wt_transpose_items(p.gla_w_in + (long)1024 * 3104, p.wt_gla_in1, 3104, 3200, 32, smem);
  wt_transpose_items(p.gla_w_out + (long)1024 * 1024, p.wt_gla_out1, 1024, 1024, 288, smem);
}

static __device__ __forceinline__ void phase_norm(const Params& p, int layer) {
  const int tid = opaque_tid(); const int bid = opaque_bid(); (void)tid; (void)bid;
  const int lane = tid & 63, wave = tid >> 6;
  const float* g = p.norm_g + layer * 1024;
  const int stride = gridDim.x * 4;
  for (int t0 = bid * 4 + wave; t0 < NTOK; t0 += 2 * stride) {
    float4 v[2][4];
#pragma unroll
    for (int u = 0; u < 2; ++u) {
      const int t = t0 + u * stride;
      if (t < NTOK) {
        const float* xr;
        if (layer == 0) xr = (t < NCTX) ? (p.x_prompt + (long)t * 1024) : (p.x_sample + (long)(t - NCTX) * 1024);
        else xr = p.out + (long)t * 1024;
#pragma unroll
        for (int i = 0; i < 4; ++i) v[u][i] = *(const float4*)(xr + lane * 4 + 256 * i);
      }
    }
#pragma unroll
    for (int u = 0; u < 2; ++u) {
      const int t = t0 + u * stride;
      if (t < NTOK) {
        const float* mv = p.modv + (layer * 3 + tok_which(t)) * 3072;
        float ss = 0.f;
#pragma unroll
        for (int i = 0; i < 4; ++i) ss += v[u][i].x * v[u][i].x + v[u][i].y * v[u][i].y + v[u][i].z * v[u][i].z + v[u][i].w * v[u][i].w;
#pragma unroll
        for (int o = 32; o > 0; o >>= 1) ss += __shfl_xor(ss, o);
        const float rstd = rsqrtf(ss * (1.0f / 1024.0f) + 1e-6f);
#pragma unroll
        for (int i = 0; i < 4; ++i) {
          const int c0 = lane * 4 + 256 * i;
          const float4 gg = *(const float4*)(g + c0);
          const float4 sh = *(const float4*)(mv + c0);
          const float4 sc = *(const float4*)(mv + 1024 + c0);
          uint2 w;
          w.x = pk2((v[u][i].x * rstd * gg.x) * (1.f + sc.x) + sh.x, (v[u][i].y * rstd * gg.y) * (1.f + sc.y) + sh.y);
          w.y = pk2((v[u][i].z * rstd * gg.z) * (1.f + sc.z) + sh.z, (v[u][i].w * rstd * gg.w) * (1.f + sc.w) + sh.w);
          *(uint2*)(p.h + (long)t * 1024 + c0) = w;
        }
      }
    }
  }
}

static __device__ __forceinline__ void phase_final_norm(const Params& p) {
  const int tid = opaque_tid(); const int bid = opaque_bid(); (void)tid; (void)bid;
  const int lane = tid & 63, wave = tid >> 6;
  for (int t = bid * 4 + wave; t < NTOK; t += gridDim.x * 4) {
    float* xr = p.out + (long)t * 1024;
    float4 v[4];
    float ss = 0.f;
#pragma unroll
    for (int i = 0; i < 4; ++i) {
      v[i] = *(const float4*)(xr + lane * 4 + 256 * i);
      ss += v[i].x * v[i].x + v[i].y * v[i].y + v[i].z * v[i].z + v[i].w * v[i].w;
    }
#pragma unroll
    for (int o = 32; o > 0; o >>= 1) ss += __shfl_xor(ss, o);
    const float rstd = rsqrtf(ss * (1.0f / 1024.0f) + 1e-6f);
#pragma unroll
    for (int i = 0; i < 4; ++i) {
      const int c0 = lane * 4 + 256 * i;
      float4 gg = *(const float4*)(p.final_norm_g + c0);
      float4 o;
      o.x = v[i].x * rstd * gg.x; o.y = v[i].y * rstd * gg.y; o.z = v[i].z * rstd * gg.z; o.w = v[i].w * rstd * gg.w;
      *(float4*)(xr + c0) = o;
    }
  }
}

static __device__ __forceinline__ void phase_gemm_out(const Params& p, int layer, const bf16_t* Wt, char* smem, const int dummy) {
  const int tid = opaque_tid(); const int bid = opaque_bid(); (void)tid; (void)bid;
  bf16_t* sA = (bf16_t*)smem;
  GEMM_STAGE_DECL
  float* outp = dummy ? (float*)p.big : p.out;
  const int n_tiles = 96 * 8;
  const int nfull = (gridDim.x == 512) ? 512 : n_tiles;
  const int n_items = nfull + 2 * (n_tiles - nfull);
  for (int item = bid; item < n_items; item += gridDim.x) {
    const bool is_half = item >= nfull;
    const int tile = is_half ? nfull + ((item - nfull) >> 1) : item;
    const int hsel = is_half ? ((item - nfull) & 1) : 0;
    const int mt = tile % 96, nt = tile / 96;
    const int m0 = mt * 128, n0 = nt * 128 + hsel * 64;
    const float* gate = p.modv + (layer * 3 + tok_which(m0)) * 3072 + 2048;
    const float* xsrc = (layer == 0) ? ((m0 < NCTX) ? p.x_prompt : (p.x_sample - (long)NCTX * 1024)) : p.out;
    const int e_lane = tid & 63, e_wave = tid >> 6;
    const int e_wm = e_wave >> 1, e_wn = e_wave & 1;
    if (!is_half) {
      f32x16 acc[2][2];
      gemm_tile(p.h + (long)m0 * 1024, 1024, Wt + (long)n0 * 1024, 1024, 1024, sA, acc, tid, GEMM_STAGE_ARGS, false, nullptr, nullptr);
      float xo[2][2][16];
      const float* xb = xsrc + (long)m0 * 1024 + n0;
      float* ob = outp + (long)m0 * 1024 + n0;
      EPIS_BEGIN
        (void)val;
        const unsigned lo = 4u * (unsigned)(e_rowl * 1024 + e_coll);
        xo[e_i][e_j][e_r] = *(const float*)((const char*)(xb + e_rowu * 1024 + e_colu) + lo);
      EPI_END
      EPIS_BEGIN
        const unsigned lo = 4u * (unsigned)(e_rowl * 1024 + e_coll);
        *(float*)((char*)(ob + e_rowu * 1024 + e_colu) + lo) = xo[e_i][e_j][e_r] + gate[n0 + e_coll + e_colu] * val;
      EPI_END
    } else {
      f32x16 acc[2];
      gemm_tile_h(p.h + (long)m0 * 1024, 1024, Wt + (long)n0 * 1024, 1024, 1024, sA, acc, tid);
      const int n = n0 + e_wn * 32 + (e_lane & 31);
      const float gn = gate[n];
      float xo[2][16];
#pragma unroll
      for (int e_i = 0; e_i < 2; ++e_i)
#pragma unroll
        for (int e_r = 0; e_r < 16; ++e_r) {
          const int row = e_wm * 64 + e_i * 32 + 8 * (e_r >> 2) + 4 * (e_lane >> 5) + (e_r & 3);
          xo[e_i][e_r] = xsrc[(long)(m0 + row) * 1024 + n];
        }
#pragma unroll
      for (int e_i = 0; e_i < 2; ++e_i)
#pragma unroll
        for (int e_r = 0; e_r < 16; ++e_r) {
          const int row = e_wm * 64 + e_i * 32 + 8 * (e_r >> 2) + 4 * (e_lane >> 5) + (e_r & 3);
          outp[(long)(m0 + row) * 1024 + n] = xo[e_i][e_r] + gn * acc[e_i][e_r];
        }
    }
  }
}

#define GLA_PROJ(p) ((p).big)
#define GLA_LR(p) ((float*)((p).big + (long)NTOK * 3072))
#define GLA_OF(p) ((p).big + (long)NTOK * 3072 + (long)NTOK * 64)
#define GLA_OB(p) (GLA_OF(p) + (long)NTOK * 1024)

static __device__ __forceinline__ void phase_gla_in(const Params& p, const bf16_t* Wt, char* smem) {
  const int tid = opaque_tid(); const int bid = opaque_bid(); (void)tid; (void)bid;
  bf16_t* sA = (bf16_t*)smem;
  GEMM_STAGE_DECL
  bool pre = false;
  bf16_t* proj = GLA_PROJ(p);
  float* lrb = GLA_LR(p);
  const int n_tiles = 96 * 25;
  for (int tile = bid; tile < n_tiles; tile += gridDim.x) {
    const int mt = tile % 96, nt = tile / 96;
    const int m0 = mt * 128, n0 = nt * 128;
    f32x16 acc[2][2];
    {
      const int tn = tile + gridDim.x;
      const bool hn = tn < n_tiles;
      gemm_tile(p.h + (long)m0 * 1024, 1024, Wt + (long)n0 * 1024, 1024, 1024, sA, acc, tid, GEMM_STAGE_ARGS, pre,
                hn ? p.h + (long)((tn % 96) * 128) * 1024 : nullptr, hn ? Wt + (long)((tn / 96) * 128) * 1024 : nullptr);
      pre = hn;
    }
    if (n0 < 3072) {
      bf16_t* tb = proj + (long)m0 * 3072 + n0;
      EPIS_BEGIN
        const unsigned lo = 2u * (unsigned)(e_rowl * 3072 + e_coll);
        *(bf16_t*)((char*)(tb + e_rowu * 3072 + e_colu) + lo) = f2bf(val);
      EPI_END
    } else {
      EPI_BEGIN
        const int t = m0 + row, n = n0 + col;
        if (n < 3104) lrb[(long)t * 32 + (n - 3072)] = val;
      EPI_END
    }
  }
}

#define GLA_IMG1(p) (GLA_OB(p) + (long)NTOK * 1024)
#define GLA_BLAST(p) ((float*)(GLA_IMG1(p) + (long)NTOK * 1024))
static __device__ __forceinline__ void phase_gla_prep(const Params& p, int j, char* smem, const int dummy) {
  const int tid = opaque_tid(); const int bid = opaque_bid();
  float* sLR = (float*)smem;
  bf16_t* proj = GLA_PROJ(p);
  bf16_t* img1 = GLA_IMG1(p);
  const float* lrb = GLA_LR(p);
  float* blast = GLA_BLAST(p);
  const int dkl = tid & 127, dir = tid >> 7;
  for (int it = bid; it < (NTOK / 32) * 4; it += gridDim.x) {
    const int tb = it >> 2, hh = it & 3;
    const int dk = hh * 128 + dkl;
    __syncthreads();
    ((float4*)sLR)[tid] = *(const float4*)(lrb + ((long)tb * 32 + (tid >> 3)) * 32 + (tid & 7) * 4);
    unsigned rqk[32];
    {
      const bf16_t* rp = proj + ((long)tb * 32 + (dir ? 31 : 0)) * 3072 + dk;
      const long rstep = dir ? -3072 : 3072;
#pragma unroll
      for (int s_ = 0; s_ < 32; ++s_) {
        rqk[s_] = (unsigned)rp[0] | ((unsigned)rp[512] << 16);
        rp += rstep;
      }
    }
    float wd[16];
    const float* wdp = p.gla_w_dec + ((long)(j * 2 + dir) * 16) * 512 + dk;
#pragma unroll
    for (int r = 0; r < 16; ++r) wd[r] = wdp[r * 512];
    const float bd = p.gla_b_dec[(j * 2 + dir) * 512 + dk];
    __syncthreads();
    float* sC = sLR + 1024 + tid;
    float run = 0.f;
#pragma unroll
    for (int s_ = 0; s_ < 32; ++s_) {
      const int pos = dir ? 31 - s_ : s_;
      const float4* lp = (const float4*)(sLR + pos * 32 + dir * 16);
      float lg = bd;
#pragma unroll
      for (int r4 = 0; r4 < 4; ++r4) {
        const float4 l4 = lp[r4];
        lg += l4.x * wd[r4 * 4 + 0] + l4.y * wd[r4 * 4 + 1] + l4.z * wd[r4 * 4 + 2] + l4.w * wd[r4 * 4 + 3];
      }
      run += (fminf(lg, 0.f) - __logf(1.f + __expf(-fabsf(lg)))) * (1.0f / 16.0f);
      sC[s_ * 256] = run;
    }
    blast[((long)dir * (NTOK / 32) + tb) * 512 + dk] = run;
    bf16_t* dst = dir ? img1 : (dummy ? GLA_OF(p) : proj);
    const long dstr = (dir || dummy) ? 1024 : 3072;
#pragma unroll
    for (int s_ = 0; s_ < 32; ++s_) {
      const int pos = dir ? 31 - s_ : s_;
      const long tok = (long)tb * 32 + pos;
      const float e0 = sC[s_ * 256] - run;
      const float qs = 0.08838834764831845f * __expf(fminf(e0, 80.f));
      const float ks = __expf(-e0);
      const unsigned o2 = pk2(bf2f((bf16_t)(rqk[s_] & 0xffffu)) * qs, bf2f((bf16_t)(rqk[s_] >> 16)) * ks);
      dst[tok * dstr + dk] = (bf16_t)(o2 & 0xffffu);
      dst[tok * dstr + 512 + dk] = (bf16_t)(o2 >> 16);
    }
  }
}

#define QS 136
#define TS 40
#define GLA_SLOC(p) ((float*)((p).h))
#define GLA_GSEG(p) (((float*)((p).h)) + (long)128 * 128 * 256)
__device__ __forceinline__ int crow_(int r, int hf) { return (r & 3) + 8 * (r >> 2) + 4 * hf; }
__device__ __forceinline__ bf16x8 pack8(const f32x16& x, const int st) {
  union { unsigned u[4]; bf16x8 v; } c;
  c.u[0] = pk2(x[8 * st + 0], x[8 * st + 1]);
  c.u[1] = pk2(x[8 * st + 2], x[8 * st + 3]);
  c.u[2] = pk2(x[8 * st + 4], x[8 * st + 5]);
  c.u[3] = pk2(x[8 * st + 6], x[8 * st + 7]);
  return c.v;
}
__device__ __forceinline__ bf16x8 ld2x8(const bf16_t* a, const bf16_t* b) {
  union { uint2 d[2]; bf16x8 v; } c;
  c.d[0] = *(const uint2*)a;
  c.d[1] = *(const uint2*)b;
  return c.v;
}

__device__ __forceinline__ unsigned kimg_off(unsigned row, unsigned ch) { return 256u * row + 16u * (ch ^ (((row & 3u) << 2) | ((row >> 2) & 3u))); }
__device__ __forceinline__ unsigned kimg_tr(unsigned lane, unsigned c, unsigned ks, unsigned t) {
  const unsigned h = lane >> 5, blk = (lane >> 4) & 1u, q = (lane & 15u) >> 2, pp = lane & 3u;
  return kimg_off(16u * ks + 8u * h + 4u * t + q, 4u * c + 2u * blk + (pp >> 1)) + 8u * (pp & 1u);
}
typedef short s16x4 __attribute__((ext_vector_type(4)));

static __device__ __forceinline__ void phase_gla_scan(const Params& p, int j, int pass, char* smem) {
  const int tid = opaque_tid(); const int bid = opaque_bid();
  bf16_t* sQ = (bf16_t*)smem;
  bf16_t* sK = sQ + 32 * QS;
  bf16_t* sKT = sK + 32 * QS;
  bf16_t* sVT = sKT + 128 * TS;
  float* sDec = (float*)(sVT + 64 * TS);
  float* sOp = sDec + 128;
  const bf16_t* proj = GLA_PROJ(p);
  const bf16_t* img1 = GLA_IMG1(p);
  const float* blast = GLA_BLAST(p);
  float* sloc = GLA_SLOC(p);
  float* gseg = GLA_GSEG(p);
  const int lane = tid & 63, wave = tid >> 6, l31 = lane & 31, hf = lane >> 5;
  const int kh = wave >> 1, nt = wave & 1;
  const int dk0 = (tid & 63) * 2, sg = tid >> 6;
  const int vp = tid & 31, sg8 = tid >> 5;
  const int irow = tid >> 3, icol = (tid & 7) * 16;
  char* sKb = (char*)sK;
  const unsigned kbase = (unsigned)(size_t)sKb;
  const unsigned ktr0 = kbase + kimg_tr(lane, 2 * kh + 0, 0, 0), ktr1 = kbase + kimg_tr(lane, 2 * kh + 0, 0, 1);
  const unsigned ktr2 = kbase + kimg_tr(lane, 2 * kh + 0, 1, 0), ktr3 = kbase + kimg_tr(lane, 2 * kh + 0, 1, 1);
  const unsigned ktr4 = kbase + kimg_tr(lane, 2 * kh + 1, 0, 0), ktr5 = kbase + kimg_tr(lane, 2 * kh + 1, 0, 1);
  const unsigned ktr6 = kbase + kimg_tr(lane, 2 * kh + 1, 1, 0), ktr7 = kbase + kimg_tr(lane, 2 * kh + 1, 1, 1);
  const int n_items = pass == 0 ? (1024 + 512) : 512;
  for (int it = bid; it < n_items; it += gridDim.x) {
    int b, hh, dir, vt, sidx, L, tbase;
    bool full, lat;
    if (pass == 0 && it < 1024) {
      vt = it & 3; const int combo = it >> 2;
      dir = combo & 1; hh = (combo >> 1) & 3; b = combo >> 3; sidx = 0;
      L = LCTX; tbase = b * LCTX; full = true; lat = false;
    } else {
      const int i2 = pass == 0 ? it - 1024 : it;
      vt = i2 & 3; const int combo = i2 >> 2;
      dir = combo & 1; hh = (combo >> 1) & 3; sidx = (combo >> 3) & 7; b = combo >> 6;
      L = LLAT; tbase = NCTX + b * LLAT; full = (pass == 1); lat = true;
    }
    bf16_t* obuf = dir ? GLA_OB(p) : GLA_OF(p);
    const bf16_t* ib = dir ? img1 : proj;
    const long istr = dir ? 1024 : 3072;
    const int vcol = vt * 64 + nt * 32 + l31;
    const int sgn = dir ? -1 : 1;
    const int offq = (dir ? 31 - irow : irow) * (int)istr + icol;
    const int offv = (dir ? 31 - 4 * sg8 : 4 * sg8) * 3072 + 2 * vp;
    const int offo = (dir ? 31 - 4 * hf : 4 * hf) * 1024 + vcol;
    f32x16 S0, S1;
    if (pass == 0) {
#pragma unroll
      for (int r = 0; r < 16; ++r) { S0[r] = 0.f; S1[r] = 0.f; }
    } else {
      const int rb = opq((kh * 64 + 4 * hf) * 256 + vcol);
      const float* s0 = p.state_gla + ((((long)b * 2 + j) * 2 + dir) * 4 + hh) * 128 * 256 + rb;
#pragma unroll
      for (int r = 0; r < 16; ++r) {
        S0[r] = s0[crow_(r, 0) * 256];
        S1[r] = s0[(32 + crow_(r, 0)) * 256];
      }
      for (int i = 0; i < sidx; ++i) {
        const int ci = (((b * 8 + i) * 4 + hh) * 2 + dir);
        const float* sl = sloc + (long)ci * 128 * 256 + rb;
        const float* gs = gseg + ci * 128 + opq(kh * 64 + 4 * hf);
#pragma unroll
        for (int r = 0; r < 16; ++r) {
          S0[r] = __expf(gs[crow_(r, 0)]) * S0[r] + sl[crow_(r, 0) * 256];
          S1[r] = __expf(gs[32 + crow_(r, 0)]) * S1[r] + sl[(32 + crow_(r, 0)) * 256];
        }
      }
    }
    float gsum = 0.f;
    struct GlaRegs { uint4 q0, q1, k0, k1; unsigned v[4]; float bl; };
    GlaRegs RA, RB;
    RA.q0 = make_uint4(0u, 0u, 0u, 0u); RA.q1 = RA.q0; RB.q0 = RA.q0; RB.q1 = RA.q0; RA.bl = 0.f; RB.bl = 0.f;
#define GLA_TOK(u_) ((long)tbase + (dir ? (L - 1 - (u_)) : (u_)))
    auto gla_load = [&](const int c_, GlaRegs& R) __attribute__((always_inline)) {
      const int ub = sidx * 256 + c_ * 32;
      const long TB = (long)tbase + (dir ? (L - 32 - ub) : ub);
      {
        const bf16_t* rp = ib + TB * istr + hh * 128 + offq;
        if (full) { R.q0 = *(const uint4*)rp; R.q1 = *(const uint4*)(rp + 8); }
        R.k0 = *(const uint4*)(rp + 512); R.k1 = *(const uint4*)(rp + 520);
      }
#pragma unroll
      for (int i = 0; i < 4; ++i) {
        const bf16_t* uv = proj + (TB + sgn * i) * 3072 + 1024 + hh * 256 + vt * 64;
        R.v[i] = *(const unsigned*)(uv + offv);
      }
      if (tid < 128) R.bl = blast[((long)dir * (NTOK / 32) + (TB >> 5)) * 512 + hh * 128 + tid];
    };
    auto gla_chunk = [&](const int c, GlaRegs& R) __attribute__((always_inline)) {
      if (full) {
        *(uint4*)(sQ + irow * QS + icol) = R.q0; *(uint4*)(sQ + irow * QS + icol + 8) = R.q1;
      }
      *(uint4*)(sKb + kimg_off(irow, 2 * (tid & 7))) = R.k0;
      *(uint4*)(sKb + kimg_off(irow, 2 * (tid & 7) + 1)) = R.k1;
      {
        uint2 pe, po;
        pe.x = (R.v[0] & 0xffffu) | (R.v[1] << 16); po.x = (R.v[0] >> 16) | (R.v[1] & 0xffff0000u);
        pe.y = (R.v[2] & 0xffffu) | (R.v[3] << 16); po.y = (R.v[2] >> 16) | (R.v[3] & 0xffff0000u);
        *(uint2*)(sVT + (2 * vp) * TS + 4 * sg8) = pe;
        *(uint2*)(sVT + (2 * vp + 1) * TS + 4 * sg8) = po;
      }
      if (tid < 128) { sDec[tid] = __expf(R.bl); gsum += R.bl; }
      __syncthreads();
      if (c + 2 < 8) gla_load(c + 2, R);
#pragma unroll
      for (int r = 0; r < 16; ++r) {
        S0[r] *= sDec[kh * 64 + crow_(r, hf)];
        S1[r] *= sDec[kh * 64 + 32 + crow_(r, hf)];
      }
      f32x16 o;
      if (full) {
        f32x16 att;
#pragma unroll
        for (int r = 0; r < 16; ++r) { att[r] = 0.f; o[r] = 0.f; }
#pragma unroll
        for (int kk = 0; kk < 8; ++kk) {
          const bf16x8 a = *(const bf16x8*)(sKb + kimg_off(l31, 2 * kk + hf));
          const bf16x8 bq = *(const bf16x8*)(sQ + l31 * QS + kk * 16 + 8 * hf);
          att = __builtin_amdgcn_mfma_f32_32x32x16_bf16(a, bq, att, 0, 0, 0);
        }
#pragma unroll
        for (int r = 0; r < 16; ++r) if (crow_(r, hf) > l31) att[r] = 0.f;
#pragma unroll
        for (int st = 0; st < 2; ++st) {
          {
            const bf16_t* qa = sQ + l31 * QS + kh * 64 + 16 * st + 4 * hf;
            o = __builtin_amdgcn_mfma_f32_32x32x16_bf16(ld2x8(qa, qa + 8), pack8(S0, st), o, 0, 0, 0);
          }
          {
            const bf16_t* qa = sQ + l31 * QS + kh * 64 + 32 + 16 * st + 4 * hf;
            o = __builtin_amdgcn_mfma_f32_32x32x16_bf16(ld2x8(qa, qa + 8), pack8(S1, st), o, 0, 0, 0);
          }
        }
        {
          const bf16x8 pa0 = pack8(att, 0), pa1 = pack8(att, 1);
          const bf16x8 pa = kh ? pa1 : pa0;
          const bf16_t* va = sVT + (nt * 32 + l31) * TS + 16 * kh + 4 * hf;
          o = __builtin_amdgcn_mfma_f32_32x32x16_bf16(pa, ld2x8(va, va + 8), o, 0, 0, 0);
        }
        if (kh == 1) {
#pragma unroll
          for (int r = 0; r < 16; ++r) sOp[(nt * 32 + crow_(r, hf)) * 32 + l31] = o[r];
        }
      }
      {
        s16x4 t00, t01, t02, t03, t10, t11, t12, t13;
        asm volatile(
            "ds_read_b64_tr_b16 %0, %8\n\t"
            "ds_read_b64_tr_b16 %1, %9\n\t"
            "ds_read_b64_tr_b16 %2, %10\n\t"
            "ds_read_b64_tr_b16 %3, %11\n\t"
            "ds_read_b64_tr_b16 %4, %12\n\t"
            "ds_read_b64_tr_b16 %5, %13\n\t"
            "ds_read_b64_tr_b16 %6, %14\n\t"
            "ds_read_b64_tr_b16 %7, %15\n\t"
            "s_waitcnt lgkmcnt(0)"
            : "=&v"(t00), "=&v"(t01), "=&v"(t02), "=&v"(t03), "=&v"(t10), "=&v"(t11), "=&v"(t12), "=&v"(t13)
            : "v"(ktr0), "v"(ktr1), "v"(ktr2), "v"(ktr3), "v"(ktr4), "v"(ktr5), "v"(ktr6), "v"(ktr7)
            : "memory");
        const bf16x8 a00 = __builtin_shufflevector(t00, t01, 0, 1, 2, 3, 4, 5, 6, 7);
        const bf16x8 a01 = __builtin_shufflevector(t02, t03, 0, 1, 2, 3, 4, 5, 6, 7);
        const bf16x8 a10 = __builtin_shufflevector(t10, t11, 0, 1, 2, 3, 4, 5, 6, 7);
        const bf16x8 a11 = __builtin_shufflevector(t12, t13, 0, 1, 2, 3, 4, 5, 6, 7);
        const bf16x8 bv0 = *(const bf16x8*)(sVT + (nt * 32 + l31) * TS + 8 * hf);
        const bf16x8 bv1 = *(const bf16x8*)(sVT + (nt * 32 + l31) * TS + 16 + 8 * hf);
        S0 = __builtin_amdgcn_mfma_f32_32x32x16_bf16(a00, bv0, S0, 0, 0, 0);
        S1 = __builtin_amdgcn_mfma_f32_32x32x16_bf16(a10, bv0, S1, 0, 0, 0);
        S0 = __builtin_amdgcn_mfma_f32_32x32x16_bf16(a01, bv1, S0, 0, 0, 0);
        S1 = __builtin_amdgcn_mfma_f32_32x32x16_bf16(a11, bv1, S1, 0, 0, 0);
      }
      __syncthreads();
      if (full && kh == 0) {
        const int ub = sidx * 256 + c * 32;
        const long TB = (long)tbase + (dir ? (L - 32 - ub) : ub);
#pragma unroll
        for (int r = 0; r < 16; ++r) {
          const int srow = crow_(r, hf);
          const float val = o[r] + sOp[(nt * 32 + srow) * 32 + l31];
          bf16_t* uo = obuf + (TB + sgn * (8 * (r >> 2) + (r & 3))) * 1024 + hh * 256;
          uo[offo] = f2bf(val);
        }
      }
    };
    gla_load(0, RA);
    gla_load(1, RB);
    __syncthreads();
    for (int c = 0; c < 8; c += 2) {
      gla_chunk(c, RA);
      gla_chunk(c + 1, RB);
    }
    const int rbo = opq((kh * 64 + 4 * hf) * 256 + vcol);
    if (!lat) {
      float* so = p.out + (long)NTOK * 1024 + ((((long)b * 2 + j) * 2 + dir) * 4 + hh) * 128 * 256 + rbo;
#pragma unroll
      for (int r = 0; r < 16; ++r) {
        so[crow_(r, 0) * 256] = S0[r];
        so[(32 + crow_(r, 0)) * 256] = S1[r];
      }
    } else if (pass == 0) {
      const int ci = (((b * 8 + sidx) * 4 + hh) * 2 + dir);
      float* sl = sloc + (long)ci * 128 * 256 + rbo;
#pragma unroll
      for (int r = 0; r < 16; ++r) {
        sl[crow_(r, 0) * 256] = S0[r];
        sl[(32 + crow_(r, 0)) * 256] = S1[r];
      }
      if (vt == 0 && tid < 128) gseg[ci * 128 + tid] = gsum;
    }
    __syncthreads();
  }
}

static __device__ __forceinline__ void phase_gla_combine(const Params& p, int j) {
  const int tid = opaque_tid(); const int bid = opaque_bid(); (void)tid; (void)bid;
  const int lane = tid & 63, wave = tid >> 6;
  const bf16_t* proj = GLA_PROJ(p);
  const bf16_t* of = GLA_OF(p);
  const bf16_t* ob = GLA_OB(p);
  const float* og = p.gla_onorm_g + j * 256;
  const float4 gg = *(const float4*)(og + lane * 4);
  const int stride = gridDim.x * 4;
  for (int it0 = bid * 4 + wave; it0 < NTOK * 4; it0 += 4 * stride) {
    uint2 a[4], b[4], r[4];
#pragma unroll
    for (int u = 0; u < 4; ++u) {
      const int it = it0 + u * stride;
      if (it < NTOK * 4) {
        const int t = it >> 2, hh = it & 3;
        const long base = (long)t * 1024 + hh * 256 + lane * 4;
        a[u] = *(const uint2*)(of + base);
        b[u] = *(const uint2*)(ob + base);
        r[u] = *(const uint2*)(proj + (long)t * 3072 + 2048 + hh * 256 + lane * 4);
      }
    }
#pragma unroll
    for (int u = 0; u < 4; ++u) {
      const int it = it0 + u * stride;
      if (it < NTOK * 4) {
        const int t = it >> 2, hh = it & 3;
        const long base = (long)t * 1024 + hh * 256 + lane * 4;
        float o[4];
        o[0] = bf2f(a[u].x & 0xffff) + bf2f(b[u].x & 0xffff);
        o[1] = bf2f(a[u].x >> 16) + bf2f(b[u].x >> 16);
        o[2] = bf2f(a[u].y & 0xffff) + bf2f(b[u].y & 0xffff);
        o[3] = bf2f(a[u].y >> 16) + bf2f(b[u].y >> 16);
        const float r0 = bf2f(r[u].x & 0xffff), r1 = bf2f(r[u].x >> 16), r2 = bf2f(r[u].y & 0xffff), r3 = bf2f(r[u].y >> 16);
        float ss = o[0] * o[0] + o[1] * o[1] + o[2] * o[2] + o[3] * o[3];
#pragma unroll
        for (int sft = 32; sft > 0; sft >>= 1) ss += __shfl_xor(ss, sft);
        const float rstd = rsqrtf(ss * (1.0f / 256.0f) + 1e-6f);
        uint2 w;
        w.x = pk2(o[0] * rstd * gg.x * siluf(r0), o[1] * rstd * gg.y * siluf(r1));
        w.y = pk2(o[2] * rstd * gg.z * siluf(r2), o[3] * rstd * gg.w * siluf(r3));
        *(uint2*)(p.h + base) = w;
      }
    }
  }
}

#define FN_PROJ(p) ((p).big)
#define FN_XCS_CTX(p) ((p).big + (long)NTOK * 2048)
#define FN_XCS_LAT(p) (FN_XCS_CTX(p) + (long)NCTX * 2048)

static __device__ __forceinline__ void phase_fn_in(const Params& p, char* smem) {
  const int tid = opaque_tid(); const int bid = opaque_bid(); (void)tid; (void)bid;
  bf16_t* sA = (bf16_t*)smem;
  GEMM_STAGE_DECL
  bool pre = false;
  bf16_t* proj = FN_PROJ(p);
  const int n_tiles = 96 * 16;
  for (int tile = bid; tile < n_tiles; tile += gridDim.x) {
    const int mt = tile % 96, nt = tile / 96;
    const int m0 = mt * 128, n0 = nt * 128;
    f32x16 acc[2][2];
    {
      const int tn = tile + gridDim.x;
      const bool hn = tn < n_tiles;
      gemm_tile(p.h + (long)m0 * 1024, 1024, p.wt_fn_in + (long)n0 * 1024, 1024, 1024, sA, acc, tid, GEMM_STAGE_ARGS, pre,
                hn ? p.h + (long)((tn % 96) * 128) * 1024 : nullptr, hn ? p.wt_fn_in + (long)((tn / 96) * 128) * 1024 : nullptr);
      pre = hn;
    }
    {
      bf16_t* tb = proj + (long)m0 * 2048 + n0;
      EPIS_BEGIN
        const unsigned lo = 2u * (unsigned)(e_rowl * 2048 + e_coll);
        *(bf16_t*)((char*)(tb + e_rowu * 2048 + e_colu) + lo) = f2bf(val);
      EPI_END
    }
  }
}

static __device__ __forceinline__ void phase_fn_a(const Params& p, char* smem) {
  const int tid = opaque_tid(); const int bid = opaque_bid(); (void)tid; (void)bid;
  bf16_t* sA = (bf16_t*)smem;
  GEMM_STAGE_DECL
  const bf16_t* proj = FN_PROJ(p);
  const int n_tiles = 4 * 96 * 4;
  for (int tile = bid; tile < n_tiles; tile += gridDim.x) {
    const int mt = tile & 3, g = (tile >> 2) & 3, tt = tile >> 4;
    const int m0 = mt * 128, t0 = tt * 128;
    f32x16 acc[2][2];
    gemm_tile(p.tabA + (long)m0 * 256, 256, proj + (long)t0 * 2048 + g * 256, 2048, 256, sA, acc, tid, GEMM_STAGE_ARGS, false, nullptr, nullptr);
    const bool lat = t0 >= NCTX;
    const int L = lat ? LLAT : LCTX;
    const int b = lat ? ((t0 - NCTX) >> 11) : (t0 >> 8);
    const int pos0 = lat ? ((t0 - NCTX) & 2047) : (t0 & 255);
    bf16_t* dst = lat ? FN_XCS_LAT(p) : FN_XCS_CTX(p);
    EPI_BEGIN_OPQ
      const int m = m0 + row;
      const int cs = m >> 8, co = m & 255;
      dst[((long)((b * 4 + g) * 256 + co)) * (2 * L) + cs * L + pos0 + col] = f2bf(val);
    EPI_END
  }
}

static __device__ __forceinline__ void phase_fn_b(const Params& p, char* smem) {
  const int tid = opaque_tid(); const int bid = opaque_bid(); (void)tid; (void)bid;
  bf16_t* sA = (bf16_t*)smem;
  GEMM_STAGE_DECL
  const bf16_t* proj = FN_PROJ(p);
  const int n_lat = 2 * 4 * 16 * 2;
  const int n_ctx = 32 * 4 * 2 * 2;
  const bool rebal = (gridDim.x == 512);
  for (int it_ = bid; it_ < (rebal ? 1024 : n_lat + n_ctx); it_ += gridDim.x) {
    int tile = it_;
    if (rebal) {
      if (it_ < 512) tile = (it_ < 256) ? it_ : (256 + 2 * (it_ - 256));
      else tile = (it_ - 512 < 256) ? -1 : (256 + 2 * (it_ - 768) + 1);
      if (tile < 0) continue;
    }
    int b, g, mt, nt, L, tbase;
    const bf16_t *tab, *xcs;
    if (tile < n_lat) {
      nt = tile & 1; mt = (tile >> 1) & 15; g = (tile >> 5) & 3; b = tile >> 7;
      L = LLAT; tbase = NCTX + b * LLAT; tab = p.tabB_lat; xcs = FN_XCS_LAT(p);
    } else {
      int t2 = tile - n_lat;
      nt = t2 & 1; mt = (t2 >> 1) & 1; g = (t2 >> 2) & 3; b = t2 >> 4;
      L = LCTX; tbase = b * LCTX; tab = p.tabB_ctx; xcs = FN_XCS_CTX(p);
    }
    const int m0 = mt * 128, n0 = nt * 128;
    f32x16 acc[2][2];
    gemm_tile(tab + (long)m0 * (2 * L), 2 * L, xcs + ((long)((b * 4 + g) * 256 + n0)) * (2 * L), 2 * L, 2 * L, sA, acc, tid, GEMM_STAGE_ARGS, false, nullptr, nullptr);
    const float scale = rsqrtf((float)L * 256.0f);
    {
      const int e_lane = tid & 63, e_wave = tid >> 6;
      const int e_wm = e_wave >> 1, e_wn = e_wave & 1;
#pragma unroll
      for (int e_i = 0; e_i < 2; ++e_i)
#pragma unroll
        for (int e_j = 0; e_j < 2; ++e_j) {
          const int rowb = opq(e_wm * 64 + e_i * 32 + 4 * (e_lane >> 5));
          const int ch = g * 256 + n0 + e_wn * 64 + e_j * 32 + (e_lane & 31);
          bf16_t zr[16];
#pragma unroll
          for (int e_r = 0; e_r < 16; ++e_r) zr[e_r] = proj[(long)(tbase + m0 + rowb + 8 * (e_r >> 2) + (e_r & 3)) * 2048 + 1024 + ch];
#pragma unroll
          for (int e_r = 0; e_r < 16; ++e_r)
            p.h[(long)(tbase + m0 + rowb + 8 * (e_r >> 2) + (e_r & 3)) * 1024 + ch] = f2bf(acc[e_i][e_j][e_r] * scale * siluf(bf2f(zr[e_r])));
        }
    }
  }
}

#define HY_UT(p) ((p).big)
#define HY_YT(p) ((p).big + (long)4096 * NTOK)

static __device__ __forceinline__ void phase_hy_in(const Params& p, char* smem) {
  const int tid = opaque_tid(); const int bid = opaque_bid(); (void)tid; (void)bid;
  bf16_t* sA = (bf16_t*)smem;
  GEMM_STAGE_DECL
  bool pre = false;
  bf16_t* uT = HY_UT(p);
  const int n_tiles = 32 * 96;
  for (int tile = bid; tile < n_tiles; tile += gridDim.x) {
    const int nt = tile % 96, mt = tile / 96;
    const int m0 = mt * 128, n0 = nt * 128;
    f32x16 acc[2][2];
    {
      const int tn = tile + gridDim.x;
      const bool hn = tn < n_tiles;
      gemm_tile(p.wt_hy_in + (long)m0 * 1024, 1024, p.h + (long)n0 * 1024, 1024, 1024, sA, acc, tid, GEMM_STAGE_ARGS, pre,
                hn ? p.wt_hy_in + (long)((tn / 96) * 128) * 1024 : nullptr, hn ? p.h + (long)((tn % 96) * 128) * 1024 : nullptr);
      pre = hn;
    }
    {
      bf16_t* tb = uT + (long)m0 * NTOK + n0;
      EPIS_BEGIN
        const unsigned lo = 2u * (unsigned)(e_rowl * NTOK + e_coll);
        *(bf16_t*)((char*)(tb + e_rowu * NTOK + e_colu) + lo) = f2bf(val);
      EPI_END
    }
  }
}

__device__ __forceinline__ int upad(int pos) { return pos + 8 * (pos >> 5); }
static __device__ __forceinline__ void phase_hy_conv(const Params& p, char* smem) {
  const int tid = opaque_tid(); const int bid = opaque_bid();
  bf16_t* sU = (bf16_t*)smem;
  bf16_t* sX1 = sU + 10240;
  bf16_t* sX2 = sX1 + 8192;
  bf16_t* sR0 = sX2 + 8192;
  bf16_t* sR1 = sR0 + 4128;
  const bf16_t* uT = HY_UT(p);
  bf16_t* yT = HY_YT(p);
  const int lane = tid & 63, wave = tid >> 6, l31 = lane & 31, hf = lane >> 5;
  const int n_items = 1024 + 1024;
  for (int it = bid; it < n_items; it += gridDim.x) {
    const bool lat = it < 1024;
    const int ch = lat ? it : (it - 1024);
    const int L = lat ? LLAT : LCTX;
    const int nb = L >> 5;
    const int tok0 = lat ? NCTX : 0;
    const int ntw = lat ? 1 : 2;
    const bf16_t* filt = (lat ? p.filt_lat : p.filt_ctx);
    __syncthreads();
    for (int pc = 0; pc < ntw; ++pc) {
      const int p0 = pc * 4096 + tid * 16;
      const bool has_l = (p0 & (L - 1)) != 0, has_r = ((p0 + 16) & (L - 1)) != 0;
#pragma unroll
      for (int g = 0; g < 3; ++g) {
        const int f = g * 1024 + ch;
        const bf16_t* row = uT + (long)f * NTOK + tok0 + p0;
        const uint4 v0 = *(const uint4*)row, v1 = *(const uint4*)(row + 8);
        float e[18];
        e[0] = has_l ? bf2f(row[-1]) : 0.f;
        e[17] = has_r ? bf2f(row[16]) : 0.f;
        const unsigned vv[8] = {v0.x, v0.y, v0.z, v0.w, v1.x, v1.y, v1.z, v1.w};
#pragma unroll
        for (int q = 0; q < 8; ++q) { e[1 + 2 * q] = bf2f((bf16_t)(vv[q] & 0xffffu)); e[2 + 2 * q] = bf2f((bf16_t)(vv[q] >> 16)); }
        const float w0 = p.hy_conv_w[f], w1 = p.hy_conv_w[3072 + f], w2 = p.hy_conv_w[6144 + f], bb = p.hy_conv_b[f];
        unsigned o[8];
#pragma unroll
        for (int q = 0; q < 8; ++q) {
          const float a0 = e[2 * q] * w0 + e[2 * q + 1] * w1 + e[2 * q + 2] * w2 + bb;
          const float a1 = e[2 * q + 1] * w0 + e[2 * q + 2] * w1 + e[2 * q + 3] * w2 + bb;
          o[q] = pk2(a0, a1);
        }
        bf16_t* dst = (g == 0) ? (sX1 + p0) : (g == 1) ? (sX2 + p0) : (sU + upad(p0));
        uint4 o0, o1;
        o0.x = o[0]; o0.y = o[1]; o0.z = o[2]; o0.w = o[3];
        o1.x = o[4]; o1.y = o[5]; o1.z = o[6]; o1.w = o[7];
        *(uint4*)dst = o0;
        *(uint4*)(dst + 8) = o1;
      }
    }
    const int xa = (L - 1) - l31 + 8 * hf;
    const bf16_t* Rp = (xa & 1) ? (sR1 - 1) : sR0;
    float y1r[2][16];
    for (int order = 0; order < 2; ++order) {
      const bf16_t* fsrc = filt + ((long)(order * 1024 + ch)) * (2 * L);
      for (int x8 = tid; x8 < (2 * L) / 8; x8 += NTHR) {
        const uint4 v = *(const uint4*)(fsrc + 8 * x8);
        *(uint4*)(sR0 + 8 * x8) = v;
        const unsigned vv[4] = {v.x, v.y, v.z, v.w};
#pragma unroll
        for (int q = 0; q < 4; ++q) {
          if (8 * x8 + 2 * q >= 1) sR1[8 * x8 + 2 * q - 1] = (bf16_t)(vv[q] & 0xffffu);
          sR1[8 * x8 + 2 * q] = (bf16_t)(vv[q] >> 16);
        }
      }
      __syncthreads();
      const float dsk = p.hy_d[order * 1024 + ch];
      const bf16_t* gate = order ? sX2 : sX1;
#pragma unroll
      for (int tt = 0; tt < 2; ++tt) {
        if (tt < ntw) {
          int bt, i_blk, dlo, dhi;
          if (lat) { bt = wave >> 1; const int i0 = 32 * (wave & 1); i_blk = i0 + l31; dlo = i0 - 63; dhi = i0 + 31; }
          else { bt = 4 * (2 * wave + tt) + (l31 >> 3); i_blk = l31 & 7; dlo = -7; dhi = 7; }
          const bf16_t* ubase = sU + upad(bt * L);
          const int pos_base = bt * L + 32 * i_blk + 4 * hf;
          f32x16 acc;
#pragma unroll
          for (int r = 0; r < 16; ++r) acc[r] = 0.f;
          for (int d = dlo; d <= dhi; ++d) {
            const int jb = i_blk - d;
            const bool valid = (unsigned)jb < (unsigned)nb;
            const int jc = valid ? jb : 0;
            const bf16_t* bp = ubase + 40 * jc + 8 * hf;
            const unsigned* ap = (const unsigned*)(Rp + (xa - 32 * d));
#pragma unroll
            for (int ks2 = 0; ks2 < 2; ++ks2) {
              union { unsigned u[4]; bf16x8 v; } A;
              A.u[0] = ap[8 * ks2 + 0]; A.u[1] = ap[8 * ks2 + 1]; A.u[2] = ap[8 * ks2 + 2]; A.u[3] = ap[8 * ks2 + 3];
              union { uint4 q; bf16x8 v; } B;
              B.q = *(const uint4*)(bp + 16 * ks2);
              if (!valid) { B.q.x = 0u; B.q.y = 0u; B.q.z = 0u; B.q.w = 0u; }
              acc = __builtin_amdgcn_mfma_f32_32x32x16_bf16(A.v, B.v, acc, 0, 0, 0);
            }
          }
#pragma unroll
          for (int g = 0; g < 4; ++g) {
            const int pos = pos_base + 8 * g;
            const uint2 gg = *(const uint2*)(gate + pos);
            const uint2 uo = *(const uint2*)(sU + upad(pos));
            const float g0 = bf2f((bf16_t)(gg.x & 0xffffu)), g1 = bf2f((bf16_t)(gg.x >> 16)), g2 = bf2f((bf16_t)(gg.y & 0xffffu)), g3 = bf2f((bf16_t)(gg.y >> 16));
            const float u0 = bf2f((bf16_t)(uo.x & 0xffffu)), u1 = bf2f((bf16_t)(uo.x >> 16)), u2 = bf2f((bf16_t)(uo.y & 0xffffu)), u3 = bf2f((bf16_t)(uo.y >> 16));
            y1r[tt][4 * g + 0] = g0 * (acc[4 * g + 0] + dsk * u0);
            y1r[tt][4 * g + 1] = g1 * (acc[4 * g + 1] + dsk * u1);
            y1r[tt][4 * g + 2] = g2 * (acc[4 * g + 2] + dsk * u2);
            y1r[tt][4 * g + 3] = g3 * (acc[4 * g + 3] + dsk * u3);
          }
        }
      }
      __syncthreads();
#pragma unroll
      for (int tt = 0; tt < 2; ++tt) {
        if (tt < ntw) {
          int bt, i_blk;
          if (lat) { bt = wave >> 1; i_blk = 32 * (wave & 1) + l31; }
          else { bt = 4 * (2 * wave + tt) + (l31 >> 3); i_blk = l31 & 7; }
          const int pos_base = bt * L + 32 * i_blk + 4 * hf;
          if (order == 0) {
#pragma unroll
            for (int g = 0; g < 4; ++g) {
              uint2 w;
              w.x = pk2(y1r[tt][4 * g + 0], y1r[tt][4 * g + 1]);
              w.y = pk2(y1r[tt][4 * g + 2], y1r[tt][4 * g + 3]);
              *(uint2*)(sU + upad(pos_base + 8 * g)) = w;
            }
          } else {
            uint2 zz[4];
#pragma unroll
            for (int g = 0; g < 4; ++g) zz[g] = *(const uint2*)(uT + (long)(3072 + ch) * NTOK + tok0 + pos_base + 8 * g);
#pragma unroll
            for (int g = 0; g < 4; ++g) {
              const long gp = (long)tok0 + pos_base + 8 * g;
              const float z0 = bf2f((bf16_t)(zz[g].x & 0xffffu)), z1 = bf2f((bf16_t)(zz[g].x >> 16)), z2 = bf2f((bf16_t)(zz[g].y & 0xffffu)), z3 = bf2f((bf16_t)(zz[g].y >> 16));
              uint2 w;
              w.x = pk2(y1r[tt][4 * g + 0] * siluf(z0), y1r[tt][4 * g + 1] * siluf(z1));
              w.y = pk2(y1r[tt][4 * g + 2] * siluf(z2), y1r[tt][4 * g + 3] * siluf(z3));
              *(uint2*)(yT + (long)ch * NTOK + gp) = w;
            }
          }
        }
      }
    }
  }
}

static __device__ __forceinline__ void phase_hy_transpose(const Params& p, char* smem) {
  const int tid = opaque_tid(); const int bid = opaque_bid(); (void)tid; (void)bid;
  bf16_t* t = (bf16_t*)smem;
  const bf16_t* yT = HY_YT(p);
  const int n_items = 16 * 192;
  for (int it = bid; it < n_items; it += gridDim.x) {
    const int ct = it & 15, tt = it >> 4;
    const int c0 = ct * 64, t0 = tt * 64;
    __syncthreads();
    for (int i = tid; i < 64 * 64; i += NTHR) {
      int r = i >> 6, cc = i & 63;
      t[cc * 66 + r] = yT[(long)(c0 + r) * NTOK + t0 + cc];
    }
    __syncthreads();
    for (int i = tid; i < 64 * 64; i += NTHR) {
      int r = i >> 6, cc = i & 63;
      p.h[(long)(t0 + r) * 1024 + c0 + cc] = t[r * 66 + cc];
    }
  }
}

#define XB_TMO      128
#define XB_XCNT(j)  (256  + 64 * (j))
#define XB_XSUB(j)  (1280 + 64 * (j))
#define XB_XGEN(j)  (2304 + 64 * (j))
#define XB_TOP      3328
#define XB_TOPGEN   3392
#define XCD_BAR_WORDS 3456
#define XB_SPIN_CAP (1u << 18)
#define LAS __attribute__((address_space(3)))
__device__ __forceinline__ unsigned xb_ld(unsigned* p)              { return __hip_atomic_load(p, __ATOMIC_RELAXED, __HIP_MEMORY_SCOPE_AGENT); }
__device__ __forceinline__ unsigned xb_add(unsigned* p, unsigned v) { return __hip_atomic_fetch_add(p, v, __ATOMIC_RELAXED, __HIP_MEMORY_SCOPE_AGENT); }
__device__ __forceinline__ unsigned xb_xcc_id() { return (unsigned)__builtin_amdgcn_s_getreg((3 << 11) | 20) & 0xFu; }
#define XB_SPIN(cond, bar) do { unsigned _sp = 0; while (cond) { __builtin_amdgcn_s_sleep(1); \
    if ((++_sp & 255u) == 0u) { if (xb_ld(&(bar)[XB_TMO])) break; if (_sp > XB_SPIN_CAP) { atomicAdd(&(bar)[XB_TMO], 1u); break; } } } } while (0)
struct XcdBarrier { unsigned* bar; unsigned x; volatile LAS unsigned* st; };
__device__ __forceinline__ XcdBarrier xcd_barrier_post(unsigned* bar, volatile LAS unsigned* st) {
    XcdBarrier b; b.bar = bar; b.x = xb_xcc_id(); b.st = st;
    if (threadIdx.x == 0) (void)xb_add(&bar[XB_XCNT(b.x)], 1u);
    return b;
}
__device__ __forceinline__ void xcd_barrier_complete(unsigned* bar, unsigned x, unsigned& nloc, unsigned& nx) {
    const unsigned G = gridDim.x * gridDim.y * gridDim.z;
    unsigned sum, cnt, mine, sp = 0u;
    for (;;) {
        sum = 0u; cnt = 0u; mine = 0u;
#pragma unroll
        for (unsigned j = 0; j < 16; ++j) { const unsigned c = xb_ld(&bar[XB_XCNT(j)]); sum += c; cnt += (c > 0u) ? 1u : 0u; mine = (j == x) ? c : mine; }
        if (sum == G) break;
        __builtin_amdgcn_s_sleep(1);
        if ((++sp & 255u) == 0u) { if (xb_ld(&bar[XB_TMO])) break; if (sp > XB_SPIN_CAP) { atomicAdd(&bar[XB_TMO], 1u); break; } }
    }
    nloc = mine > 0u ? mine : 1u; nx = cnt > 0u ? cnt : 1u;
}
__device__ __forceinline__ void xcd_barrier(const XcdBarrier& b) {
    asm volatile("s_waitcnt vmcnt(0)" ::: "memory");
    __syncthreads();
    if (threadIdx.x == 0) {
        unsigned* bar = b.bar;
        __builtin_amdgcn_s_waitcnt(0);
        unsigned nloc = b.st[0], nx = b.st[1];
        if (nloc == 0u) { xcd_barrier_complete(bar, b.x, nloc, nx); b.st[0] = nloc; b.st[1] = nx; }
        const unsigned old = xb_add(&bar[XB_XSUB(b.x)], 1u);
        const unsigned gen = old / nloc;
        if (old + 1u == (gen + 1u) * nloc) {
            __builtin_amdgcn_fence(__ATOMIC_RELEASE, "agent");
            asm volatile("s_waitcnt vmcnt(0)" ::: "memory");
            const unsigned og = xb_add(&bar[XB_TOP], 1u);
            const unsigned tg = og / nx;
            if (og + 1u == (tg + 1u) * nx) xb_add(&bar[XB_TOPGEN], 1u);
            else XB_SPIN(xb_ld(&bar[XB_TOPGEN]) == tg, bar);
            __builtin_amdgcn_fence(__ATOMIC_ACQUIRE, "agent");
            xb_add(&bar[XB_XGEN(b.x)], 1u);
            asm volatile("s_waitcnt vmcnt(0)" ::: "memory");
        } else {
            XB_SPIN(xb_ld(&bar[XB_XGEN(b.x)]) == gen, bar);
            __builtin_amdgcn_fence(__ATOMIC_ACQUIRE, "agent");
            asm volatile("s_waitcnt vmcnt(0)" ::: "memory");
        }
    }
    __syncthreads();
}

__global__ void __launch_bounds__(NTHR, 2) mega(Params p) {
  cg::grid_group grid = cg::this_grid();
  __shared__ __attribute__((aligned(16))) char smem[SMEM_BYTES];
  __shared__ uint4 xb_words;
  if (threadIdx.x == 0) xb_words = make_uint4(0u, 0u, 0u, 0u);
  __syncthreads();
  const XcdBarrier xb = xcd_barrier_post(p.bar, (volatile LAS unsigned*)&xb_words);
  if (p.use_cg) grid.sync();
#define GSYNC() xcd_barrier(xb)
#define REP(id) for (int rep##id = 0; rep##id < (PROBE == (id) ? 3 : 1); ++rep##id)
  REP(19) {
  REP(1) { p0_mod(p, smem); }
  REP(2) { p0_filt_mlp(p, smem); }
  REP(3) { p0_tables(p, smem); }
  REP(4) { p0_weights(p, smem); }
  GSYNC();
  }
  if (PROBE == 5) { for (int rep = 0; rep < 40; ++rep) GSYNC(); }
  for (int layer = 0; layer < 4; ++layer) {
    const int kind = layer % 3, j = layer / 3;
    REP(6) { phase_norm(p, layer); if (layer == 1) phase_filt_main(p, smem); GSYNC(); }
    const bf16_t* wt_out;
    if (kind == 0) {
      REP(7) { phase_gla_in(p, j ? p.wt_gla_in1 : p.wt_gla_in0, smem); GSYNC(); }
      for (int rep = 0; rep < (PROBE == 17 ? 3 : 1); ++rep) { phase_gla_prep(p, j, smem, rep + 1 < (PROBE == 17 ? 3 : 1)); GSYNC(); }
      REP(8) { phase_gla_scan(p, j, 0, smem); GSYNC(); }
      REP(9) { phase_gla_scan(p, j, 1, smem); GSYNC(); }
      REP(10) { phase_gla_combine(p, j); GSYNC(); }
      wt_out = j ? p.wt_gla_out1 : p.wt_gla_out0;
    } else if (kind == 1) {
      REP(11) { phase_fn_in(p, smem); GSYNC(); }
      REP(12) { phase_fn_a(p, smem); GSYNC(); }
      REP(13) { phase_fn_b(p, smem); GSYNC(); }
      wt_out = p.wt_fn_out;
    } else {
      REP(14) { phase_hy_in(p, smem); GSYNC(); }
      REP(15) { phase_hy_conv(p, smem); GSYNC(); }
      REP(16) { phase_hy_transpose(p, smem); GSYNC(); }
      wt_out = p.wt_hy_out;
    }
    for (int rep = 0; rep < (PROBE == 18 ? 3 : 1); ++rep) { phase_gemm_out(p, layer, wt_out, smem, rep + 1 < (PROBE == 18 ? 3 : 1)); GSYNC(); }
  }
  phase_final_norm(p);
}

static inline size_t align_up(size_t x) { return (x + 255) & ~(size_t)255; }

extern "C" void kernel_launch(void* const* d_in, const int* in_sizes, int n_in, void* d_out,
                              int out_size, void* d_ws, size_t ws_size, hipStream_t stream) {
  static int grid_blocks = 0;
  if (!grid_blocks) {
    int dev = 0, cus = 0, per_cu = 0;
    hipGetDevice(&dev);
    hipDeviceGetAttribute(&cus, hipDeviceAttributeMultiprocessorCount, dev);
    hipOccupancyMaxActiveBlocksPerMultiprocessor(&per_cu, mega, NTHR, 0);
    if (per_cu > 2) per_cu = 2;
    if (per_cu < 1) per_cu = 1;
    grid_blocks = cus * per_cu;
  }
  Params p{};
  const float* const* in = (const float* const*)d_in;
  p.x_prompt = in[0]; p.x_sample = in[1]; p.state_gla = in[2]; p.c = in[3]; p.c_ctx = in[4];
  p.mod_w = in[5]; p.mod_b = in[6]; p.norm_g = in[7]; p.final_norm_g = in[8];
  p.gla_w_in = in[9]; p.gla_w_dec = in[10]; p.gla_b_dec = in[11]; p.gla_onorm_g = in[12]; p.gla_w_out = in[13];
  p.fn_w_in = in[14]; p.fn_w_out = in[15];
  p.hy_w_in = in[16]; p.hy_conv_w = in[17]; p.hy_conv_b = in[18];
  p.hy_w1 = in[19]; p.hy_b1 = in[20]; p.hy_w2 = in[21]; p.hy_b2 = in[22]; p.hy_w3 = in[23]; p.hy_b3 = in[24];
  p.hy_w4 = in[25]; p.hy_freq = in[26]; p.hy_d = in[27]; p.hy_w_out = in[28];
  p.out = (float*)d_out;
  char* w = (char*)d_ws;
  size_t off = 0;
  auto take = [&](size_t bytes) { char* r = w + off; off = align_up(off + bytes); return r; };
  p.h = (bf16_t*)take((size_t)NTOK * 1024 * 2);
  p.big = (bf16_t*)take((size_t)156 * 1024 * 1024);
  p.wt_gla_in0 = (bf16_t*)take((size_t)3200 * 1024 * 2);
  p.wt_gla_in1 = (bf16_t*)take((size_t)3200 * 1024 * 2);
  p.wt_gla_out0 = (bf16_t*)take((size_t)1024 * 1024 * 2);
  p.wt_gla_out1 = (bf16_t*)take((size_t)1024 * 1024 * 2);
  p.wt_fn_in = (bf16_t*)take((size_t)2048 * 1024 * 2);
  p.wt_fn_out = (bf16_t*)take((size_t)1024 * 1024 * 2);
  p.wt_hy_in = (bf16_t*)take((size_t)4096 * 1024 * 2);
  p.wt_hy_out = (bf16_t*)take((size_t)1024 * 1024 * 2);
  p.tabA = (bf16_t*)take((size_t)512 * 256 * 2);
  p.tabB_ctx = (bf16_t*)take((size_t)256 * 512 * 2);
  p.tabB_lat = (bf16_t*)take((size_t)2048 * 4096 * 2);
  p.filt_ctx = (bf16_t*)take((size_t)2 * 1024 * 512 * 2);
  p.filt_lat = (bf16_t*)take((size_t)2 * 1024 * 4096 * 2);
  p.filt_a3 = (float*)take((size_t)2304 * 64 * 4);
  p.bar = (unsigned*)take((size_t)XCD_BAR_WORDS * 4 + (size_t)4 * 3 * 3072 * 4);
  p.modv = (float*)(p.bar + XCD_BAR_WORDS);
  p.use_cg = 0; p.pad = 0;
  hipMemsetAsync(p.bar, 0, (size_t)XCD_BAR_WORDS * 4 + (size_t)4 * 3 * 3072 * 4, stream);
  void* args[] = {&p};
  hipError_t e = hipLaunchCooperativeKernel((void*)mega, dim3(grid_blocks), dim3(NTHR), args, 0, stream);
  if (e != hipSuccess) fprintf(stderr, "cooperative launch failed: %s (grid %d, ws %zu need %zu)\n", hipGetErrorString(e), grid_blocks, ws_size, off);
}
```

```cpp
#include <hip/hip_runtime.h>
#include <hip/hip_cooperative_groups.h>
#include <cstdio>
namespace cg = cooperative_groups;

typedef unsigned short bf16_t;
typedef short bf16x8 __attribute__((ext_vector_type(8)));
typedef float f32x16 __attribute__((ext_vector_type(16)));

#ifndef PROBE
#define PROBE 0
#endif
#define NTOK 12288
#define NCTX 8192
#define DM 1024
#define LCTX 256
#define LLAT 2048
#define NTHR 256
#define SMEM_BYTES 73728
#define LDSS 72
#define TWO_PI 6.283185307179586f

struct Params {
  const float *x_prompt, *x_sample, *state_gla, *c, *c_ctx, *mod_w, *mod_b, *norm_g, *final_norm_g;
  const float *gla_w_in, *gla_w_dec, *gla_b_dec, *gla_onorm_g, *gla_w_out;
  const float *fn_w_in, *fn_w_out;
  const float *hy_w_in, *hy_conv_w, *hy_conv_b, *hy_w1, *hy_b1, *hy_w2, *hy_b2, *hy_w3, *hy_b3, *hy_w4, *hy_freq, *hy_d, *hy_w_out;
  float* out;
  bf16_t* h;
  bf16_t* big;
  float* modv;
  bf16_t* wt_gla_in0; bf16_t* wt_gla_in1; bf16_t* wt_gla_out0; bf16_t* wt_gla_out1;
  bf16_t* wt_fn_in; bf16_t* wt_fn_out; bf16_t* wt_hy_in; bf16_t* wt_hy_out;
  bf16_t* tabA; bf16_t* tabB_ctx; bf16_t* tabB_lat;
  bf16_t* filt_ctx; bf16_t* filt_lat;
  float* filt_a3;
  unsigned* bar;
  int use_cg; int pad;
};

typedef __bf16 bf16n2 __attribute__((ext_vector_type(2)));
typedef float f32n2 __attribute__((ext_vector_type(2)));
__device__ __forceinline__ unsigned pk2(float a, float b) {
  f32n2 v = {a, b};
  return __builtin_bit_cast(unsigned, __builtin_convertvector(v, bf16n2));
}
__device__ __forceinline__ bf16_t f2bf(float x) { return (bf16_t)(pk2(x, 0.f) & 0xffffu); }
__device__ __forceinline__ float bf2f(bf16_t b) { return __uint_as_float(((unsigned)b) << 16); }
__device__ __forceinline__ float siluf(float x) { return x / (1.f + expf(-x)); }
__device__ __forceinline__ float logsigf(float x) { return fminf(x, 0.f) - log1pf(expf(-fabsf(x))); }
__device__ __forceinline__ int opaque_tid() { int t = threadIdx.x; asm volatile("" : "+v"(t)); return t; }
__device__ __forceinline__ int opq(int t) { asm volatile("" : "+v"(t)); return t; }
__device__ __forceinline__ int opaque_bid() { int b = blockIdx.x; asm volatile("" : "+s"(b)); return b; }
__device__ __forceinline__ int first_item_(int bid, int off) {
  int G = gridDim.x;
  return (int)((bid + G - (off % G)) % G);
}
#define first_item(off) first_item_(bid, off)

#define GEMM_BUF (2 * 128 * LDSS)
#define GEMM_STAGE_DECL uint4 g_xa0, g_xa1, g_xa2, g_xa3, g_xb0, g_xb1, g_xb2, g_xb3, g_ya0, g_ya1, g_ya2, g_ya3, g_yb0, g_yb1, g_yb2, g_yb3;
#define GEMM_STAGE_ARGS g_xa0, g_xa1, g_xa2, g_xa3, g_xb0, g_xb1, g_xb2, g_xb3, g_ya0, g_ya1, g_ya2, g_ya3, g_yb0, g_yb1, g_yb2, g_yb3
__device__ __forceinline__ void gemm_tile(const bf16_t* __restrict__ A, long lda, const bf16_t* __restrict__ B, long ldb,
                                          int K, bf16_t* sbase, f32x16 (&acc)[2][2], const int tid,
                                          uint4& xa0, uint4& xa1, uint4& xa2, uint4& xa3, uint4& xb0, uint4& xb1, uint4& xb2, uint4& xb3, uint4& ya0, uint4& ya1, uint4& ya2, uint4& ya3, uint4& yb0, uint4& yb1, uint4& yb2, uint4& yb3,
                                          const bool preloaded, const bf16_t* An, const bf16_t* Bn) {
  const int lane = tid & 63, wave = tid >> 6;
  const int wm = wave >> 1, wn = wave & 1;
  const int lr = tid >> 3, lc = (tid & 7) * 8;
#pragma unroll
  for (int i = 0; i < 2; ++i)
#pragma unroll
    for (int j = 0; j < 2; ++j)
#pragma unroll
      for (int r = 0; r < 16; ++r) acc[i][j][r] = 0.f;
  const bf16_t* pa = A + (long)lr * lda + lc;
  const bf16_t* pb = B + (long)lr * ldb + lc;
  const bf16_t* pan = An + (long)lr * lda + lc;
  const bf16_t* pbn = Bn + (long)lr * ldb + lc;
#define GEMM_GLOAD_(S, PA, PB, ko)                            \
  S##a0 = *(const uint4*)(PA + (ko));                      \
  S##a1 = *(const uint4*)(PA + 32 * lda + (ko));           \
  S##a2 = *(const uint4*)(PA + 64 * lda + (ko));           \
  S##a3 = *(const uint4*)(PA + 96 * lda + (ko));           \
  S##b0 = *(const uint4*)(PB + (ko));                      \
  S##b1 = *(const uint4*)(PB + 32 * ldb + (ko));           \
  S##b2 = *(const uint4*)(PB + 64 * ldb + (ko));           \
  S##b3 = *(const uint4*)(PB + 96 * ldb + (ko));
#define GEMM_GLOAD(S, ko) GEMM_GLOAD_(S, pa, pb, ko)
#define GEMM_GLOADN(S, ko) GEMM_GLOAD_(S, pan, pbn, ko)
#define GEMM_LSTORE(S, buf)                                                                      \
  { bf16_t* wa = sbase + (buf) * GEMM_BUF + lr * LDSS + lc; bf16_t* wb = wa + 128 * LDSS;         \
    *(uint4*)(wa) = S##a0; *(uint4*)(wa + 32 * LDSS) = S##a1; *(uint4*)(wa + 64 * LDSS) = S##a2; *(uint4*)(wa + 96 * LDSS) = S##a3; \
    *(uint4*)(wb) = S##b0; *(uint4*)(wb + 32 * LDSS) = S##b1; *(uint4*)(wb + 64 * LDSS) = S##b2; *(uint4*)(wb + 96 * LDSS) = S##b3; }
#define GEMM_COMPUTE(buf)                                                                         \
  { __builtin_amdgcn_s_setprio(1); const bf16_t* ra = sbase + (buf) * GEMM_BUF + (wm * 64 + (lane & 31)) * LDSS + (lane >> 5) * 8; \
    const bf16_t* rb = sbase + (buf) * GEMM_BUF + 128 * LDSS + (wn * 64 + (lane & 31)) * LDSS + (lane >> 5) * 8; \
    _Pragma("unroll") for (int kk = 0; kk < 4; ++kk) {                                            \
      const bf16x8 af0 = *(const bf16x8*)(ra + kk * 16), af1 = *(const bf16x8*)(ra + 32 * LDSS + kk * 16); \
      const bf16x8 bf0 = *(const bf16x8*)(rb + kk * 16), bf1 = *(const bf16x8*)(rb + 32 * LDSS + kk * 16); \
      acc[0][0] = __builtin_amdgcn_mfma_f32_32x32x16_bf16(af0, bf0, acc[0][0], 0, 0, 0);         \
      acc[0][1] = __builtin_amdgcn_mfma_f32_32x32x16_bf16(af0, bf1, acc[0][1], 0, 0, 0);         \
      acc[1][0] = __builtin_amdgcn_mfma_f32_32x32x16_bf16(af1, bf0, acc[1][0], 0, 0, 0);         \
      acc[1][1] = __builtin_amdgcn_mfma_f32_32x32x16_bf16(af1, bf1, acc[1][1], 0, 0, 0);         \
    } __builtin_amdgcn_s_setprio(0); }
  const int nk = K >> 6;
  const bool hasn = (An != nullptr);
  if (!preloaded) {
    GEMM_GLOAD(x, 0)
    if (nk > 1) { GEMM_GLOAD(y, 64) }
  }
  __syncthreads();
  GEMM_LSTORE(x, 0)
  if (nk > 2) { GEMM_GLOAD(x, 128) }
  __syncthreads();
  for (int kt = 0; kt < nk; kt += 2) {
    GEMM_COMPUTE(0)
    if (kt + 1 < nk) { GEMM_LSTORE(y, 1) }
    if (kt + 3 < nk) { GEMM_GLOAD(y, (kt + 3) * 64) }
    else if (hasn && kt + 3 == nk + 1) { GEMM_GLOADN(y, 64) }
    __syncthreads();
    if (kt + 1 < nk) {
      GEMM_COMPUTE(1)
      if (kt + 2 < nk) { GEMM_LSTORE(x, 0) }
      if (kt + 4 < nk) { GEMM_GLOAD(x, (kt + 4) * 64) }
      else if (hasn && kt + 4 == nk) { GEMM_GLOADN(x, 0) }
      __syncthreads();
    }
  }
}

__device__ __forceinline__ void gemm_tile_h(const bf16_t* __restrict__ A, long lda, const bf16_t* __restrict__ B, long ldb,
                                            int K, bf16_t* sbase, f32x16 (&acc)[2], const int tid) {
  const int lane = tid & 63, wave = tid >> 6;
  const int wm = wave >> 1, wn = wave & 1;
  const int lr = tid >> 3, lc = (tid & 7) * 8;
#pragma unroll
  for (int i = 0; i < 2; ++i)
#pragma unroll
    for (int r = 0; r < 16; ++r) acc[i][r] = 0.f;
  const bf16_t* pa = A + (long)lr * lda + lc;
  const bf16_t* pb = B + (long)lr * ldb + lc;
  uint4 xa0, xa1, xa2, xa3, xb0, xb1;
  uint4 ya0, ya1, ya2, ya3, yb0, yb1;
#define GEMMH_GLOAD(S, ko)                                 \
  S##a0 = *(const uint4*)(pa + (ko));                      \
  S##a1 = *(const uint4*)(pa + 32 * lda + (ko));           \
  S##a2 = *(const uint4*)(pa + 64 * lda + (ko));           \
  S##a3 = *(const uint4*)(pa + 96 * lda + (ko));           \
  S##b0 = *(const uint4*)(pb + (ko));                      \
  S##b1 = *(const uint4*)(pb + 32 * ldb + (ko));
#define GEMMH_LSTORE(S, buf)                                                                     \
  { bf16_t* wa = sbase + (buf) * GEMM_BUF + lr * LDSS + lc; bf16_t* wb = wa + 128 * LDSS;         \
    *(uint4*)(wa) = S##a0; *(uint4*)(wa + 32 * LDSS) = S##a1; *(uint4*)(wa + 64 * LDSS) = S##a2; *(uint4*)(wa + 96 * LDSS) = S##a3; \
    *(uint4*)(wb) = S##b0; *(uint4*)(wb + 32 * LDSS) = S##b1; }
#define GEMMH_COMPUTE(buf)                                                                        \
  { const bf16_t* ra = sbase + (buf) * GEMM_BUF + (wm * 64 + (lane & 31)) * LDSS + (lane >> 5) * 8; \
    const bf16_t* rb = sbase + (buf) * GEMM_BUF + 128 * LDSS + (wn * 32 + (lane & 31)) * LDSS + (lane >> 5) * 8; \
    _Pragma("unroll") for (int kk = 0; kk < 4; ++kk) {                                            \
      const bf16x8 af0 = *(const bf16x8*)(ra + kk * 16), af1 = *(const bf16x8*)(ra + 32 * LDSS + kk * 16); \
      const bf16x8 bf0 = *(const bf16x8*)(rb + kk * 16);                                          \
      acc[0] = __builtin_amdgcn_mfma_f32_32x32x16_bf16(af0, bf0, acc[0], 0, 0, 0);               \
      acc[1] = __builtin_amdgcn_mfma_f32_32x32x16_bf16(af1, bf0, acc[1], 0, 0, 0);               \
    } }
  const int nk = K >> 6;
  GEMMH_GLOAD(x, 0)
  if (nk > 1) { GEMMH_GLOAD(y, 64) }
  __syncthreads();
  GEMMH_LSTORE(x, 0)
  if (nk > 2) { GEMMH_GLOAD(x, 128) }
  __syncthreads();
  for (int kt = 0; kt < nk; kt += 2) {
    if (kt + 1 < nk) { GEMMH_LSTORE(y, 1) }
    if (kt + 3 < nk) { GEMMH_GLOAD(y, (kt + 3) * 64) }
    GEMMH_COMPUTE(0)
    __syncthreads();
    if (kt + 1 < nk) {
      if (kt + 2 < nk) { GEMMH_LSTORE(x, 0) }
      if (kt + 4 < nk) { GEMMH_GLOAD(x, (kt + 4) * 64) }
      GEMMH_COMPUTE(1)
      __syncthreads();
    }
  }
}

#define EPI_BEGIN_(ROWEXPR)                                                        \
  {                                                                                \
    const int e_lane = tid & 63, e_wave = tid >> 6;                                \
    const int e_wm = e_wave >> 1, e_wn = e_wave & 1;                               \
    _Pragma("unroll") for (int e_i = 0; e_i < 2; ++e_i)                            \
    _Pragma("unroll") for (int e_j = 0; e_j < 2; ++e_j)                            \
    _Pragma("unroll") for (int e_r = 0; e_r < 16; ++e_r) {                         \
      const int row = ROWEXPR;                                                     \
      const int col = e_wn * 64 + e_j * 32 + (e_lane & 31);                        \
      const float val = acc[e_i][e_j][e_r];
#define EPI_BEGIN EPI_BEGIN_(e_wm * 64 + e_i * 32 + 8 * (e_r >> 2) + 4 * (e_lane >> 5) + (e_r & 3))
#define EPI_BEGIN_OPQ EPI_BEGIN_(opq(e_wm * 64 + e_i * 32 + 8 * (e_r >> 2) + 4 * (e_lane >> 5)) + (e_r & 3))
#define EPI_END }}
#define EPIS_BEGIN                                                                 \
  {                                                                                \
    const int e_lane = tid & 63, e_wave = tid >> 6;                                \
    const int e_rowl = (e_wave >> 1) * 64 + 4 * (e_lane >> 5);                     \
    const int e_coll = (e_wave & 1) * 64 + (e_lane & 31);                          \
    _Pragma("unroll") for (int e_i = 0; e_i < 2; ++e_i)                            \
    _Pragma("unroll") for (int e_j = 0; e_j < 2; ++e_j)                            \
    _Pragma("unroll") for (int e_r = 0; e_r < 16; ++e_r) {                         \
      const int e_rowu = e_i * 32 + 8 * (e_r >> 2) + (e_r & 3);                    \
      const int e_colu = e_j * 32;                                                 \
      const float val = acc[e_i][e_j][e_r];

__device__ __forceinline__ int tok_which(int t) { return t < NCTX ? 0 : 1 + ((t - NCTX) >> 11); }

static __device__ __forceinline__ void p0_mod(const Params& p, char* smem) {
  const int tid = opaque_tid(); const int bid = opaque_bid(); (void)tid; (void)bid;
  float* sc = (float*)smem;
  float* red = sc + 3 * 1024;
  for (int it = first_item(0); it < 192; it += gridDim.x) {
    __syncthreads();
    for (int i = tid; i < 3 * 1024; i += NTHR) {
      const int w = i >> 10, d = i & 1023;
      sc[i] = siluf((w == 0) ? p.c_ctx[d] : p.c[(w - 1) * 1024 + d]);
    }
    __syncthreads();
    const int l = it / 48, e0 = (it % 48) * 64;
    const int col = tid & 63, dq = tid >> 6;
    float a0 = 0.f, a1 = 0.f, a2 = 0.f;
    const float* wp = p.mod_w + ((long)l * 1024 + dq * 256) * 3072 + e0 + col;
    for (int db = 0; db < 256; db += 16) {
      float wv[16];
#pragma unroll
      for (int d = 0; d < 16; ++d) wv[d] = wp[(long)(db + d) * 3072];
#pragma unroll
      for (int d = 0; d < 16; ++d) {
        a0 += sc[dq * 256 + db + d] * wv[d];
        a1 += sc[1024 + dq * 256 + db + d] * wv[d];
        a2 += sc[2048 + dq * 256 + db + d] * wv[d];
      }
    }
    red[(dq * 3 + 0) * 64 + col] = a0;
    red[(dq * 3 + 1) * 64 + col] = a1;
    red[(dq * 3 + 2) * 64 + col] = a2;
    __syncthreads();
    if (tid < 192) {
      const int w = tid >> 6, cc = tid & 63;
      const float sum = red[(0 * 3 + w) * 64 + cc] + red[(1 * 3 + w) * 64 + cc] + red[(2 * 3 + w) * 64 + cc] + red[(3 * 3 + w) * 64 + cc];
      p.modv[(l * 3 + w) * 3072 + e0 + cc] = sum + p.mod_b[l * 3072 + e0 + cc];
    }
  }
}

static __device__ __forceinline__ void p0_filt_mlp(const Params& p, char* smem) {
  const int tid = opaque_tid(); const int bid = opaque_bid(); (void)tid; (void)bid;
  float* z = (float*)smem;
  float* a = z + 16 * 33;
  float* b = a + 1024;
  float* wS = b + 1024;
  for (int it = first_item(192); it < 144; it += gridDim.x) {
    const int lt = (it < 128) ? 1 : 0;
    const int L = lt ? LLAT : LCTX;
    const int p0 = (lt ? it : (it - 128)) * 16;
    float* a3 = p.filt_a3 + (long)(lt ? 256 : 0) * 64;
    __syncthreads();
    for (int i = tid; i < 16 * 33; i += NTHR) {
      const int pp = i / 33, j = i % 33;
      const int l = p0 + pp;
      const float t = (float)l / (float)(L - 1);
      const float w = TWO_PI * (float)l / (float)L;
      float v;
      if (j == 0) v = t;
      else {
        const int bi = (j - 1) & 15;
        const float f = 1e-4f + (float)bi * ((15.0f - 1e-4f) / 15.0f);
        v = (j <= 16) ? cosf(f * w) : -sinf(f * w);
      }
      z[i] = v;
    }
    const int n = opq(tid & 63), pg = opq(tid >> 6);
    const float fr = p.hy_freq[n];
    for (int i = tid; i < 2112; i += NTHR) wS[i] = p.hy_w1[i];
    __syncthreads();
    {
      float acc[4];
#pragma unroll
      for (int q = 0; q < 4; ++q) acc[q] = p.hy_b1[n];
#pragma unroll 3
      for (int jn = 0; jn < 33; ++jn) {
        const float w = wS[jn * 64 + n];
#pragma unroll
        for (int q = 0; q < 4; ++q) acc[q] += z[(pg * 4 + q) * 33 + jn] * w;
      }
#pragma unroll
      for (int q = 0; q < 4; ++q) a[(pg * 4 + q) * 64 + n] = sinf(fr * acc[q]);
    }
    __syncthreads();
    for (int i = tid; i < 4096; i += NTHR) wS[i] = p.hy_w2[i];
    __syncthreads();
    {
      float acc[4];
#pragma unroll
      for (int q = 0; q < 4; ++q) acc[q] = p.hy_b2[n];
#pragma unroll 4
      for (int jn = 0; jn < 64; ++jn) {
        const float w = wS[jn * 64 + n];
#pragma unroll
        for (int q = 0; q < 4; ++q) acc[q] += a[(pg * 4 + q) * 64 + jn] * w;
      }
#pragma unroll
      for (int q = 0; q < 4; ++q) b[(pg * 4 + q) * 64 + n] = sinf(fr * acc[q]);
    }
    __syncthreads();
    for (int i = tid; i < 4096; i += NTHR) wS[i] = p.hy_w3[i];
    __syncthreads();
    {
      float acc[4];
#pragma unroll
      for (int q = 0; q < 4; ++q) acc[q] = p.hy_b3[n];
#pragma unroll 4
      for (int jn = 0; jn < 64; ++jn) {
        const float w = wS[jn * 64 + n];
#pragma unroll
        for (int q = 0; q < 4; ++q) acc[q] += b[(pg * 4 + q) * 64 + jn] * w;
      }
#pragma unroll
      for (int q = 0; q < 4; ++q) a3[(long)(p0 + pg * 4 + q) * 64 + n] = sinf(fr * acc[q]);
    }
  }
}

static __device__ __forceinline__ void phase_filt_main(const Params& p, char* smem) {
  const int tid = opaque_tid(); const int bid = opaque_bid(); (void)tid; (void)bid;
  float* a = (float*)smem;
  const float dmin = -3.0701134573253945f;
  const float dmax = -15.350567286626973f;
  for (int it = bid; it < 36 * 16; it += gridDim.x) {
    const int pc = it >> 4, cb = it & 15;
    const int lt = (pc < 32) ? 1 : 0;
    const int L = lt ? LLAT : LCTX;
    const int p0 = (lt ? pc : (pc - 32)) * 64;
    bf16_t* filt = lt ? p.filt_lat : p.filt_ctx;
    const float* a3 = p.filt_a3 + ((long)(lt ? 256 : 0) + p0) * 64;
    __syncthreads();
    for (int i = tid; i < 1024; i += NTHR) ((float4*)a)[i] = ((const float4*)a3)[i];
    const int cidx = cb * 256 + opq(tid);
    float w4[64];
#pragma unroll
    for (int k = 0; k < 64; ++k) w4[k] = p.hy_w4[k * 4096 + cidx];
    __syncthreads();
    const int ch = cidx & 1023, od = cidx >> 10, order = od >> 1, dir = od & 1;
    const float delta = fabsf(dmin + (float)ch * ((dmax - dmin) / 1023.0f));
    bf16_t* dst = filt + ((long)(order * 1024 + ch)) * (2 * L);
#pragma unroll 1
    for (int pp = 0; pp < 64; ++pp) {
      const float4* ap = (const float4*)(a + pp * 64);
      float acc = 0.f;
#pragma unroll
      for (int k4 = 0; k4 < 16; ++k4) {
        const float4 av = ap[k4];
        acc += av.x * w4[4 * k4 + 0] + av.y * w4[4 * k4 + 1] + av.z * w4[4 * k4 + 2] + av.w * w4[4 * k4 + 3];
      }
      const int l = p0 + pp;
      const float t = (float)l / (float)(L - 1);
      const float v = acc * expf(-t * delta);
      if (dir == 0) dst[L - 1 - l] = f2bf(v);
      else { if (l == 0) dst[2 * L - 1] = 0; else dst[L - 1 + l] = f2bf(v); }
    }
  }
}

static __device__ __forceinline__ void p0_tables(const Params& p, char* smem) {
  const int tid = opaque_tid(); const int bid = opaque_bid(); (void)tid; (void)bid;
  float2* T = (float2*)smem;
  __syncthreads();
  for (int m = tid; m < 2048; m += NTHR) {
    float sv, cv;
    sincosf(TWO_PI * (float)m / 2048.0f, &sv, &cv);
    T[m] = make_float2(cv, sv);
  }
  __syncthreads();
  const int n_items = 64 + 64 + 4096;
  for (int it = first_item(320); it < n_items; it += gridDim.x) {
    unsigned short vals[8];
    if (it < 64) {
#pragma unroll
      for (int q = 0; q < 8; ++q) {
        const int e = it * 2048 + tid * 8 + q;
        const int m = e >> 8, k = e & 255;
        const int cs = m >> 8, co = m & 255;
        const float2 tv = T[((co * k) & 255) * 8];
        vals[q] = f2bf(cs ? tv.y : tv.x);
      }
      *(uint4*)(p.tabA + (long)it * 2048 + tid * 8) = make_uint4(vals[0] | (vals[1] << 16), vals[2] | (vals[3] << 16), vals[4] | (vals[5] << 16), vals[6] | (vals[7] << 16));
    } else if (it < 128) {
#pragma unroll
      for (int q = 0; q < 8; ++q) {
        const int e = (it - 64) * 2048 + tid * 8 + q;
        const int pp = e >> 9, k = e & 511;
        const int cs = k >> 8, pi = k & 255;
        const float2 tv = T[((pp * pi) & 255) * 8];
        vals[q] = f2bf(cs ? -tv.y : tv.x);
      }
      *(uint4*)(p.tabB_ctx + (long)(it - 64) * 2048 + tid * 8) = make_uint4(vals[0] | (vals[1] << 16), vals[2] | (vals[3] << 16), vals[4] | (vals[5] << 16), vals[6] | (vals[7] << 16));
    } else {
#pragma unroll
      for (int q = 0; q < 8; ++q) {
        const int e = (it - 128) * 2048 + tid * 8 + q;
        const int pp = e >> 12, k = e & 4095;
        const int cs = k >> 11, pi = k & 2047;
        const float2 tv = T[(pp * pi) & 2047];
        vals[q] = f2bf(cs ? -tv.y : tv.x);
      }
      *(uint4*)(p.tabB_lat + (long)(it - 128) * 2048 + tid * 8) = make_uint4(vals[0] | (vals[1] << 16), vals[2] | (vals[3] << 16), vals[4] | (vals[5] << 16), vals[6] | (vals[7] << 16));
    }
  }
}

static __device__ __forceinline__ void wt_transpose_items(const float* __restrict__ W, bf16_t* __restrict__ Wt, int N, int Npad, int off, char* smem) {
  const int tid = opaque_tid(); const int bid = opaque_bid(); (void)tid; (void)bid;
  float* t = (float*)smem;
  const int ntn = Npad / 64;
  const int n_items = ntn * 16;
  for (int it = first_item(off); it < n_items; it += gridDim.x) {
    const int nt = it % ntn, kt = it / ntn;
    const int n0 = nt * 64, k0 = kt * 64;
    __syncthreads();
    const int tx = tid & 63, ty = tid >> 6;
    float v[16];
#pragma unroll
    for (int i = 0; i < 16; ++i) v[i] = (n0 + tx < N) ? W[(long)(k0 + ty + 4 * i) * N + n0 + tx] : 0.f;
#pragma unroll
    for (int i = 0; i < 16; ++i) t[tx * 65 + ty + 4 * i] = v[i];
    __syncthreads();
    const int r = tid >> 2, cch = (tid & 3) * 16;
    unsigned w[8];
#pragma unroll
    for (int q = 0; q < 8; ++q) w[q] = pk2(t[r * 65 + cch + 2 * q], t[r * 65 + cch + 2 * q + 1]);
    uint4* dp = (uint4*)(Wt + (long)(n0 + r) * 1024 + k0 + cch);
    dp[0] = make_uint4(w[0], w[1], w[2], w[3]);
    dp[1] = make_uint4(w[4], w[5], w[6], w[7]);
  }
}

static __device__ __forceinline__ void p0_weights(const Params& p, char* smem) {
  wt_transpose_items(p.gla_w_in, p.wt_gla_in0, 3104, 3200, 0, smem);
  wt_transpose_items(p.gla_w_out, p.wt_gla_out0, 1024, 1024, 288, smem);
  wt_transpose_items(p.fn_w_in, p.wt_fn_in, 2048, 2048, 32, smem);
  wt_transpose_items(p.fn_w_out, p.wt_fn_out, 1024, 1024, 32, smem);
  wt_transpose_items(p.hy_w_in, p.wt_hy_in, 4096, 4096, 288, smem);
  wt_transpose_items(p.hy_w_out, p.wt_hy_out, 1024, 1024, 288, smem);
  wt_transpose_items(p.gla_w_in + (long)1024 * 3104, p.wt_gla_in1, 3104, 3200, 32, smem);
  wt_transpose_items(p.gla_w_out + (long)1024 * 1024, p.wt_gla_out1, 1024, 1024, 288, smem);
}

static __device__ __forceinline__ void phase_norm(const Params& p, int layer) {
  const int tid = opaque_tid(); const int bid = opaque_bid(); (void)tid; (void)bid;
  const int lane = tid & 63, wave = tid >> 6;
  const float* g = p.norm_g + layer * 1024;
  const int stride = gridDim.x * 4;
  for (int t0 = bid * 4 + wave; t0 < NTOK; t0 += 2 * stride) {
    float4 v[2][4];
#pragma unroll
    for (int u = 0; u < 2; ++u) {
      const int t = t0 + u * stride;
      if (t < NTOK) {
        const float* xr;
        if (layer == 0) xr = (t < NCTX) ? (p.x_prompt + (long)t * 1024) : (p.x_sample + (long)(t - NCTX) * 1024);
        else xr = p.out + (long)t * 1024;
#pragma unroll
        for (int i = 0; i < 4; ++i) v[u][i] = *(const float4*)(xr + lane * 4 + 256 * i);
      }
    }
#pragma unroll
    for (int u = 0; u < 2; ++u) {
      const int t = t0 + u * stride;
      if (t < NTOK) {
        const float* mv = p.modv + (layer * 3 + tok_which(t)) * 3072;
        float ss = 0.f;
#pragma unroll
        for (int i = 0; i < 4; ++i) ss += v[u][i].x * v[u][i].x + v[u][i].y * v[u][i].y + v[u][i].z * v[u][i].z + v[u][i].w * v[u][i].w;
#pragma unroll
        for (int o = 32; o > 0; o >>= 1) ss += __shfl_xor(ss, o);
        const float rstd = rsqrtf(ss * (1.0f / 1024.0f) + 1e-6f);
#pragma unroll
        for (int i = 0; i < 4; ++i) {
          const int c0 = lane * 4 + 256 * i;
          const float4 gg = *(const float4*)(g + c0);
          const float4 sh = *(const float4*)(mv + c0);
          const float4 sc = *(const float4*)(mv + 1024 + c0);
          uint2 w;
          w.x = pk2((v[u][i].x * rstd * gg.x) * (1.f + sc.x) + sh.x, (v[u][i].y * rstd * gg.y) * (1.f + sc.y) + sh.y);
          w.y = pk2((v[u][i].z * rstd * gg.z) * (1.f + sc.z) + sh.z, (v[u][i].w * rstd * gg.w) * (1.f + sc.w) + sh.w);
          *(uint2*)(p.h + (long)t * 1024 + c0) = w;
        }
      }
    }
  }
}

static __device__ __forceinline__ void phase_final_norm(const Params& p) {
  const int tid = opaque_tid(); const int bid = opaque_bid(); (void)tid; (void)bid;
  const int lane = tid & 63, wave = tid >> 6;
  for (int t = bid * 4 + wave; t < NTOK; t += gridDim.x * 4) {
    float* xr = p.out + (long)t * 1024;
    float4 v[4];
    float ss = 0.f;
#pragma unroll
    for (int i = 0; i < 4; ++i) {
      v[i] = *(const float4*)(xr + lane * 4 + 256 * i);
      ss += v[i].x * v[i].x + v[i].y * v[i].y + v[i].z * v[i].z + v[i].w * v[i].w;
    }
#pragma unroll
    for (int o = 32; o > 0; o >>= 1) ss += __shfl_xor(ss, o);
    const float rstd = rsqrtf(ss * (1.0f / 1024.0f) + 1e-6f);
#pragma unroll
    for (int i = 0; i < 4; ++i) {
      const int c0 = lane * 4 + 256 * i;
      float4 gg = *(const float4*)(p.final_norm_g + c0);
      float4 o;
      o.x = v[i].x * rstd * gg.x; o.y = v[i].y * rstd * gg.y; o.z = v[i].z * rstd * gg.z; o.w = v[i].w * rstd * gg.w;
      *(float4*)(xr + c0) = o;
    }
  }
}

static __device__ __forceinline__ void phase_gemm_out(const Params& p, int layer, const bf16_t* Wt, char* smem, const int dummy) {
  const int tid = opaque_tid(); const int bid = opaque_bid(); (void)tid; (void)bid;
  bf16_t* sA = (bf16_t*)smem;
  GEMM_STAGE_DECL
  float* outp = dummy ? (float*)p.big : p.out;
  const int n_tiles = 96 * 8;
  const int nfull = (gridDim.x == 512) ? 512 : n_tiles;
  const int n_items = nfull + 2 * (n_tiles - nfull);
  for (int item = bid; item < n_items; item += gridDim.x) {
    const bool is_half = item >= nfull;
    const int tile = is_half ? nfull + ((item - nfull) >> 1) : item;
    const int hsel = is_half ? ((item - nfull) & 1) : 0;
    const int mt = tile % 96, nt = tile / 96;
    const int m0 = mt * 128, n0 = nt * 128 + hsel * 64;
    const float* gate = p.modv + (layer * 3 + tok_which(m0)) * 3072 + 2048;
    const float* xsrc = (layer == 0) ? ((m0 < NCTX) ? p.x_prompt : (p.x_sample - (long)NCTX * 1024)) : p.out;
    const int e_lane = tid & 63, e_wave = tid >> 6;
    const int e_wm = e_wave >> 1, e_wn = e_wave & 1;
    if (!is_half) {
      f32x16 acc[2][2];
      gemm_tile(p.h + (long)m0 * 1024, 1024, Wt + (long)n0 * 1024, 1024, 1024, sA, acc, tid, GEMM_STAGE_ARGS, false, nullptr, nullptr);
      float xo[2][2][16];
      const float* xb = xsrc + (long)m0 * 1024 + n0;
      float* ob = outp + (long)m0 * 1024 + n0;
      EPIS_BEGIN
        (void)val;
        const unsigned lo = 4u * (unsigned)(e_rowl * 1024 + e_coll);
        xo[e_i][e_j][e_r] = *(const float*)((const char*)(xb + e_rowu * 1024 + e_colu) + lo);
      EPI_END
      EPIS_BEGIN
        const unsigned lo = 4u * (unsigned)(e_rowl * 1024 + e_coll);
        *(float*)((char*)(ob + e_rowu * 1024 + e_colu) + lo) = xo[e_i][e_j][e_r] + gate[n0 + e_coll + e_colu] * val;
      EPI_END
    } else {
      f32x16 acc[2];
      gemm_tile_h(p.h + (long)m0 * 1024, 1024, Wt + (long)n0 * 1024, 1024, 1024, sA, acc, tid);
      const int n = n0 + e_wn * 32 + (e_lane & 31);
      const float gn = gate[n];
      float xo[2][16];
#pragma unroll
      for (int e_i = 0; e_i < 2; ++e_i)
#pragma unroll
        for (int e_r = 0; e_r < 16; ++e_r) {
          const int row = e_wm * 64 + e_i * 32 + 8 * (e_r >> 2) + 4 * (e_lane >> 5) + (e_r & 3);
          xo[e_i][e_r] = xsrc[(long)(m0 + row) * 1024 + n];
        }
#pragma unroll
      for (int e_i = 0; e_i < 2; ++e_i)
#pragma unroll
        for (int e_r = 0; e_r < 16; ++e_r) {
          const int row = e_wm * 64 + e_i * 32 + 8 * (e_r >> 2) + 4 * (e_lane >> 5) + (e_r & 3);
          outp[(long)(m0 + row) * 1024 + n] = xo[e_i][e_r] + gn * acc[e_i][e_r];
        }
    }
  }
}

#define GLA_PROJ(p) ((p).big)
#define GLA_LR(p) ((float*)((p).big + (long)NTOK * 3072))
#define GLA_OF(p) ((p).big + (long)NTOK * 3072 + (long)NTOK * 64)
#define GLA_OB(p) (GLA_OF(p) + (long)NTOK * 1024)

static __device__ __forceinline__ void phase_gla_in(const Params& p, const bf16_t* Wt, char* smem) {
  const int tid = opaque_tid(); const int bid = opaque_bid(); (void)tid; (void)bid;
  bf16_t* sA = (bf16_t*)smem;
  GEMM_STAGE_DECL
  bool pre = false;
  bf16_t* proj = GLA_PROJ(p);
  float* lrb = GLA_LR(p);
  const int n_tiles = 96 * 25;
  for (int tile = bid; tile < n_tiles; tile += gridDim.x) {
    const int mt = tile % 96, nt = tile / 96;
    const int m0 = mt * 128, n0 = nt * 128;
    f32x16 acc[2][2];
    {
      const int tn = tile + gridDim.x;
      const bool hn = tn < n_tiles;
      gemm_tile(p.h + (long)m0 * 1024, 1024, Wt + (long)n0 * 1024, 1024, 1024, sA, acc, tid, GEMM_STAGE_ARGS, pre,
                hn ? p.h + (long)((tn % 96) * 128) * 1024 : nullptr, hn ? Wt + (long)((tn / 96) * 128) * 1024 : nullptr);
      pre = hn;
    }
    if (n0 < 3072) {
      bf16_t* tb = proj + (long)m0 * 3072 + n0;
      EPIS_BEGIN
        const unsigned lo = 2u * (unsigned)(e_rowl * 3072 + e_coll);
        *(bf16_t*)((char*)(tb + e_rowu * 3072 + e_colu) + lo) = f2bf(val);
      EPI_END
    } else {
      EPI_BEGIN
        const int t = m0 + row, n = n0 + col;
        if (n < 3104) lrb[(long)t * 32 + (n - 3072)] = val;
      EPI_END
    }
  }
}

#define GLA_IMG1(p) (GLA_OB(p) + (long)NTOK * 1024)
#define GLA_BLAST(p) ((float*)(GLA_IMG1(p) + (long)NTOK * 1024))
static __device__ __forceinline__ void phase_gla_prep(const Params& p, int j, char* smem, const int dummy) {
  const int tid = opaque_tid(); const int bid = opaque_bid();
  float* sLR = (float*)smem;
  bf16_t* proj = GLA_PROJ(p);
  bf16_t* img1 = GLA_IMG1(p);
  const float* lrb = GLA_LR(p);
  float* blast = GLA_BLAST(p);
  const int dkl = tid & 127, dir = tid >> 7;
  for (int it = bid; it < (NTOK / 32) * 4; it += gridDim.x) {
    const int tb = it >> 2, hh = it & 3;
    const int dk = hh * 128 + dkl;
    __syncthreads();
    ((float4*)sLR)[tid] = *(const float4*)(lrb + ((long)tb * 32 + (tid >> 3)) * 32 + (tid & 7) * 4);
    unsigned rqk[32];
    {
      const bf16_t* rp = proj + ((long)tb * 32 + (dir ? 31 : 0)) * 3072 + dk;
      const long rstep = dir ? -3072 : 3072;
#pragma unroll
      for (int s_ = 0; s_ < 32; ++s_) {
        rqk[s_] = (unsigned)rp[0] | ((unsigned)rp[512] << 16);
        rp += rstep;
      }
    }
    float wd[16];
    const float* wdp = p.gla_w_dec + ((long)(j * 2 + dir) * 16) * 512 + dk;
#pragma unroll
    for (int r = 0; r < 16; ++r) wd[r] = wdp[r * 512];
    const float bd = p.gla_b_dec[(j * 2 + dir) * 512 + dk];
    __syncthreads();
    float* sC = sLR + 1024 + tid;
    float run = 0.f;
#pragma unroll
    for (int s_ = 0; s_ < 32; ++s_) {
      const int pos = dir ? 31 - s_ : s_;
      const float4* lp = (const float4*)(sLR + pos * 32 + dir * 16);
      float lg = bd;
#pragma unroll
      for (int r4 = 0; r4 < 4; ++r4) {
        const float4 l4 = lp[r4];
        lg += l4.x * wd[r4 * 4 + 0] + l4.y * wd[r4 * 4 + 1] + l4.z * wd[r4 * 4 + 2] + l4.w * wd[r4 * 4 + 3];
      }
      run += (fminf(lg, 0.f) - __logf(1.f + __expf(-fabsf(lg)))) * (1.0f / 16.0f);
      sC[s_ * 256] = run;
    }
    blast[((long)dir * (NTOK / 32) + tb) * 512 + dk] = run;
    bf16_t* dst = dir ? img1 : (dummy ? GLA_OF(p) : proj);
    const long dstr = (dir || dummy) ? 1024 : 3072;
#pragma unroll
    for (int s_ = 0; s_ < 32; ++s_) {
      const int pos = dir ? 31 - s_ : s_;
      const long tok = (long)tb * 32 + pos;
      const float e0 = sC[s_ * 256] - run;
      const float qs = 0.08838834764831845f * __expf(fminf(e0, 80.f));
      const float ks = __expf(-e0);
      const unsigned o2 = pk2(bf2f((bf16_t)(rqk[s_] & 0xffffu)) * qs, bf2f((bf16_t)(rqk[s_] >> 16)) * ks);
      dst[tok * dstr + dk] = (bf16_t)(o2 & 0xffffu);
      dst[tok * dstr + 512 + dk] = (bf16_t)(o2 >> 16);
    }
  }
}

#define QS 136
#define TS 40
#define GLA_SLOC(p) ((float*)((p).h))
#define GLA_GSEG(p) (((float*)((p).h)) + (long)128 * 128 * 256)
__device__ __forceinline__ int crow_(int r, int hf) { return (r & 3) + 8 * (r >> 2) + 4 * hf; }
__device__ __forceinline__ bf16x8 pack8(const f32x16& x, const int st) {
  union { unsigned u[4]; bf16x8 v; } c;
  c.u[0] = pk2(x[8 * st + 0], x[8 * st + 1]);
  c.u[1] = pk2(x[8 * st + 2], x[8 * st + 3]);
  c.u[2] = pk2(x[8 * st + 4], x[8 * st + 5]);
  c.u[3] = pk2(x[8 * st + 6], x[8 * st + 7]);
  return c.v;
}
__device__ __forceinline__ bf16x8 ld2x8(const bf16_t* a, const bf16_t* b) {
  union { uint2 d[2]; bf16x8 v; } c;
  c.d[0] = *(const uint2*)a;
  c.d[1] = *(const uint2*)b;
  return c.v;
}

__device__ __forceinline__ unsigned kimg_off(unsigned row, unsigned ch) { return 256u * row + 16u * (ch ^ (((row & 3u) << 2) | ((row >> 2) & 3u))); }
__device__ __forceinline__ unsigned kimg_tr(unsigned lane, unsigned c, unsigned ks, unsigned t) {
  const unsigned h = lane >> 5, blk = (lane >> 4) & 1u, q = (lane & 15u) >> 2, pp = lane & 3u;
  return kimg_off(16u * ks + 8u * h + 4u * t + q, 4u * c + 2u * blk + (pp >> 1)) + 8u * (pp & 1u);
}
typedef short s16x4 __attribute__((ext_vector_type(4)));

static __device__ __forceinline__ void phase_gla_scan(const Params& p, int j, int pass, char* smem) {
  const int tid = opaque_tid(); const int bid = opaque_bid();
  bf16_t* sQ = (bf16_t*)smem;
  bf16_t* sK = sQ + 32 * QS;
  bf16_t* sKT = sK + 32 * QS;
  bf16_t* sVT = sKT + 128 * TS;
  float* sDec = (float*)(sVT + 64 * TS);
  float* sOp = sDec + 128;
  const bf16_t* proj = GLA_PROJ(p);
  const bf16_t* img1 = GLA_IMG1(p);
  const float* blast = GLA_BLAST(p);
  float* sloc = GLA_SLOC(p);
  float* gseg = GLA_GSEG(p);
  const int lane = tid & 63, wave = tid >> 6, l31 = lane & 31, hf = lane >> 5;
  const int kh = wave >> 1, nt = wave & 1;
  const int dk0 = (tid & 63) * 2, sg = tid >> 6;
  const int vp = tid & 31, sg8 = tid >> 5;
  const int irow = tid >> 3, icol = (tid & 7) * 16;
  char* sKb = (char*)sK;
  char* sVb = (char*)sKT;
  const unsigned vbase = (unsigned)(size_t)sVb;
  const unsigned vtr0 = vbase + kimg_tr(lane, nt, 0, 0), vtr1 = vbase + kimg_tr(lane, nt, 0, 1);
  const unsigned vtr2 = vbase + kimg_tr(lane, nt, 1, 0), vtr3 = vbase + kimg_tr(lane, nt, 1, 1);
  const unsigned vq_ = (lane & 15) >> 2, vch_ = 4 * nt + 2 * ((lane >> 4) & 1) + ((lane & 3) >> 1), vb8_ = 8 * (lane & 1);
  const unsigned vtrp0 = vbase + kimg_off(16 * kh + 4 * hf + vq_, vch_) + vb8_;
  const unsigned vtrp1 = vbase + kimg_off(16 * kh + 8 + 4 * hf + vq_, vch_) + vb8_;
  const unsigned kbase = (unsigned)(size_t)sKb;
  const unsigned ktr0 = kbase + kimg_tr(lane, 2 * kh + 0, 0, 0), ktr1 = kbase + kimg_tr(lane, 2 * kh + 0, 0, 1);
  const unsigned ktr2 = kbase + kimg_tr(lane, 2 * kh + 0, 1, 0), ktr3 = kbase + kimg_tr(lane, 2 * kh + 0, 1, 1);
  const unsigned ktr4 = kbase + kimg_tr(lane, 2 * kh + 1, 0, 0), ktr5 = kbase + kimg_tr(lane, 2 * kh + 1, 0, 1);
  const unsigned ktr6 = kbase + kimg_tr(lane, 2 * kh + 1, 1, 0), ktr7 = kbase + kimg_tr(lane, 2 * kh + 1, 1, 1);
  const int n_items = pass == 0 ? (1024 + 512) : 512;
  for (int it = bid; it < n_items; it += gridDim.x) {
    int b, hh, dir, vt, sidx, L, tbase;
    bool full, lat;
    if (pass == 0 && it < 1024) {
      vt = it & 3; const int combo = it >> 2;
      dir = combo & 1; hh = (combo >> 1) & 3; b = combo >> 3; sidx = 0;
      L = LCTX; tbase = b * LCTX; full = true; lat = false;
    } else {
      const int i2 = pass == 0 ? it - 1024 : it;
      vt = i2 & 3; const int combo = i2 >> 2;
      dir = combo & 1; hh = (combo >> 1) & 3; sidx = (combo >> 3) & 7; b = combo >> 6;
      L = LLAT; tbase = NCTX + b * LLAT; full = (pass == 1); lat = true;
    }
    bf16_t* obuf = dir ? GLA_OB(p) : GLA_OF(p);
    const bf16_t* ib = dir ? img1 : proj;
    const long istr = dir ? 1024 : 3072;
    const int vcol = vt * 64 + nt * 32 + l31;
    const int sgn = dir ? -1 : 1;
    const int offq = (dir ? 31 - irow : irow) * (int)istr + icol;
    const int offv = (dir ? 31 - irow : irow) * 3072 + (tid & 7) * 8;
    const int offo = (dir ? 31 - 4 * hf : 4 * hf) * 1024 + vcol;
    f32x16 S0, S1;
    if (pass == 0) {
#pragma unroll
      for (int r = 0; r < 16; ++r) { S0[r] = 0.f; S1[r] = 0.f; }
    } else {
      const int rb = opq((kh * 64 + 4 * hf) * 256 + vcol);
      const float* s0 = p.state_gla + ((((long)b * 2 + j) * 2 + dir) * 4 + hh) * 128 * 256 + rb;
#pragma unroll
      for (int r = 0; r < 16; ++r) {
        S0[r] = s0[crow_(r, 0) * 256];
        S1[r] = s0[(32 + crow_(r, 0)) * 256];
      }
      for (int i = 0; i < sidx; ++i) {
        const int ci = (((b * 8 + i) * 4 + hh) * 2 + dir);
        const float* sl = sloc + (long)ci * 128 * 256 + rb;
        const float* gs = gseg + ci * 128 + opq(kh * 64 + 4 * hf);
#pragma unroll
        for (int r = 0; r < 16; ++r) {
          S0[r] = __expf(gs[crow_(r, 0)]) * S0[r] + sl[crow_(r, 0) * 256];
          S1[r] = __expf(gs[32 + crow_(r, 0)]) * S1[r] + sl[(32 + crow_(r, 0)) * 256];
        }
      }
    }
    float gsum = 0.f;
    struct GlaRegs { uint4 q0, q1, k0, k1, v; float bl; };
    GlaRegs RA, RB;
    RA.q0 = make_uint4(0u, 0u, 0u, 0u); RA.q1 = RA.q0; RB.q0 = RA.q0; RB.q1 = RA.q0; RA.bl = 0.f; RB.bl = 0.f;
#define GLA_TOK(u_) ((long)tbase + (dir ? (L - 1 - (u_)) : (u_)))
    auto gla_load = [&](const int c_, GlaRegs& R) __attribute__((always_inline)) {
      const int ub = sidx * 256 + c_ * 32;
      const long TB = (long)tbase + (dir ? (L - 32 - ub) : ub);
      {
        const bf16_t* rp = ib + TB * istr + hh * 128 + offq;
        if (full) { R.q0 = *(const uint4*)rp; R.q1 = *(const uint4*)(rp + 8); }
        R.k0 = *(const uint4*)(rp + 512); R.k1 = *(const uint4*)(rp + 520);
      }
      R.v = *(const uint4*)(proj + TB * 3072 + 1024 + hh * 256 + vt * 64 + offv);
      if (tid < 128) R.bl = blast[((long)dir * (NTOK / 32) + (TB >> 5)) * 512 + hh * 128 + tid];
    };
    auto gla_chunk = [&](const int c, GlaRegs& R) __attribute__((always_inline)) {
      if (full) {
        *(uint4*)(sQ + irow * QS + icol) = R.q0; *(uint4*)(sQ + irow * QS + icol + 8) = R.q1;
      }
      *(uint4*)(sKb + kimg_off(irow, 2 * (tid & 7))) = R.k0;
      *(uint4*)(sKb + kimg_off(irow, 2 * (tid & 7) + 1)) = R.k1;
      *(uint4*)(sVb + kimg_off(irow, tid & 7)) = R.v;
      if (tid < 128) { sDec[tid] = __expf(R.bl); gsum += R.bl; }
      __syncthreads();
      if (c + 2 < 8) gla_load(c + 2, R);
#pragma unroll
      for (int r = 0; r < 16; ++r) {
        S0[r] *= sDec[kh * 64 + crow_(r, hf)];
        S1[r] *= sDec[kh * 64 + 32 + crow_(r, hf)];
      }
      f32x16 o;
      if (full) {
        f32x16 att;
#pragma unroll
        for (int r = 0; r < 16; ++r) { att[r] = 0.f; o[r] = 0.f; }
#pragma unroll
        for (int kk = 0; kk < 8; ++kk) {
          const bf16x8 a = *(const bf16x8*)(sKb + kimg_off(l31, 2 * kk + hf));
          const bf16x8 bq = *(const bf16x8*)(sQ + l31 * QS + kk * 16 + 8 * hf);
          att = __builtin_amdgcn_mfma_f32_32x32x16_bf16(a, bq, att, 0, 0, 0);
        }
#pragma unroll
        for (int r = 0; r < 16; ++r) if (crow_(r, hf) > l31) att[r] = 0.f;
#pragma unroll
        for (int st = 0; st < 2; ++st) {
          {
            const bf16_t* qa = sQ + l31 * QS + kh * 64 + 16 * st + 4 * hf;
            o = __builtin_amdgcn_mfma_f32_32x32x16_bf16(ld2x8(qa, qa + 8), pack8(S0, st), o, 0, 0, 0);
          }
          {
            const bf16_t* qa = sQ + l31 * QS + kh * 64 + 32 + 16 * st + 4 * hf;
            o = __builtin_amdgcn_mfma_f32_32x32x16_bf16(ld2x8(qa, qa + 8), pack8(S1, st), o, 0, 0, 0);
          }
        }
        {
          const bf16x8 pa0 = pack8(att, 0), pa1 = pack8(att, 1);
          const bf16x8 pa = kh ? pa1 : pa0;
          s16x4 u0, u1;
          asm volatile("ds_read_b64_tr_b16 %0, %2\n\tds_read_b64_tr_b16 %1, %3\n\ts_waitcnt lgkmcnt(0)"
                       : "=&v"(u0), "=&v"(u1) : "v"(vtrp0), "v"(vtrp1) : "memory");
          o = __builtin_amdgcn_mfma_f32_32x32x16_bf16(pa, __builtin_shufflevector(u0, u1, 0, 1, 2, 3, 4, 5, 6, 7), o, 0, 0, 0);
        }
        if (kh == 1) {
#pragma unroll
          for (int r = 0; r < 16; ++r) sOp[(nt * 32 + crow_(r, hf)) * 32 + l31] = o[r];
        }
      }
      {
        s16x4 t00, t01, t02, t03, t10, t11, t12, t13;
        s16x4 w0, w1, w2, w3;
        asm volatile(
            "ds_read_b64_tr_b16 %0, %12\n\t"
            "ds_read_b64_tr_b16 %1, %13\n\t"
            "ds_read_b64_tr_b16 %2, %14\n\t"
            "ds_read_b64_tr_b16 %3, %15\n\t"
            "ds_read_b64_tr_b16 %4, %16\n\t"
            "ds_read_b64_tr_b16 %5, %17\n\t"
            "ds_read_b64_tr_b16 %6, %18\n\t"
            "ds_read_b64_tr_b16 %7, %19\n\t"
            "ds_read_b64_tr_b16 %8, %20\n\t"
            "ds_read_b64_tr_b16 %9, %21\n\t"
            "ds_read_b64_tr_b16 %10, %22\n\t"
            "ds_read_b64_tr_b16 %11, %23\n\t"
            "s_waitcnt lgkmcnt(0)"
            : "=&v"(t00), "=&v"(t01), "=&v"(t02), "=&v"(t03), "=&v"(t10), "=&v"(t11), "=&v"(t12), "=&v"(t13),
              "=&v"(w0), "=&v"(w1), "=&v"(w2), "=&v"(w3)
            : "v"(ktr0), "v"(ktr1), "v"(ktr2), "v"(ktr3), "v"(ktr4), "v"(ktr5), "v"(ktr6), "v"(ktr7),
              "v"(vtr0), "v"(vtr1), "v"(vtr2), "v"(vtr3)
            : "memory");
        const bf16x8 a00 = __builtin_shufflevector(t00, t01, 0, 1, 2, 3, 4, 5, 6, 7);
        const bf16x8 a01 = __builtin_shufflevector(t02, t03, 0, 1, 2, 3, 4, 5, 6, 7);
        const bf16x8 a10 = __builtin_shufflevector(t10, t11, 0, 1, 2, 3, 4, 5, 6, 7);
        const bf16x8 a11 = __builtin_shufflevector(t12, t13, 0, 1, 2, 3, 4, 5, 6, 7);
        const bf16x8 bv0 = __builtin_shufflevector(w0, w1, 0, 1, 2, 3, 4, 5, 6, 7);
        const bf16x8 bv1 = __builtin_shufflevector(w2, w3, 0, 1, 2, 3, 4, 5, 6, 7);
        S0 = __builtin_amdgcn_mfma_f32_32x32x16_bf16(a00, bv0, S0, 0, 0, 0);
        S1 = __builtin_amdgcn_mfma_f32_32x32x16_bf16(a10, bv0, S1, 0, 0, 0);
        S0 = __builtin_amdgcn_mfma_f32_32x32x16_bf16(a01, bv1, S0, 0, 0, 0);
        S1 = __builtin_amdgcn_mfma_f32_32x32x16_bf16(a11, bv1, S1, 0, 0, 0);
      }
      __syncthreads();
      if (full && kh == 0) {
        const int ub = sidx * 256 + c * 32;
        const long TB = (long)tbase + (dir ? (L - 32 - ub) : ub);
#pragma unroll
        for (int r = 0; r < 16; ++r) {
          const int srow = crow_(r, hf);
          const float val = o[r] + sOp[(nt * 32 + srow) * 32 + l31];
          bf16_t* uo = obuf + (TB + sgn * (8 * (r >> 2) + (r & 3))) * 1024 + hh * 256;
          uo[offo] = f2bf(val);
        }
      }
    };
    gla_load(0, RA);
    gla_load(1, RB);
    __syncthreads();
    for (int c = 0; c < 8; c += 2) {
      gla_chunk(c, RA);
      gla_chunk(c + 1, RB);
    }
    const int rbo = opq((kh * 64 + 4 * hf) * 256 + vcol);
    if (!lat) {
      float* so = p.out + (long)NTOK * 1024 + ((((long)b * 2 + j) * 2 + dir) * 4 + hh) * 128 * 256 + rbo;
#pragma unroll
      for (int r = 0; r < 16; ++r) {
        so[crow_(r, 0) * 256] = S0[r];
        so[(32 + crow_(r, 0)) * 256] = S1[r];
      }
    } else if (pass == 0) {
      const int ci = (((b * 8 + sidx) * 4 + hh) * 2 + dir);
      float* sl = sloc + (long)ci * 128 * 256 + rbo;
#pragma unroll
      for (int r = 0; r < 16; ++r) {
        sl[crow_(r, 0) * 256] = S0[r];
        sl[(32 + crow_(r, 0)) * 256] = S1[r];
      }
      if (vt == 0 && tid < 128) gseg[ci * 128 + tid] = gsum;
    }
    __syncthreads();
  }
}

static __device__ __forceinline__ void phase_gla_combine(const Params& p, int j) {
  const int tid = opaque_tid(); const int bid = opaque_bid(); (void)tid; (void)bid;
  const int lane = tid & 63, wave = tid >> 6;
  const bf16_t* proj = GLA_PROJ(p);
  const bf16_t* of = GLA_OF(p);
  const bf16_t* ob = GLA_OB(p);
  const float* og = p.gla_onorm_g + j * 256;
  const float4 gg = *(const float4*)(og + lane * 4);
  const int stride = gridDim.x * 4;
  for (int it0 = bid * 4 + wave; it0 < NTOK * 4; it0 += 4 * stride) {
    uint2 a[4], b[4], r[4];
#pragma unroll
    for (int u = 0; u < 4; ++u) {
      const int it = it0 + u * stride;
      if (it < NTOK * 4) {
        const int t = it >> 2, hh = it & 3;
        const long base = (long)t * 1024 + hh * 256 + lane * 4;
        a[u] = *(const uint2*)(of + base);
        b[u] = *(const uint2*)(ob + base);
        r[u] = *(const uint2*)(proj + (long)t * 3072 + 2048 + hh * 256 + lane * 4);
      }
    }
#pragma unroll
    for (int u = 0; u < 4; ++u) {
      const int it = it0 + u * stride;
      if (it < NTOK * 4) {
        const int t = it >> 2, hh = it & 3;
        const long base = (long)t * 1024 + hh * 256 + lane * 4;
        float o[4];
        o[0] = bf2f(a[u].x & 0xffff) + bf2f(b[u].x & 0xffff);
        o[1] = bf2f(a[u].x >> 16) + bf2f(b[u].x >> 16);
        o[2] = bf2f(a[u].y & 0xffff) + bf2f(b[u].y & 0xffff);
        o[3] = bf2f(a[u].y >> 16) + bf2f(b[u].y >> 16);
        const float r0 = bf2f(r[u].x & 0xffff), r1 = bf2f(r[u].x >> 16), r2 = bf2f(r[u].y & 0xffff), r3 = bf2f(r[u].y >> 16);
        float ss = o[0] * o[0] + o[1] * o[1] + o[2] * o[2] + o[3] * o[3];
#pragma unroll
        for (int sft = 32; sft > 0; sft >>= 1) ss += __shfl_xor(ss, sft);
        const float rstd = rsqrtf(ss * (1.0f / 256.0f) + 1e-6f);
        uint2 w;
        w.x = pk2(o[0] * rstd * gg.x * siluf(r0), o[1] * rstd * gg.y * siluf(r1));
        w.y = pk2(o[2] * rstd * gg.z * siluf(r2), o[3] * rstd * gg.w * siluf(r3));
        *(uint2*)(p.h + base) = w;
      }
    }
  }
}

#define FN_PROJ(p) ((p).big)
#define FN_XCS_CTX(p) ((p).big + (long)NTOK * 2048)
#define FN_XCS_LAT(p) (FN_XCS_CTX(p) + (long)NCTX * 2048)

static __device__ __forceinline__ void phase_fn_in(const Params& p, char* smem) {
  const int tid = opaque_tid(); const int bid = opaque_bid(); (void)tid; (void)bid;
  bf16_t* sA = (bf16_t*)smem;
  GEMM_STAGE_DECL
  bool pre = false;
  bf16_t* proj = FN_PROJ(p);
  const int n_tiles = 96 * 16;
  for (int tile = bid; tile < n_tiles; tile += gridDim.x) {
    const int mt = tile % 96, nt = tile / 96;
    const int m0 = mt * 128, n0 = nt * 128;
    f32x16 acc[2][2];
    {
      const int tn = tile + gridDim.x;
      const bool hn = tn < n_tiles;
      gemm_tile(p.h + (long)m0 * 1024, 1024, p.wt_fn_in + (long)n0 * 1024, 1024, 1024, sA, acc, tid, GEMM_STAGE_ARGS, pre,
                hn ? p.h + (long)((tn % 96) * 128) * 1024 : nullptr, hn ? p.wt_fn_in + (long)((tn / 96) * 128) * 1024 : nullptr);
      pre = hn;
    }
    {
      bf16_t* tb = proj + (long)m0 * 2048 + n0;
      EPIS_BEGIN
        const unsigned lo = 2u * (unsigned)(e_rowl * 2048 + e_coll);
        *(bf16_t*)((char*)(tb + e_rowu * 2048 + e_colu) + lo) = f2bf(val);
      EPI_END
    }
  }
}

static __device__ __forceinline__ void phase_fn_a(const Params& p, char* smem) {
  const int tid = opaque_tid(); const int bid = opaque_bid(); (void)tid; (void)bid;
  bf16_t* sA = (bf16_t*)smem;
  GEMM_STAGE_DECL
  const bf16_t* proj = FN_PROJ(p);
  const int n_tiles = 4 * 96 * 4;
  for (int tile = bid; tile < n_tiles; tile += gridDim.x) {
    const int mt = tile & 3, g = (tile >> 2) & 3, tt = tile >> 4;
    const int m0 = mt * 128, t0 = tt * 128;
    f32x16 acc[2][2];
    gemm_tile(p.tabA + (long)m0 * 256, 256, proj + (long)t0 * 2048 + g * 256, 2048, 256, sA, acc, tid, GEMM_STAGE_ARGS, false, nullptr, nullptr);
    const bool lat = t0 >= NCTX;
    const int L = lat ? LLAT : LCTX;
    const int b = lat ? ((t0 - NCTX) >> 11) : (t0 >> 8);
    const int pos0 = lat ? ((t0 - NCTX) & 2047) : (t0 & 255);
    bf16_t* dst = lat ? FN_XCS_LAT(p) : FN_XCS_CTX(p);
    EPI_BEGIN_OPQ
      const int m = m0 + row;
      const int cs = m >> 8, co = m & 255;
      dst[((long)((b * 4 + g) * 256 + co)) * (2 * L) + cs * L + pos0 + col] = f2bf(val);
    EPI_END
  }
}

static __device__ __forceinline__ void phase_fn_b(const Params& p, char* smem) {
  const int tid = opaque_tid(); const int bid = opaque_bid(); (void)tid; (void)bid;
  bf16_t* sA = (bf16_t*)smem;
  GEMM_STAGE_DECL
  const bf16_t* proj = FN_PROJ(p);
  const int n_lat = 2 * 4 * 16 * 2;
  const int n_ctx = 32 * 4 * 2 * 2;
  const bool rebal = (gridDim.x == 512);
  for (int it_ = bid; it_ < (rebal ? 1024 : n_lat + n_ctx); it_ += gridDim.x) {
    int tile = it_;
    if (rebal) {
      if (it_ < 512) tile = (it_ < 256) ? it_ : (256 + 2 * (it_ - 256));
      else tile = (it_ - 512 < 256) ? -1 : (256 + 2 * (it_ - 768) + 1);
      if (tile < 0) continue;
    }
    int b, g, mt, nt, L, tbase;
    const bf16_t *tab, *xcs;
    if (tile < n_lat) {
      nt = tile & 1; mt = (tile >> 1) & 15; g = (tile >> 5) & 3; b = tile >> 7;
      L = LLAT; tbase = NCTX + b * LLAT; tab = p.tabB_lat; xcs = FN_XCS_LAT(p);
    } else {
      int t2 = tile - n_lat;
      nt = t2 & 1; mt = (t2 >> 1) & 1; g = (t2 >> 2) & 3; b = t2 >> 4;
      L = LCTX; tbase = b * LCTX; tab = p.tabB_ctx; xcs = FN_XCS_CTX(p);
    }
    const int m0 = mt * 128, n0 = nt * 128;
    f32x16 acc[2][2];
    gemm_tile(tab + (long)m0 * (2 * L), 2 * L, xcs + ((long)((b * 4 + g) * 256 + n0)) * (2 * L), 2 * L, 2 * L, sA, acc, tid, GEMM_STAGE_ARGS, false, nullptr, nullptr);
    const float scale = rsqrtf((float)L * 256.0f);
    {
      const int e_lane = tid & 63, e_wave = tid >> 6;
      const int e_wm = e_wave >> 1, e_wn = e_wave & 1;
#pragma unroll
      for (int e_i = 0; e_i < 2; ++e_i)
#pragma unroll
        for (int e_j = 0; e_j < 2; ++e_j) {
          const int rowb = opq(e_wm * 64 + e_i * 32 + 4 * (e_lane >> 5));
          const int ch = g * 256 + n0 + e_wn * 64 + e_j * 32 + (e_lane & 31);
          bf16_t zr[16];
#pragma unroll
          for (int e_r = 0; e_r < 16; ++e_r) zr[e_r] = proj[(long)(tbase + m0 + rowb + 8 * (e_r >> 2) + (e_r & 3)) * 2048 + 1024 + ch];
#pragma unroll
          for (int e_r = 0; e_r < 16; ++e_r)
            p.h[(long)(tbase + m0 + rowb + 8 * (e_r >> 2) + (e_r & 3)) * 1024 + ch] = f2bf(acc[e_i][e_j][e_r] * scale * siluf(bf2f(zr[e_r])));
        }
    }
  }
}

#define HY_UT(p) ((p).big)
#define HY_YT(p) ((p).big + (long)4096 * NTOK)

static __device__ __forceinline__ void phase_hy_in(const Params& p, char* smem) {
  const int tid = opaque_tid(); const int bid = opaque_bid(); (void)tid; (void)bid;
  bf16_t* sA = (bf16_t*)smem;
  GEMM_STAGE_DECL
  bool pre = false;
  bf16_t* uT = HY_UT(p);
  const int n_tiles = 32 * 96;
  for (int tile = bid; tile < n_tiles; tile += gridDim.x) {
    const int nt = tile % 96, mt = tile / 96;
    const int m0 = mt * 128, n0 = nt * 128;
    f32x16 acc[2][2];
    {
      const int tn = tile + gridDim.x;
      const bool hn = tn < n_tiles;
      gemm_tile(p.wt_hy_in + (long)m0 * 1024, 1024, p.h + (long)n0 * 1024, 1024, 1024, sA, acc, tid, GEMM_STAGE_ARGS, pre,
                hn ? p.wt_hy_in + (long)((tn / 96) * 128) * 1024 : nullptr, hn ? p.h + (long)((tn % 96) * 128) * 1024 : nullptr);
      pre = hn;
    }
    {
      bf16_t* tb = uT + (long)m0 * NTOK + n0;
      EPIS_BEGIN
        const unsigned lo = 2u * (unsigned)(e_rowl * NTOK + e_coll);
        *(bf16_t*)((char*)(tb + e_rowu * NTOK + e_colu) + lo) = f2bf(val);
      EPI_END
    }
  }
}

__device__ __forceinline__ int upad(int pos) { return pos + 8 * (pos >> 5); }
static __device__ __forceinline__ void phase_hy_conv(const Params& p, char* smem) {
  const int tid = opaque_tid(); const int bid = opaque_bid();
  bf16_t* sU = (bf16_t*)smem;
  bf16_t* sX1 = sU + 10240;
  bf16_t* sX2 = sX1 + 8192;
  bf16_t* sR0 = sX2 + 8192;
  bf16_t* sR1 = sR0 + 4128;
  const bf16_t* uT = HY_UT(p);
  bf16_t* yT = HY_YT(p);
  const int lane = tid & 63, wave = tid >> 6, l31 = lane & 31, hf = lane >> 5;
  const int n_items = 1024 + 1024;
  for (int it = bid; it < n_items; it += gridDim.x) {
    const bool lat = it < 1024;
    const int ch = lat ? it : (it - 1024);
    const int L = lat ? LLAT : LCTX;
    const int nb = L >> 5;
    const int tok0 = lat ? NCTX : 0;
    const int ntw = lat ? 1 : 2;
    const bf16_t* filt = (lat ? p.filt_lat : p.filt_ctx);
    __syncthreads();
    for (int pc = 0; pc < ntw; ++pc) {
      const int p0 = pc * 4096 + tid * 16;
      const bool has_l = (p0 & (L - 1)) != 0, has_r = ((p0 + 16) & (L - 1)) != 0;
#pragma unroll
      for (int g = 0; g < 3; ++g) {
        const int f = g * 1024 + ch;
        const bf16_t* row = uT + (long)f * NTOK + tok0 + p0;
        const uint4 v0 = *(const uint4*)row, v1 = *(const uint4*)(row + 8);
        float e[18];
        e[0] = has_l ? bf2f(row[-1]) : 0.f;
        e[17] = has_r ? bf2f(row[16]) : 0.f;
        const unsigned vv[8] = {v0.x, v0.y, v0.z, v0.w, v1.x, v1.y, v1.z, v1.w};
#pragma unroll
        for (int q = 0; q < 8; ++q) { e[1 + 2 * q] = bf2f((bf16_t)(vv[q] & 0xffffu)); e[2 + 2 * q] = bf2f((bf16_t)(vv[q] >> 16)); }
        const float w0 = p.hy_conv_w[f], w1 = p.hy_conv_w[3072 + f], w2 = p.hy_conv_w[6144 + f], bb = p.hy_conv_b[f];
        unsigned o[8];
#pragma unroll
        for (int q = 0; q < 8; ++q) {
          const float a0 = e[2 * q] * w0 + e[2 * q + 1] * w1 + e[2 * q + 2] * w2 + bb;
          const float a1 = e[2 * q + 1] * w0 + e[2 * q + 2] * w1 + e[2 * q + 3] * w2 + bb;
          o[q] = pk2(a0, a1);
        }
        bf16_t* dst = (g == 0) ? (sX1 + p0) : (g == 1) ? (sX2 + p0) : (sU + upad(p0));
        uint4 o0, o1;
        o0.x = o[0]; o0.y = o[1]; o0.z = o[2]; o0.w = o[3];
        o1.x = o[4]; o1.y = o[5]; o1.z = o[6]; o1.w = o[7];
        *(uint4*)dst = o0;
        *(uint4*)(dst + 8) = o1;
      }
    }
    const int xa = (L - 1) - l31 + 8 * hf;
    const bf16_t* Rp = (xa & 1) ? (sR1 - 1) : sR0;
    float y1r[2][16];
    for (int order = 0; order < 2; ++order) {
      const bf16_t* fsrc = filt + ((long)(order * 1024 + ch)) * (2 * L);
      for (int x8 = tid; x8 < (2 * L) / 8; x8 += NTHR) {
        const uint4 v = *(const uint4*)(fsrc + 8 * x8);
        *(uint4*)(sR0 + 8 * x8) = v;
        const unsigned vv[4] = {v.x, v.y, v.z, v.w};
#pragma unroll
        for (int q = 0; q < 4; ++q) {
          if (8 * x8 + 2 * q >= 1) sR1[8 * x8 + 2 * q - 1] = (bf16_t)(vv[q] & 0xffffu);
          sR1[8 * x8 + 2 * q] = (bf16_t)(vv[q] >> 16);
        }
      }
      __syncthreads();
      const float dsk = p.hy_d[order * 1024 + ch];
      const bf16_t* gate = order ? sX2 : sX1;
#pragma unroll
      for (int tt = 0; tt < 2; ++tt) {
        if (tt < ntw) {
          int bt, i_blk, dlo, dhi;
          if (lat) { bt = wave >> 1; const int i0 = 32 * (wave & 1); i_blk = i0 + l31; dlo = i0 - 63; dhi = i0 + 31; }
          else { bt = 4 * (2 * wave + tt) + (l31 >> 3); i_blk = l31 & 7; dlo = -7; dhi = 7; }
          const bf16_t* ubase = sU + upad(bt * L);
          const int pos_base = bt * L + 32 * i_blk + 4 * hf;
          f32x16 acc;
#pragma unroll
          for (int r = 0; r < 16; ++r) acc[r] = 0.f;
          for (int d = dlo; d <= dhi; ++d) {
            const int jb = i_blk - d;
            const bool valid = (unsigned)jb < (unsigned)nb;
            const int jc = valid ? jb : 0;
            const bf16_t* bp = ubase + 40 * jc + 8 * hf;
            const unsigned* ap = (const unsigned*)(Rp + (xa - 32 * d));
#pragma unroll
            for (int ks2 = 0; ks2 < 2; ++ks2) {
              union { unsigned u[4]; bf16x8 v; } A;
              A.u[0] = ap[8 * ks2 + 0]; A.u[1] = ap[8 * ks2 + 1]; A.u[2] = ap[8 * ks2 + 2]; A.u[3] = ap[8 * ks2 + 3];
              union { uint4 q; bf16x8 v; } B;
              B.q = *(const uint4*)(bp + 16 * ks2);
              if (!valid) { B.q.x = 0u; B.q.y = 0u; B.q.z = 0u; B.q.w = 0u; }
              acc = __builtin_amdgcn_mfma_f32_32x32x16_bf16(A.v, B.v, acc, 0, 0, 0);
            }
          }
#pragma unroll
          for (int g = 0; g < 4; ++g) {
            const int pos = pos_base + 8 * g;
            const uint2 gg = *(const uint2*)(gate + pos);
            const uint2 uo = *(const uint2*)(sU + upad(pos));
            const float g0 = bf2f((bf16_t)(gg.x & 0xffffu)), g1 = bf2f((bf16_t)(gg.x >> 16)), g2 = bf2f((bf16_t)(gg.y & 0xffffu)), g3 = bf2f((bf16_t)(gg.y >> 16));
            const float u0 = bf2f((bf16_t)(uo.x & 0xffffu)), u1 = bf2f((bf16_t)(uo.x >> 16)), u2 = bf2f((bf16_t)(uo.y & 0xffffu)), u3 = bf2f((bf16_t)(uo.y >> 16));
            y1r[tt][4 * g + 0] = g0 * (acc[4 * g + 0] + dsk * u0);
            y1r[tt][4 * g + 1] = g1 * (acc[4 * g + 1] + dsk * u1);
            y1r[tt][4 * g + 2] = g2 * (acc[4 * g + 2] + dsk * u2);
            y1r[tt][4 * g + 3] = g3 * (acc[4 * g + 3] + dsk * u3);
          }
        }
      }
      __syncthreads();
#pragma unroll
      for (int tt = 0; tt < 2; ++tt) {
        if (tt < ntw) {
          int bt, i_blk;
          if (lat) { bt = wave >> 1; i_blk = 32 * (wave & 1) + l31; }
          else { bt = 4 * (2 * wave + tt) + (l31 >> 3); i_blk = l31 & 7; }
          const int pos_base = bt * L + 32 * i_blk + 4 * hf;
          if (order == 0) {
#pragma unroll
            for (int g = 0; g < 4; ++g) {
              uint2 w;
              w.x = pk2(y1r[tt][4 * g + 0], y1r[tt][4 * g + 1]);
              w.y = pk2(y1r[tt][4 * g + 2], y1r[tt][4 * g + 3]);
              *(uint2*)(sU + upad(pos_base + 8 * g)) = w;
            }
          } else {
            uint2 zz[4];
#pragma unroll
            for (int g = 0; g < 4; ++g) zz[g] = *(const uint2*)(uT + (long)(3072 + ch) * NTOK + tok0 + pos_base + 8 * g);
#pragma unroll
            for (int g = 0; g < 4; ++g) {
              const long gp = (long)tok0 + pos_base + 8 * g;
              const float z0 = bf2f((bf16_t)(zz[g].x & 0xffffu)), z1 = bf2f((bf16_t)(zz[g].x >> 16)), z2 = bf2f((bf16_t)(zz[g].y & 0xffffu)), z3 = bf2f((bf16_t)(zz[g].y >> 16));
              uint2 w;
              w.x = pk2(y1r[tt][4 * g + 0] * siluf(z0), y1r[tt][4 * g + 1] * siluf(z1));
              w.y = pk2(y1r[tt][4 * g + 2] * siluf(z2), y1r[tt][4 * g + 3] * siluf(z3));
              *(uint2*)(yT + (long)ch * NTOK + gp) = w;
            }
          }
        }
      }
    }
  }
}

static __device__ __forceinline__ void phase_hy_transpose(const Params& p, char* smem) {
  const int tid = opaque_tid(); const int bid = opaque_bid(); (void)tid; (void)bid;
  bf16_t* t = (bf16_t*)smem;
  const bf16_t* yT = HY_YT(p);
  const int n_items = 16 * 192;
  for (int it = bid; it < n_items; it += gridDim.x) {
    const int ct = it & 15, tt = it >> 4;
    const int c0 = ct * 64, t0 = tt * 64;
    __syncthreads();
    for (int i = tid; i < 64 * 64; i += NTHR) {
      int r = i >> 6, cc = i & 63;
      t[cc * 66 + r] = yT[(long)(c0 + r) * NTOK + t0 + cc];
    }
    __syncthreads();
    for (int i = tid; i < 64 * 64; i += NTHR) {
      int r = i >> 6, cc = i & 63;
      p.h[(long)(t0 + r) * 1024 + c0 + cc] = t[r * 66 + cc];
    }
  }
}

#define XB_TMO      128
#define XB_XCNT(j)  (256  + 64 * (j))
#define XB_XSUB(j)  (1280 + 64 * (j))
#define XB_XGEN(j)  (2304 + 64 * (j))
#define XB_TOP      3328
#define XB_TOPGEN   3392
#define XCD_BAR_WORDS 3456
#define XB_SPIN_CAP (1u << 18)
#define LAS __attribute__((address_space(3)))
__device__ __forceinline__ unsigned xb_ld(unsigned* p)              { return __hip_atomic_load(p, __ATOMIC_RELAXED, __HIP_MEMORY_SCOPE_AGENT); }
__device__ __forceinline__ unsigned xb_add(unsigned* p, unsigned v) { return __hip_atomic_fetch_add(p, v, __ATOMIC_RELAXED, __HIP_MEMORY_SCOPE_AGENT); }
__device__ __forceinline__ unsigned xb_xcc_id() { return (unsigned)__builtin_amdgcn_s_getreg((3 << 11) | 20) & 0xFu; }
#define XB_SPIN(cond, bar) do { unsigned _sp = 0; while (cond) { __builtin_amdgcn_s_sleep(1); \
    if ((++_sp & 255u) == 0u) { if (xb_ld(&(bar)[XB_TMO])) break; if (_sp > XB_SPIN_CAP) { atomicAdd(&(bar)[XB_TMO], 1u); break; } } } } while (0)
struct XcdBarrier { unsigned* bar; unsigned x; volatile LAS unsigned* st; };
__device__ __forceinline__ XcdBarrier xcd_barrier_post(unsigned* bar, volatile LAS unsigned* st) {
    XcdBarrier b; b.bar = bar; b.x = xb_xcc_id(); b.st = st;
    if (threadIdx.x == 0) (void)xb_add(&bar[XB_XCNT(b.x)], 1u);
    return b;
}
__device__ __forceinline__ void xcd_barrier_complete(unsigned* bar, unsigned x, unsigned& nloc, unsigned& nx) {
    const unsigned G = gridDim.x * gridDim.y * gridDim.z;
    unsigned sum, cnt, mine, sp = 0u;
    for (;;) {
        sum = 0u; cnt = 0u; mine = 0u;
#pragma unroll
        for (unsigned j = 0; j < 16; ++j) { const unsigned c = xb_ld(&bar[XB_XCNT(j)]); sum += c; cnt += (c > 0u) ? 1u : 0u; mine = (j == x) ? c : mine; }
        if (sum == G) break;
        __builtin_amdgcn_s_sleep(1);
        if ((++sp & 255u) == 0u) { if (xb_ld(&bar[XB_TMO])) break; if (sp > XB_SPIN_CAP) { atomicAdd(&bar[XB_TMO], 1u); break; } }
    }
    nloc = mine > 0u ? mine : 1u; nx = cnt > 0u ? cnt : 1u;
}
__device__ __forceinline__ void xcd_barrier(const XcdBarrier& b) {
    asm volatile("s_waitcnt vmcnt(0)" ::: "memory");
    __syncthreads();
    if (threadIdx.x == 0) {
        unsigned* bar = b.bar;
        __builtin_amdgcn_s_waitcnt(0);
        unsigned nloc = b.st[0], nx = b.st[1];
        if (nloc == 0u) { xcd_barrier_complete(bar, b.x, nloc, nx); b.st[0] = nloc; b.st[1] = nx; }
        const unsigned old = xb_add(&bar[XB_XSUB(b.x)], 1u);
        const unsigned gen = old / nloc;
        if (old + 1u == (gen + 1u) * nloc) {
            __builtin_amdgcn_fence(__ATOMIC_RELEASE, "agent");
            asm volatile("s_waitcnt vmcnt(0)" ::: "memory");
            const unsigned og = xb_add(&bar[XB_TOP], 1u);
            const unsigned tg = og / nx;
            if (og + 1u == (tg + 1u) * nx) xb_add(&bar[XB_TOPGEN], 1u);
            else XB_SPIN(xb_ld(&bar[XB_TOPGEN]) == tg, bar);
            __builtin_amdgcn_fence(__ATOMIC_ACQUIRE, "agent");
            xb_add(&bar[XB_XGEN(b.x)], 1u);
            asm volatile("s_waitcnt vmcnt(0)" ::: "memory");
        } else {
            XB_SPIN(xb_ld(&bar[XB_XGEN(b.x)]) == gen, bar);
            __builtin_amdgcn_fence(__ATOMIC_ACQUIRE, "agent");
            asm volatile("s_waitcnt vmcnt(0)" ::: "memory");
        }
    }
    __syncthreads();
}

__global__ void __launch_bounds__(NTHR, 2) mega(Params p) {
  cg::grid_group grid = cg::this_grid();
  __shared__ __attribute__((aligned(16))) char smem[SMEM_BYTES];
  __shared__ uint4 xb_words;
  if (threadIdx.x == 0) xb_words = make_uint4(0u, 0u, 0u, 0u);
  __syncthreads();
  const XcdBarrier xb = xcd_barrier_post(p.bar, (volatile LAS unsigned*)&xb_words);
  if (p.use_cg) grid.sync();
#define GSYNC() xcd_barrier(xb)
#define REP(id) for (int rep##id = 0; rep##id < (PROBE == (id) ? 3 : 1); ++rep##id)
  REP(19) {
  REP(1) { p0_mod(p, smem); }
  REP(2) { p0_filt_mlp(p, smem); }
  REP(3) { p0_tables(p, smem); }
  REP(4) { p0_weights(p, smem); }
  GSYNC();
  }
  if (PROBE == 5) { for (int rep = 0; rep < 40; ++rep) GSYNC(); }
  for (int layer = 0; layer < 4; ++layer) {
    const int kind = layer % 3, j = layer / 3;
    REP(6) { phase_norm(p, layer); if (layer == 1) phase_filt_main(p, smem); GSYNC(); }
    const bf16_t* wt_out;
    if (kind == 0) {
      REP(7) { phase_gla_in(p, j ? p.wt_gla_in1 : p.wt_gla_in0, smem); GSYNC(); }
      for (int rep = 0; rep < (PROBE == 17 ? 3 : 1); ++rep) { phase_gla_prep(p, j, smem, rep + 1 < (PROBE == 17 ? 3 : 1)); GSYNC(); }
      REP(8) { phase_gla_scan(p, j, 0, smem); GSYNC(); }
      REP(9) { phase_gla_scan(p, j, 1, smem); GSYNC(); }
      REP(10) { phase_gla_combine(p, j); GSYNC(); }
      wt_out = j ? p.wt_gla_out1 : p.wt_gla_out0;
    } else if (kind == 1) {
      REP(11) { phase_fn_in(p, smem); GSYNC(); }
      REP(12) { phase_fn_a(p, smem); GSYNC(); }
      REP(13) { phase_fn_b(p, smem); GSYNC(); }
      wt_out = p.wt_fn_out;
    } else {
      REP(14) { phase_hy_in(p, smem); GSYNC(); }
      REP(15) { phase_hy_conv(p, smem); GSYNC(); }
      REP(16) { phase_hy_transpose(p, smem); GSYNC(); }
      wt_out = p.wt_hy_out;
    }
    for (int rep = 0; rep < (PROBE == 18 ? 3 : 1); ++rep) { phase_gemm_out(p, layer, wt_out, smem, rep + 1 < (PROBE == 18 ? 3 : 1)); GSYNC(); }
  }
  phase_final_norm(p);
}

static inline size_t align_up(size_t x) { return (x + 255) & ~(size_t)255; }

extern "C" void kernel_launch(void* const* d_in, const int* in_sizes, int n_in, void* d_out,
                              int out_size, void* d_ws, size_t ws_size, hipStream_t stream) {
  static int grid_blocks = 0;
  if (!grid_blocks) {
    int dev = 0, cus = 0, per_cu = 0;
    hipGetDevice(&dev);
    hipDeviceGetAttribute(&cus, hipDeviceAttributeMultiprocessorCount, dev);
    hipOccupancyMaxActiveBlocksPerMultiprocessor(&per_cu, mega, NTHR, 0);
    if (per_cu > 2) per_cu = 2;
    if (per_cu < 1) per_cu = 1;
    grid_blocks = cus * per_cu;
  }
  Params p{};
  const float* const* in = (const float* const*)d_in;
  p.x_prompt = in[0]; p.x_sample = in[1]; p.state_gla = in[2]; p.c = in[3]; p.c_ctx = in[4];
  p.mod_w = in[5]; p.mod_b = in[6]; p.norm_g = in[7]; p.final_norm_g = in[8];
  p.gla_w_in = in[9]; p.gla_w_dec = in[10]; p.gla_b_dec = in[11]; p.gla_onorm_g = in[12]; p.gla_w_out = in[13];
  p.fn_w_in = in[14]; p.fn_w_out = in[15];
  p.hy_w_in = in[16]; p.hy_conv_w = in[17]; p.hy_conv_b = in[18];
  p.hy_w1 = in[19]; p.hy_b1 = in[20]; p.hy_w2 = in[21]; p.hy_b2 = in[22]; p.hy_w3 = in[23]; p.hy_b3 = in[24];
  p.hy_w4 = in[25]; p.hy_freq = in[26]; p.hy_d = in[27]; p.hy_w_out = in[28];
  p.out = (float*)d_out;
  char* w = (char*)d_ws;
  size_t off = 0;
  auto take = [&](size_t bytes) { char* r = w + off; off = align_up(off + bytes); return r; };
  p.h = (bf16_t*)take((size_t)NTOK * 1024 * 2);
  p.big = (bf16_t*)take((size_t)156 * 1024 * 1024);
  p.wt_gla_in0 = (bf16_t*)take((size_t)3200 * 1024 * 2);
  p.wt_gla_in1 = (bf16_t*)take((size_t)3200 * 1024 * 2);
  p.wt_gla_out0 = (bf16_t*)take((size_t)1024 * 1024 * 2);
  p.wt_gla_out1 = (bf16_t*)take((size_t)1024 * 1024 * 2);
  p.wt_fn_in = (bf16_t*)take((size_t)2048 * 1024 * 2);
  p.wt_fn_out = (bf16_t*)take((size_t)1024 * 1024 * 2);
  p.wt_hy_in = (bf16_t*)take((size_t)4096 * 1024 * 2);
  p.wt_hy_out = (bf16_t*)take((size_t)1024 * 1024 * 2);
  p.tabA = (bf16_t*)take((size_t)512 * 256 * 2);
  p.tabB_ctx = (bf16_t*)take((size_t)256 * 512 * 2);
  p.tabB_lat = (bf16_t*)take((size_t)2048 * 4096 * 2);
  p.filt_ctx = (bf16_t*)take((size_t)2 * 1024 * 512 * 2);
  p.filt_lat = (bf16_t*)take((size_t)2 * 1024 * 4096 * 2);
  p.filt_a3 = (float*)take((size_t)2304 * 64 * 4);
  p.bar = (unsigned*)take((size_t)XCD_BAR_WORDS * 4 + (size_t)4 * 3 * 3072 * 4);
  p.modv = (float*)(p.bar + XCD_BAR_WORDS);
  p.use_cg = 0; p.pad = 0;
  hipMemsetAsync(p.bar, 0, (size_t)XCD_BAR_WORDS * 4 + (size_t)4 * 3 * 3072 * 4, stream);
  void* args[] = {&p};
  hipError_t e = hipLaunchCooperativeKernel((void*)mega, dim3(grid_blocks), dim3(NTHR), args, 0, stream);
  if (e != hipSuccess) fprintf(stderr, "cooperative launch failed: %s (grid %d, ws %zu need %zu)\n", hipGetErrorString(e), grid_blocks, ws_size, off);
}
```

```cpp
#include <hip/hip_runtime.h>
#include <hip/hip_cooperative_groups.h>
#include <cstdio>
namespace cg = cooperative_groups;

typedef unsigned short bf16_t;
typedef short bf16x8 __attribute__((ext_vector_type(8)));
typedef float f32x16 __attribute__((ext_vector_type(16)));

#ifndef PROBE
#define PROBE 0
#endif
#define NTOK 12288
#define NCTX 8192
#define DM 1024
#define LCTX 256
#define LLAT 2048
#define NTHR 256
#define SMEM_BYTES 73728
#define LDSS 72
#define TWO_PI 6.283185307179586f

struct Params {
  const float *x_prompt, *x_sample, *state_gla, *c, *c_ctx, *mod_w, *mod_b, *norm_g, *final_norm_g;
  const float *gla_w_in, *gla_w_dec, *gla_b_dec, *gla_onorm_g, *gla_w_out;
  const float *fn_w_in, *fn_w_out;
  const float *hy_w_in, *hy_conv_w, *hy_conv_b, *hy_w1, *hy_b1, *hy_w2, *hy_b2, *hy_w3, *hy_b3, *hy_w4, *hy_freq, *hy_d, *hy_w_out;
  float* out;
  bf16_t* h;
  bf16_t* big;
  float* modv;
  bf16_t* wt_gla_in0; bf16_t* wt_gla_in1; bf16_t* wt_gla_out0; bf16_t* wt_gla_out1;
  bf16_t* wt_fn_in; bf16_t* wt_fn_out; bf16_t* wt_hy_in; bf16_t* wt_hy_out;
  bf16_t* tabA; bf16_t* tabB_ctx; bf16_t* tabB_lat;
  bf16_t* filt_ctx; bf16_t* filt_lat;
  float* filt_a3;
  unsigned* bar;
  int use_cg; int pad;
};

typedef __bf16 bf16n2 __attribute__((ext_vector_type(2)));
typedef float f32n2 __attribute__((ext_vector_type(2)));
__device__ __forceinline__ unsigned pk2(float a, float b) {
  f32n2 v = {a, b};
  return __builtin_bit_cast(unsigned, __builtin_convertvector(v, bf16n2));
}
__device__ __forceinline__ bf16_t f2bf(float x) { return (bf16_t)(pk2(x, 0.f) & 0xffffu); }
__device__ __forceinline__ float bf2f(bf16_t b) { return __uint_as_float(((unsigned)b) << 16); }
__device__ __forceinline__ float siluf(float x) { return x / (1.f + expf(-x)); }
__device__ __forceinline__ float logsigf(float x) { return fminf(x, 0.f) - log1pf(expf(-fabsf(x))); }
__device__ __forceinline__ int opaque_tid() { int t = threadIdx.x; asm volatile("" : "+v"(t)); return t; }
__device__ __forceinline__ int opq(int t) { asm volatile("" : "+v"(t)); return t; }
__device__ __forceinline__ int opaque_bid() { int b = blockIdx.x; asm volatile("" : "+s"(b)); return b; }
__device__ __forceinline__ int first_item_(int bid, int off) {
  int G = gridDim.x;
  return (int)((bid + G - (off % G)) % G);
}
#define first_item(off) first_item_(bid, off)

#define GEMM_BUF (2 * 128 * LDSS)
#define GEMM_STAGE_DECL uint4 g_xa0, g_xa1, g_xa2, g_xa3, g_xb0, g_xb1, g_xb2, g_xb3, g_ya0, g_ya1, g_ya2, g_ya3, g_yb0, g_yb1, g_yb2, g_yb3;
#define GEMM_STAGE_ARGS g_xa0, g_xa1, g_xa2, g_xa3, g_xb0, g_xb1, g_xb2, g_xb3, g_ya0, g_ya1, g_ya2, g_ya3, g_yb0, g_yb1, g_yb2, g_yb3
__device__ __forceinline__ void gemm_tile(const bf16_t* __restrict__ A, long lda, const bf16_t* __restrict__ B, long ldb,
                                          int K, bf16_t* sbase, f32x16 (&acc)[2][2], const int tid,
                                          uint4& xa0, uint4& xa1, uint4& xa2, uint4& xa3, uint4& xb0, uint4& xb1, uint4& xb2, uint4& xb3, uint4& ya0, uint4& ya1, uint4& ya2, uint4& ya3, uint4& yb0, uint4& yb1, uint4& yb2, uint4& yb3,
                                          const bool preloaded, const bf16_t* An, const bf16_t* Bn) {
  const int lane = tid & 63, wave = tid >> 6;
  const int wm = wave >> 1, wn = wave & 1;
  const int lr = tid >> 3, lc = (tid & 7) * 8;
#pragma unroll
  for (int i = 0; i < 2; ++i)
#pragma unroll
    for (int j = 0; j < 2; ++j)
#pragma unroll
      for (int r = 0; r < 16; ++r) acc[i][j][r] = 0.f;
  const bf16_t* pa = A + (long)lr * lda + lc;
  const bf16_t* pb = B + (long)lr * ldb + lc;
  const bf16_t* pan = An + (long)lr * lda + lc;
  const bf16_t* pbn = Bn + (long)lr * ldb + lc;
#define GEMM_GLOAD_(S, PA, PB, ko)                            \
  S##a0 = *(const uint4*)(PA + (ko));                      \
  S##a1 = *(const uint4*)(PA + 32 * lda + (ko));           \
  S##a2 = *(const uint4*)(PA + 64 * lda + (ko));           \
  S##a3 = *(const uint4*)(PA + 96 * lda + (ko));           \
  S##b0 = *(const uint4*)(PB + (ko));                      \
  S##b1 = *(const uint4*)(PB + 32 * ldb + (ko));           \
  S##b2 = *(const uint4*)(PB + 64 * ldb + (ko));           \
  S##b3 = *(const uint4*)(PB + 96 * ldb + (ko));
#define GEMM_GLOAD(S, ko) GEMM_GLOAD_(S, pa, pb, ko)
#define GEMM_GLOADN(S, ko) GEMM_GLOAD_(S, pan, pbn, ko)
#define GEMM_LSTORE(S, buf)                                                                      \
  { bf16_t* wa = sbase + (buf) * GEMM_BUF + lr * LDSS + lc; bf16_t* wb = wa + 128 * LDSS;         \
    *(uint4*)(wa) = S##a0; *(uint4*)(wa + 32 * LDSS) = S##a1; *(uint4*)(wa + 64 * LDSS) = S##a2; *(uint4*)(wa + 96 * LDSS) = S##a3; \
    *(uint4*)(wb) = S##b0; *(uint4*)(wb + 32 * LDSS) = S##b1; *(uint4*)(wb + 64 * LDSS) = S##b2; *(uint4*)(wb + 96 * LDSS) = S##b3; }
#define GEMM_COMPUTE(buf)                                                                         \
  { __builtin_amdgcn_s_setprio(1); const bf16_t* ra = sbase + (buf) * GEMM_BUF + (wm * 64 + (lane & 31)) * LDSS + (lane >> 5) * 8; \
    const bf16_t* rb = sbase + (buf) * GEMM_BUF + 128 * LDSS + (wn * 64 + (lane & 31)) * LDSS + (lane >> 5) * 8; \
    _Pragma("unroll") for (int kk = 0; kk < 4; ++kk) {                                            \
      const bf16x8 af0 = *(const bf16x8*)(ra + kk * 16), af1 = *(const bf16x8*)(ra + 32 * LDSS + kk * 16); \
      const bf16x8 bf0 = *(const bf16x8*)(rb + kk * 16), bf1 = *(const bf16x8*)(rb + 32 * LDSS + kk * 16); \
      acc[0][0] = __builtin_amdgcn_mfma_f32_32x32x16_bf16(af0, bf0, acc[0][0], 0, 0, 0);         \
      acc[0][1] = __builtin_amdgcn_mfma_f32_32x32x16_bf16(af0, bf1, acc[0][1], 0, 0, 0);         \
      acc[1][0] = __builtin_amdgcn_mfma_f32_32x32x16_bf16(af1, bf0, acc[1][0], 0, 0, 0);         \
      acc[1][1] = __builtin_amdgcn_mfma_f32_32x32x16_bf16(af1, bf1, acc[1][1], 0, 0, 0);         \
    } __builtin_amdgcn_s_setprio(0); }
  const int nk = K >> 6;
  const bool hasn = (An != nullptr);
  if (!preloaded) {
    GEMM_GLOAD(x, 0)
    if (nk > 1) { GEMM_GLOAD(y, 64) }
  }
  __syncthreads();
  GEMM_LSTORE(x, 0)
  if (nk > 2) { GEMM_GLOAD(x, 128) }
  __syncthreads();
  for (int kt = 0; kt < nk; kt += 2) {
    GEMM_COMPUTE(0)
    if (kt + 1 < nk) { GEMM_LSTORE(y, 1) }
    if (kt + 3 < nk) { GEMM_GLOAD(y, (kt + 3) * 64) }
    else if (hasn && kt + 3 == nk + 1) { GEMM_GLOADN(y, 64) }
    __syncthreads();
    if (kt + 1 < nk) {
      GEMM_COMPUTE(1)
      if (kt + 2 < nk) { GEMM_LSTORE(x, 0) }
      if (kt + 4 < nk) { GEMM_GLOAD(x, (kt + 4) * 64) }
      else if (hasn && kt + 4 == nk) { GEMM_GLOADN(x, 0) }
      __syncthreads();
    }
  }
}

__device__ __forceinline__ void gemm_tile_h(const bf16_t* __restrict__ A, long lda, const bf16_t* __restrict__ B, long ldb,
                                            int K, bf16_t* sbase, f32x16 (&acc)[2], const int tid) {
  const int lane = tid & 63, wave = tid >> 6;
  const int wm = wave >> 1, wn = wave & 1;
  const int lr = tid >> 3, lc = (tid & 7) * 8;
#pragma unroll
  for (int i = 0; i < 2; ++i)
#pragma unroll
    for (int r = 0; r < 16; ++r) acc[i][r] = 0.f;
  const bf16_t* pa = A + (long)lr * lda + lc;
  const bf16_t* pb = B + (long)lr * ldb + lc;
  uint4 xa0, xa1, xa2, xa3, xb0, xb1;
  uint4 ya0, ya1, ya2, ya3, yb0, yb1;
#define GEMMH_GLOAD(S, ko)                                 \
  S##a0 = *(const uint4*)(pa + (ko));                      \
  S##a1 = *(const uint4*)(pa + 32 * lda + (ko));           \
  S##a2 = *(const uint4*)(pa + 64 * lda + (ko));           \
  S##a3 = *(const uint4*)(pa + 96 * lda + (ko));           \
  S##b0 = *(const uint4*)(pb + (ko));                      \
  S##b1 = *(const uint4*)(pb + 32 * ldb + (ko));
#define GEMMH_LSTORE(S, buf)                                                                     \
  { bf16_t* wa = sbase + (buf) * GEMM_BUF + lr * LDSS + lc; bf16_t* wb = wa + 128 * LDSS;         \
    *(uint4*)(wa) = S##a0; *(uint4*)(wa + 32 * LDSS) = S##a1; *(uint4*)(wa + 64 * LDSS) = S##a2; *(uint4*)(wa + 96 * LDSS) = S##a3; \
    *(uint4*)(wb) = S##b0; *(uint4*)(wb + 32 * LDSS) = S##b1; }
#define GEMMH_COMPUTE(buf)                                                                        \
  { const bf16_t* ra = sbase + (buf) * GEMM_BUF + (wm * 64 + (lane & 31)) * LDSS + (lane >> 5) * 8; \
    const bf16_t* rb = sbase + (buf) * GEMM_BUF + 128 * LDSS + (wn * 32 + (lane & 31)) * LDSS + (lane >> 5) * 8; \
    _Pragma("unroll") for (int kk = 0; kk < 4; ++kk) {                                            \
      const bf16x8 af0 = *(const bf16x8*)(ra + kk * 16), af1 = *(const bf16x8*)(ra + 32 * LDSS + kk * 16); \
      const bf16x8 bf0 = *(const bf16x8*)(rb + kk * 16);                                          \
      acc[0] = __builtin_amdgcn_mfma_f32_32x32x16_bf16(af0, bf0, acc[0], 0, 0, 0);               \
      acc[1] = __builtin_amdgcn_mfma_f32_32x32x16_bf16(af1, bf0, acc[1], 0, 0, 0);               \
    } }
  const int nk = K >> 6;
  GEMMH_GLOAD(x, 0)
  if (nk > 1) { GEMMH_GLOAD(y, 64) }
  __syncthreads();
  GEMMH_LSTORE(x, 0)
  if (nk > 2) { GEMMH_GLOAD(x, 128) }
  __syncthreads();
  for (int kt = 0; kt < nk; kt += 2) {
    if (kt + 1 < nk) { GEMMH_LSTORE(y, 1) }
    if (kt + 3 < nk) { GEMMH_GLOAD(y, (kt + 3) * 64) }
    GEMMH_COMPUTE(0)
    __syncthreads();
    if (kt + 1 < nk) {
      if (kt + 2 < nk) { GEMMH_LSTORE(x, 0) }
      if (kt + 4 < nk) { GEMMH_GLOAD(x, (kt + 4) * 64) }
      GEMMH_COMPUTE(1)
      __syncthreads();
    }
  }
}

#define EPI_BEGIN_(ROWEXPR)                                                        \
  {                                                                                \
    const int e_lane = tid & 63, e_wave = tid >> 6;                                \
    const int e_wm = e_wave >> 1, e_wn = e_wave & 1;                               \
    _Pragma("unroll") for (int e_i = 0; e_i < 2; ++e_i)                            \
    _Pragma("unroll") for (int e_j = 0; e_j < 2; ++e_j)                            \
    _Pragma("unroll") for (int e_r = 0; e_r < 16; ++e_r) {                         \
      const int row = ROWEXPR;                                                     \
      const int col = e_wn * 64 + e_j * 32 + (e_lane & 31);                        \
      const float val = acc[e_i][e_j][e_r];
#define EPI_BEGIN EPI_BEGIN_(e_wm * 64 + e_i * 32 + 8 * (e_r >> 2) + 4 * (e_lane >> 5) + (e_r & 3))
#define EPI_BEGIN_OPQ EPI_BEGIN_(opq(e_wm * 64 + e_i * 32 + 8 * (e_r >> 2) + 4 * (e_lane >> 5)) + (e_r & 3))
#define EPI_END }}
#define EPIS_BEGIN                                                                 \
  {                                                                                \
    const int e_lane = tid & 63, e_wave = tid >> 6;                                \
    const int e_rowl = (e_wave >> 1) * 64 + 4 * (e_lane >> 5);                     \
    const int e_coll = (e_wave & 1) * 64 + (e_lane & 31);                          \
    _Pragma("unroll") for (int e_i = 0; e_i < 2; ++e_i)                            \
    _Pragma("unroll") for (int e_j = 0; e_j < 2; ++e_j)                            \
    _Pragma("unroll") for (int e_r = 0; e_r < 16; ++e_r) {                         \
      const int e_rowu = e_i * 32 + 8 * (e_r >> 2) + (e_r & 3);                    \
      const int e_colu = e_j * 32;                                                 \
      const float val = acc[e_i][e_j][e_r];

__device__ __forceinline__ int tok_which(int t) { return t < NCTX ? 0 : 1 + ((t - NCTX) >> 11); }

static __device__ __forceinline__ void p0_mod(const Params& p, char* smem) {
  const int tid = opaque_tid(); const int bid = opaque_bid(); (void)tid; (void)bid;
  float* sc = (float*)smem;
  float* red = sc + 3 * 1024;
  for (int it = first_item(0); it < 192; it += gridDim.x) {
    __syncthreads();
    for (int i = tid; i < 3 * 1024; i += NTHR) {
      const int w = i >> 10, d = i & 1023;
      sc[i] = siluf((w == 0) ? p.c_ctx[d] : p.c[(w - 1) * 1024 + d]);
    }
    __syncthreads();
    const int l = it / 48, e0 = (it % 48) * 64;
    const int col = tid & 63, dq = tid >> 6;
    float a0 = 0.f, a1 = 0.f, a2 = 0.f;
    const float* wp = p.mod_w + ((long)l * 1024 + dq * 256) * 3072 + e0 + col;
    for (int db = 0; db < 256; db += 16) {
      float wv[16];
#pragma unroll
      for (int d = 0; d < 16; ++d) wv[d] = wp[(long)(db + d) * 3072];
#pragma unroll
      for (int d = 0; d < 16; ++d) {
        a0 += sc[dq * 256 + db + d] * wv[d];
        a1 += sc[1024 + dq * 256 + db + d] * wv[d];
        a2 += sc[2048 + dq * 256 + db + d] * wv[d];
      }
    }
    red[(dq * 3 + 0) * 64 + col] = a0;
    red[(dq * 3 + 1) * 64 + col] = a1;
    red[(dq * 3 + 2) * 64 + col] = a2;
    __syncthreads();
    if (tid < 192) {
      const int w = tid >> 6, cc = tid & 63;
      const float sum = red[(0 * 3 + w) * 64 + cc] + red[(1 * 3 + w) * 64 + cc] + red[(2 * 3 + w) * 64 + cc] + red[(3 * 3 + w) * 64 + cc];
      p.modv[(l * 3 + w) * 3072 + e0 + cc] = sum + p.mod_b[l * 3072 + e0 + cc];
    }
  }
}

static __device__ __forceinline__ void p0_filt_mlp(const Params& p, char* smem) {
  const int tid = opaque_tid(); const int bid = opaque_bid(); (void)tid; (void)bid;
  float* z = (float*)smem;
  float* a = z + 16 * 33;
  float* b = a + 1024;
  float* wS = b + 1024;
  for (int it = first_item(192); it < 144; it += gridDim.x) {
    const int lt = (it < 128) ? 1 : 0;
    const int L = lt ? LLAT : LCTX;
    const int p0 = (lt ? it : (it - 128)) * 16;
    float* a3 = p.filt_a3 + (long)(lt ? 256 : 0) * 64;
    __syncthreads();
    for (int i = tid; i < 16 * 33; i += NTHR) {
      const int pp = i / 33, j = i % 33;
      const int l = p0 + pp;
      const float t = (float)l / (float)(L - 1);
      const float w = TWO_PI * (float)l / (float)L;
      float v;
      if (j == 0) v = t;
      else {
        const int bi = (j - 1) & 15;
        const float f = 1e-4f + (float)bi * ((15.0f - 1e-4f) / 15.0f);
        v = (j <= 16) ? cosf(f * w) : -sinf(f * w);
      }
      z[i] = v;
    }
    const int n = opq(tid & 63), pg = opq(tid >> 6);
    const float fr = p.hy_freq[n];
    for (int i = tid; i < 2112; i += NTHR) wS[i] = p.hy_w1[i];
    __syncthreads();
    {
      float acc[4];
#pragma unroll
      for (int q = 0; q < 4; ++q) acc[q] = p.hy_b1[n];
#pragma unroll 3
      for (int jn = 0; jn < 33; ++jn) {
        const float w = wS[jn * 64 + n];
#pragma unroll
        for (int q = 0; q < 4; ++q) acc[q] += z[(pg * 4 + q) * 33 + jn] * w;
      }
#pragma unroll
      for (int q = 0; q < 4; ++q) a[(pg * 4 + q) * 64 + n] = sinf(fr * acc[q]);
    }
    __syncthreads();
    for (int i = tid; i < 4096; i += NTHR) wS[i] = p.hy_w2[i];
    __syncthreads();
    {
      float acc[4];
#pragma unroll
      for (int q = 0; q < 4; ++q) acc[q] = p.hy_b2[n];
#pragma unroll 4
      for (int jn = 0; jn < 64; ++jn) {
        const float w = wS[jn * 64 + n];
#pragma unroll
        for (int q = 0; q < 4; ++q) acc[q] += a[(pg * 4 + q) * 64 + jn] * w;
      }
#pragma unroll
      for (int q = 0; q < 4; ++q) b[(pg * 4 + q) * 64 + n] = sinf(fr * acc[q]);
    }
    __syncthreads();
    for (int i = tid; i < 4096; i += NTHR) wS[i] = p.hy_w3[i];
    __syncthreads();
    {
      float acc[4];
#pragma unroll
      for (int q = 0; q < 4; ++q) acc[q] = p.hy_b3[n];
#pragma unroll 4
      for (int jn = 0; jn < 64; ++jn) {
        const float w = wS[jn * 64 + n];
#pragma unroll
        for (int q = 0; q < 4; ++q) acc[q] += b[(pg * 4 + q) * 64 + jn] * w;
      }
#pragma unroll
      for (int q = 0; q < 4; ++q) a3[(long)(p0 + pg * 4 + q) * 64 + n] = sinf(fr * acc[q]);
    }
  }
}

static __device__ __forceinline__ void phase_filt_main(const Params& p, char* smem) {
  const int tid = opaque_tid(); const int bid = opaque_bid(); (void)tid; (void)bid;
  float* a = (float*)smem;
  const float dmin = -3.0701134573253945f;
  const float dmax = -15.350567286626973f;
  for (int it = bid; it < 36 * 16; it += gridDim.x) {
    const int pc = it >> 4, cb = it & 15;
    const int lt = (pc < 32) ? 1 : 0;
    const int L = lt ? LLAT : LCTX;
    const int p0 = (lt ? pc : (pc - 32)) * 64;
    bf16_t* filt = lt ? p.filt_lat : p.filt_ctx;
    const float* a3 = p.filt_a3 + ((long)(lt ? 256 : 0) + p0) * 64;
    __syncthreads();
    for (int i = tid; i < 1024; i += NTHR) ((float4*)a)[i] = ((const float4*)a3)[i];
    const int cidx = cb * 256 + opq(tid);
    float w4[64];
#pragma unroll
    for (int k = 0; k < 64; ++k) w4[k] = p.hy_w4[k * 4096 + cidx];
    __syncthreads();
    const int ch = cidx & 1023, od = cidx >> 10, order = od >> 1, dir = od & 1;
    const float delta = fabsf(dmin + (float)ch * ((dmax - dmin) / 1023.0f));
    bf16_t* dst = filt + ((long)(order * 1024 + ch)) * (2 * L);
#pragma unroll 1
    for (int pp = 0; pp < 64; ++pp) {
      const float4* ap = (const float4*)(a + pp * 64);
      float acc = 0.f;
#pragma unroll
      for (int k4 = 0; k4 < 16; ++k4) {
        const float4 av = ap[k4];
        acc += av.x * w4[4 * k4 + 0] + av.y * w4[4 * k4 + 1] + av.z * w4[4 * k4 + 2] + av.w * w4[4 * k4 + 3];
      }
      const int l = p0 + pp;
      const float t = (float)l / (float)(L - 1);
      const float v = acc * expf(-t * delta);
      if (dir == 0) dst[L - 1 - l] = f2bf(v);
      else { if (l == 0) dst[2 * L - 1] = 0; else dst[L - 1 + l] = f2bf(v); }
    }
  }
}

static __device__ __forceinline__ void p0_tables(const Params& p, char* smem) {
  const int tid = opaque_tid(); const int bid = opaque_bid(); (void)tid; (void)bid;
  float2* T = (float2*)smem;
  __syncthreads();
  for (int m = tid; m < 2048; m += NTHR) {
    float sv, cv;
    sincosf(TWO_PI * (float)m / 2048.0f, &sv, &cv);
    T[m] = make_float2(cv, sv);
  }
  __syncthreads();
  const int n_items = 64 + 64 + 4096;
  for (int it = first_item(320); it < n_items; it += gridDim.x) {
    unsigned short vals[8];
    if (it < 64) {
#pragma unroll
      for (int q = 0; q < 8; ++q) {
        const int e = it * 2048 + tid * 8 + q;
        const int m = e >> 8, k = e & 255;
        const int cs = m >> 8, co = m & 255;
        const float2 tv = T[((co * k) & 255) * 8];
        vals[q] = f2bf(cs ? tv.y : tv.x);
      }
      *(uint4*)(p.tabA + (long)it * 2048 + tid * 8) = make_uint4(vals[0] | (vals[1] << 16), vals[2] | (vals[3] << 16), vals[4] | (vals[5] << 16), vals[6] | (vals[7] << 16));
    } else if (it < 128) {
#pragma unroll
      for (int q = 0; q < 8; ++q) {
        const int e = (it - 64) * 2048 + tid * 8 + q;
        const int pp = e >> 9, k = e & 511;
        const int cs = k >> 8, pi = k & 255;
        const float2 tv = T[((pp * pi) & 255) * 8];
        vals[q] = f2bf(cs ? -tv.y : tv.x);
      }
      *(uint4*)(p.tabB_ctx + (long)(it - 64) * 2048 + tid * 8) = make_uint4(vals[0] | (vals[1] << 16), vals[2] | (vals[3] << 16), vals[4] | (vals[5] << 16), vals[6] | (vals[7] << 16));
    } else {
#pragma unroll
      for (int q = 0; q < 8; ++q) {
        const int e = (it - 128) * 2048 + tid * 8 + q;
        const int pp = e >> 12, k = e & 4095;
        const int cs = k >> 11, pi = k & 2047;
        const float2 tv = T[(pp * pi) & 2047];
        vals[q] = f2bf(cs ? -tv.y : tv.x);
      }
      *(uint4*)(p.tabB_lat + (long)(it - 128) * 2048 + tid * 8) = make_uint4(vals[0] | (vals[1] << 16), vals[2] | (vals[3] << 16), vals[4] | (vals[5] << 16), vals[6] | (vals[7] << 16));
    }
  }
}

static __device__ __forceinline__ void wt_transpose_items(const float* __restrict__ W, bf16_t* __restrict__ Wt, int N, int Npad, int off, char* smem) {
  const int tid = opaque_tid(); const int bid = opaque_bid(); (void)tid; (void)bid;
  float* t = (float*)smem;
  const int ntn = Npad / 64;
  const int n_items = ntn * 16;
  for (int it = first_item(off); it < n_items; it += gridDim.x) {
    const int nt = it % ntn, kt = it / ntn;
    const int n0 = nt * 64, k0 = kt * 64;
    __syncthreads();
    const int tx = tid & 63, ty = tid >> 6;
    float v[16];
#pragma unroll
    for (int i = 0; i < 16; ++i) v[i] = (n0 + tx < N) ? W[(long)(k0 + ty + 4 * i) * N + n0 + tx] : 0.f;
#pragma unroll
    for (int i = 0; i < 16; ++i) t[tx * 65 + ty + 4 * i] = v[i];
    __syncthreads();
    const int r = tid >> 2, cch = (tid & 3) * 16;
    unsigned w[8];
#pragma unroll
    for (int q = 0; q < 8; ++q) w[q] = pk2(t[r * 65 + cch + 2 * q], t[r * 65 + cch + 2 * q + 1]);
    uint4* dp = (uint4*)(Wt + (long)(n0 + r) * 1024 + k0 + cch);
    dp[0] = make_uint4(w[0], w[1], w[2], w[3]);
    dp[1] = make_uint4(w[4], w[5], w[6], w[7]);
  }
}

static __device__ __forceinline__ void p0_weights(const Params& p, char* smem) {
  wt_transpose_items(p.gla_w_in, p.wt_gla_in0, 3104, 3200, 0, smem);
  wt_transpose_items(p.gla_w_out, p.wt_gla_out0, 1024, 1024, 288, smem);
  wt_transpose_items(p.fn_w_in, p.wt_fn_in, 2048, 2048, 32, smem);
  wt_transpose_items(p.fn_w_out, p.wt_fn_out, 1024, 1024, 32, smem);
  wt_transpose_items(p.hy_w_in, p.wt_hy_in, 4096, 4096, 288, smem);
  wt_transpose_items(p.hy_w_out, p.wt_hy_out, 1024, 1024, 288, smem);
  wt_transpose_items(p.gla_w_in + (long)1024 * 3104, p.wt_gla_in1, 3104, 3200, 32, smem);
  wt_transpose_items(p.gla_w_out + (long)1024 * 1024, p.wt_gla_out1, 1024, 1024, 288, smem);
}

static __device__ __forceinline__ void phase_norm(const Params& p, int layer) {
  const int tid = opaque_tid(); const int bid = opaque_bid(); (void)tid; (void)bid;
  const int lane = tid & 63, wave = tid >> 6;
  const float* g = p.norm_g + layer * 1024;
  const int stride = gridDim.x * 4;
  for (int t0 = bid * 4 + wave; t0 < NTOK; t0 += 2 * stride) {
    float4 v[2][4];
#pragma unroll
    for (int u = 0; u < 2; ++u) {
      const int t = t0 + u * stride;
      if (t < NTOK) {
        const float* xr;
        if (layer == 0) xr = (t < NCTX) ? (p.x_prompt + (long)t * 1024) : (p.x_sample + (long)(t - NCTX) * 1024);
        else xr = p.out + (long)t * 1024;
#pragma unroll
        for (int i = 0; i < 4; ++i) v[u][i] = *(const float4*)(xr + lane * 4 + 256 * i);
      }
    }
#pragma unroll
    for (int u = 0; u < 2; ++u) {
      const int t = t0 + u * stride;
      if (t < NTOK) {
        const float* mv = p.modv + (layer * 3 + tok_which(t)) * 3072;
        float ss = 0.f;
#pragma unroll
        for (int i = 0; i < 4; ++i) ss += v[u][i].x * v[u][i].x + v[u][i].y * v[u][i].y + v[u][i].z * v[u][i].z + v[u][i].w * v[u][i].w;
#pragma unroll
        for (int o = 32; o > 0; o >>= 1) ss += __shfl_xor(ss, o);
        const float rstd = rsqrtf(ss * (1.0f / 1024.0f) + 1e-6f);
#pragma unroll
        for (int i = 0; i < 4; ++i) {
          const int c0 = lane * 4 + 256 * i;
          const float4 gg = *(const float4*)(g + c0);
          const float4 sh = *(const float4*)(mv + c0);
          const float4 sc = *(const float4*)(mv + 1024 + c0);
          uint2 w;
          w.x = pk2((v[u][i].x * rstd * gg.x) * (1.f + sc.x) + sh.x, (v[u][i].y * rstd * gg.y) * (1.f + sc.y) + sh.y);
          w.y = pk2((v[u][i].z * rstd * gg.z) * (1.f + sc.z) + sh.z, (v[u][i].w * rstd * gg.w) * (1.f + sc.w) + sh.w);
          *(uint2*)(p.h + (long)t * 1024 + c0) = w;
        }
      }
    }
  }
}

static __device__ __forceinline__ void phase_final_norm(const Params& p) {
  const int tid = opaque_tid(); const int bid = opaque_bid(); (void)tid; (void)bid;
  const int lane = tid & 63, wave = tid >> 6;
  for (int t = bid * 4 + wave; t < NTOK; t += gridDim.x * 4) {
    float* xr = p.out + (long)t * 1024;
    float4 v[4];
    float ss = 0.f;
#pragma unroll
    for (int i = 0; i < 4; ++i) {
      v[i] = *(const float4*)(xr + lane * 4 + 256 * i);
      ss += v[i].x * v[i].x + v[i].y * v[i].y + v[i].z * v[i].z + v[i].w * v[i].w;
    }
#pragma unroll
    for (int o = 32; o > 0; o >>= 1) ss += __shfl_xor(ss, o);
    const float rstd = rsqrtf(ss * (1.0f / 1024.0f) + 1e-6f);
#pragma unroll
    for (int i = 0; i < 4; ++i) {
      const int c0 = lane * 4 + 256 * i;
      float4 gg = *(const float4*)(p.final_norm_g + c0);
      float4 o;
      o.x = v[i].x * rstd * gg.x; o.y = v[i].y * rstd * gg.y; o.z = v[i].z * rstd * gg.z; o.w = v[i].w * rstd * gg.w;
      *(float4*)(xr + c0) = o;
    }
  }
}

static __device__ __forceinline__ void phase_gemm_out(const Params& p, int layer, const bf16_t* Wt, char* smem, const int dummy) {
  const int tid = opaque_tid(); const int bid = opaque_bid(); (void)tid; (void)bid;
  bf16_t* sA = (bf16_t*)smem;
  GEMM_STAGE_DECL
  float* outp = dummy ? (float*)p.big : p.out;
  const int n_tiles = 96 * 8;
  const int nfull = (gridDim.x == 512) ? 512 : n_tiles;
  const int n_items = nfull + 2 * (n_tiles - nfull);
  for (int item = bid; item < n_items; item += gridDim.x) {
    const bool is_half = item >= nfull;
    const int tile = is_half ? nfull + ((item - nfull) >> 1) : item;
    const int hsel = is_half ? ((item - nfull) & 1) : 0;
    const int mt = tile % 96, nt = tile / 96;
    const int m0 = mt * 128, n0 = nt * 128 + hsel * 64;
    const float* gate = p.modv + (layer * 3 + tok_which(m0)) * 3072 + 2048;
    const float* xsrc = (layer == 0) ? ((m0 < NCTX) ? p.x_prompt : (p.x_sample - (long)NCTX * 1024)) : p.out;
    const int e_lane = tid & 63, e_wave = tid >> 6;
    const int e_wm = e_wave >> 1, e_wn = e_wave & 1;
    if (!is_half) {
      f32x16 acc[2][2];
      gemm_tile(p.h + (long)m0 * 1024, 1024, Wt + (long)n0 * 1024, 1024, 1024, sA, acc, tid, GEMM_STAGE_ARGS, false, nullptr, nullptr);
      float xo[2][2][16];
      const float* xb = xsrc + (long)m0 * 1024 + n0;
      float* ob = outp + (long)m0 * 1024 + n0;
      EPIS_BEGIN
        (void)val;
        const unsigned lo = 4u * (unsigned)(e_rowl * 1024 + e_coll);
        xo[e_i][e_j][e_r] = *(const float*)((const char*)(xb + e_rowu * 1024 + e_colu) + lo);
      EPI_END
      EPIS_BEGIN
        const unsigned lo = 4u * (unsigned)(e_rowl * 1024 + e_coll);
        *(float*)((char*)(ob + e_rowu * 1024 + e_colu) + lo) = xo[e_i][e_j][e_r] + gate[n0 + e_coll + e_colu] * val;
      EPI_END
    } else {
      f32x16 acc[2];
      gemm_tile_h(p.h + (long)m0 * 1024, 1024, Wt + (long)n0 * 1024, 1024, 1024, sA, acc, tid);
      const int n = n0 + e_wn * 32 + (e_lane & 31);
      const float gn = gate[n];
      float xo[2][16];
#pragma unroll
      for (int e_i = 0; e_i < 2; ++e_i)
#pragma unroll
        for (int e_r = 0; e_r < 16; ++e_r) {
          const int row = e_wm * 64 + e_i * 32 + 8 * (e_r >> 2) + 4 * (e_lane >> 5) + (e_r & 3);
          xo[e_i][e_r] = xsrc[(long)(m0 + row) * 1024 + n];
        }
#pragma unroll
      for (int e_i = 0; e_i < 2; ++e_i)
#pragma unroll
        for (int e_r = 0; e_r < 16; ++e_r) {
          const int row = e_wm * 64 + e_i * 32 + 8 * (e_r >> 2) + 4 * (e_lane >> 5) + (e_r & 3);
          outp[(long)(m0 + row) * 1024 + n] = xo[e_i][e_r] + gn * acc[e_i][e_r];
        }
    }
  }
}

#define GLA_PROJ(p) ((p).big)
#define GLA_LR(p) ((float*)((p).big + (long)NTOK * 3072))
#define GLA_OF(p) ((p).big + (long)NTOK * 3072 + (long)NTOK * 64)
#define GLA_OB(p) (GLA_OF(p) + (long)NTOK * 1024)

static __device__ __forceinline__ void phase_gla_in(const Params& p, const bf16_t* Wt, char* smem) {
  const int tid = opaque_tid(); const int bid = opaque_bid(); (void)tid; (void)bid;
  bf16_t* sA = (bf16_t*)smem;
  GEMM_STAGE_DECL
  bool pre = false;
  bf16_t* proj = GLA_PROJ(p);
  float* lrb = GLA_LR(p);
  const int n_tiles = 96 * 25;
  for (int tile = bid; tile < n_tiles; tile += gridDim.x) {
    const int mt = tile % 96, nt = tile / 96;
    const int m0 = mt * 128, n0 = nt * 128;
    f32x16 acc[2][2];
    {
      const int tn = tile + gridDim.x;
      const bool hn = tn < n_tiles;
      gemm_tile(p.h + (long)m0 * 1024, 1024, Wt + (long)n0 * 1024, 1024, 1024, sA, acc, tid, GEMM_STAGE_ARGS, pre,
                hn ? p.h + (long)((tn % 96) * 128) * 1024 : nullptr, hn ? Wt + (long)((tn / 96) * 128) * 1024 : nullptr);
      pre = hn;
    }
    if (n0 < 3072) {
      bf16_t* tb = proj + (long)m0 * 3072 + n0;
      EPIS_BEGIN
        const unsigned lo = 2u * (unsigned)(e_rowl * 3072 + e_coll);
        *(bf16_t*)((char*)(tb + e_rowu * 3072 + e_colu) + lo) = f2bf(val);
      EPI_END
    } else {
      EPI_BEGIN
        const int t = m0 + row, n = n0 + col;
        if (n < 3104) lrb[(long)t * 32 + (n - 3072)] = val;
      EPI_END
    }
  }
}

#define GLA_IMG1(p) (GLA_OB(p) + (long)NTOK * 1024)
#define GLA_BLAST(p) ((float*)(GLA_IMG1(p) + (long)NTOK * 1024))
static __device__ __forceinline__ void phase_gla_prep(const Params& p, int j, char* smem, const int dummy) {
  const int tid = opaque_tid(); const int bid = opaque_bid();
  float* sLR = (float*)smem;
  bf16_t* proj = GLA_PROJ(p);
  bf16_t* img1 = GLA_IMG1(p);
  const float* lrb = GLA_LR(p);
  float* blast = GLA_BLAST(p);
  const int dkl = tid & 127, dir = tid >> 7;
  for (int it = bid; it < (NTOK / 32) * 4; it += gridDim.x) {
    const int tb = it >> 2, hh = it & 3;
    const int dk = hh * 128 + dkl;
    __syncthreads();
    ((float4*)sLR)[tid] = *(const float4*)(lrb + ((long)tb * 32 + (tid >> 3)) * 32 + (tid & 7) * 4);
    unsigned rqk[32];
    {
      const bf16_t* rp = proj + ((long)tb * 32 + (dir ? 31 : 0)) * 3072 + dk;
      const long rstep = dir ? -3072 : 3072;
#pragma unroll
      for (int s_ = 0; s_ < 32; ++s_) {
        rqk[s_] = (unsigned)rp[0] | ((unsigned)rp[512] << 16);
        rp += rstep;
      }
    }
    float wd[16];
    const float* wdp = p.gla_w_dec + ((long)(j * 2 + dir) * 16) * 512 + dk;
#pragma unroll
    for (int r = 0; r < 16; ++r) wd[r] = wdp[r * 512];
    const float bd = p.gla_b_dec[(j * 2 + dir) * 512 + dk];
    __syncthreads();
    float* sC = sLR + 1024 + tid;
    float run = 0.f;
#pragma unroll
    for (int s_ = 0; s_ < 32; ++s_) {
      const int pos = dir ? 31 - s_ : s_;
      const float4* lp = (const float4*)(sLR + pos * 32 + dir * 16);
      float lg = bd;
#pragma unroll
      for (int r4 = 0; r4 < 4; ++r4) {
        const float4 l4 = lp[r4];
        lg += l4.x * wd[r4 * 4 + 0] + l4.y * wd[r4 * 4 + 1] + l4.z * wd[r4 * 4 + 2] + l4.w * wd[r4 * 4 + 3];
      }
      run += (fminf(lg, 0.f) - __logf(1.f + __expf(-fabsf(lg)))) * (1.0f / 16.0f);
      sC[s_ * 256] = run;
    }
    blast[((long)dir * (NTOK / 32) + tb) * 512 + dk] = run;
    bf16_t* dst = dir ? img1 : (dummy ? GLA_OF(p) : proj);
    const long dstr = (dir || dummy) ? 1024 : 3072;
#pragma unroll
    for (int s_ = 0; s_ < 32; ++s_) {
      const int pos = dir ? 31 - s_ : s_;
      const long tok = (long)tb * 32 + pos;
      const float e0 = sC[s_ * 256] - run;
      const float qs = 0.08838834764831845f * __expf(fminf(e0, 80.f));
      const float ks = __expf(-e0);
      const unsigned o2 = pk2(bf2f((bf16_t)(rqk[s_] & 0xffffu)) * qs, bf2f((bf16_t)(rqk[s_] >> 16)) * ks);
      dst[tok * dstr + dk] = (bf16_t)(o2 & 0xffffu);
      dst[tok * dstr + 512 + dk] = (bf16_t)(o2 >> 16);
    }
  }
}

#define QS 136
#define TS 40
#define GLA_SLOC(p) ((float*)((p).h))
#define GLA_GSEG(p) (((float*)((p).h)) + (long)128 * 128 * 256)
__device__ __forceinline__ int crow_(int r, int hf) { return (r & 3) + 8 * (r >> 2) + 4 * hf; }
__device__ __forceinline__ bf16x8 pack8(const f32x16& x, const int st) {
  union { unsigned u[4]; bf16x8 v; } c;
  c.u[0] = pk2(x[8 * st + 0], x[8 * st + 1]);
  c.u[1] = pk2(x[8 * st + 2], x[8 * st + 3]);
  c.u[2] = pk2(x[8 * st + 4], x[8 * st + 5]);
  c.u[3] = pk2(x[8 * st + 6], x[8 * st + 7]);
  return c.v;
}
__device__ __forceinline__ bf16x8 ld2x8(const bf16_t* a, const bf16_t* b) {
  union { uint2 d[2]; bf16x8 v; } c;
  c.d[0] = *(const uint2*)a;
  c.d[1] = *(const uint2*)b;
  return c.v;
}

__device__ __forceinline__ unsigned kimg_off(unsigned row, unsigned ch) { return 256u * row + 16u * (ch ^ (((row & 3u) << 2) | ((row >> 2) & 3u))); }
__device__ __forceinline__ unsigned kimg_tr(unsigned lane, unsigned c, unsigned ks, unsigned t) {
  const unsigned h = lane >> 5, blk = (lane >> 4) & 1u, q = (lane & 15u) >> 2, pp = lane & 3u;
  return kimg_off(16u * ks + 8u * h + 4u * t + q, 4u * c + 2u * blk + (pp >> 1)) + 8u * (pp & 1u);
}
typedef short s16x4 __attribute__((ext_vector_type(4)));

static __device__ __forceinline__ void phase_gla_scan(const Params& p, int j, int pass, char* smem) {
  const int tid = opaque_tid(); const int bid = opaque_bid();
  bf16_t* sQ = (bf16_t*)smem;
  bf16_t* sK = sQ + 32 * QS;
  bf16_t* sKT = sK + 32 * QS;
  bf16_t* sVT = sKT + 128 * TS;
  float* sDec = (float*)(sVT + 64 * TS);
  float* sOp = sDec + 128;
  const bf16_t* proj = GLA_PROJ(p);
  const bf16_t* img1 = GLA_IMG1(p);
  const float* blast = GLA_BLAST(p);
  float* sloc = GLA_SLOC(p);
  float* gseg = GLA_GSEG(p);
  const int lane = tid & 63, wave = tid >> 6, l31 = lane & 31, hf = lane >> 5;
  const int kh = wave >> 1, nt = wave & 1;
  const int dk0 = (tid & 63) * 2, sg = tid >> 6;
  const int vp = tid & 31, sg8 = tid >> 5;
  const int irow = tid >> 3, icol = (tid & 7) * 16;
  char* sKb = (char*)sK;
  char* sVb = (char*)sKT;
  const unsigned vbase = (unsigned)(size_t)sVb;
  const unsigned vtr0 = vbase + kimg_tr(lane, nt, 0, 0), vtr1 = vbase + kimg_tr(lane, nt, 0, 1);
  const unsigned vtr2 = vbase + kimg_tr(lane, nt, 1, 0), vtr3 = vbase + kimg_tr(lane, nt, 1, 1);
  const unsigned vq_ = (lane & 15) >> 2, vch_ = 4 * nt + 2 * ((lane >> 4) & 1) + ((lane & 3) >> 1), vb8_ = 8 * (lane & 1);
  const unsigned vtrp0 = vbase + kimg_off(16 * kh + 4 * hf + vq_, vch_) + vb8_;
  const unsigned vtrp1 = vbase + kimg_off(16 * kh + 8 + 4 * hf + vq_, vch_) + vb8_;
  const unsigned kbase = (unsigned)(size_t)sKb;
  const unsigned ktr0 = kbase + kimg_tr(lane, 2 * kh + 0, 0, 0), ktr1 = kbase + kimg_tr(lane, 2 * kh + 0, 0, 1);
  const unsigned ktr2 = kbase + kimg_tr(lane, 2 * kh + 0, 1, 0), ktr3 = kbase + kimg_tr(lane, 2 * kh + 0, 1, 1);
  const unsigned ktr4 = kbase + kimg_tr(lane, 2 * kh + 1, 0, 0), ktr5 = kbase + kimg_tr(lane, 2 * kh + 1, 0, 1);
  const unsigned ktr6 = kbase + kimg_tr(lane, 2 * kh + 1, 1, 0), ktr7 = kbase + kimg_tr(lane, 2 * kh + 1, 1, 1);
  const int n_items = pass == 0 ? (1024 + 512) : 512;
  for (int it = bid; it < n_items; it += gridDim.x) {
    int b, hh, dir, vt, sidx, L, tbase;
    bool full, lat;
    if (pass == 0 && it < 1024) {
      vt = it & 3; const int combo = it >> 2;
      dir = combo & 1; hh = (combo >> 1) & 3; b = combo >> 3; sidx = 0;
      L = LCTX; tbase = b * LCTX; full = true; lat = false;
    } else {
      const int i2 = pass == 0 ? it - 1024 : it;
      vt = i2 & 3; const int combo = i2 >> 2;
      dir = combo & 1; hh = (combo >> 1) & 3; sidx = (combo >> 3) & 7; b = combo >> 6;
      L = LLAT; tbase = NCTX + b * LLAT; full = (pass == 1); lat = true;
    }
    bf16_t* obuf = dir ? GLA_OB(p) : GLA_OF(p);
    const bf16_t* ib = dir ? img1 : proj;
    const long istr = dir ? 1024 : 3072;
    const int vcol = vt * 64 + nt * 32 + l31;
    const int sgn = dir ? -1 : 1;
    const int offq = (dir ? 31 - irow : irow) * (int)istr + icol;
    const int offv = (dir ? 31 - irow : irow) * 3072 + (tid & 7) * 8;
    const int offo = (dir ? 31 - 4 * hf : 4 * hf) * 1024 + vcol;
    f32x16 S0, S1;
    if (pass == 0) {
#pragma unroll
      for (int r = 0; r < 16; ++r) { S0[r] = 0.f; S1[r] = 0.f; }
    } else {
      const int rb = opq((kh * 64 + 4 * hf) * 256 + vcol);
      const float* s0 = p.state_gla + ((((long)b * 2 + j) * 2 + dir) * 4 + hh) * 128 * 256 + rb;
#pragma unroll
      for (int r = 0; r < 16; ++r) {
        S0[r] = s0[crow_(r, 0) * 256];
        S1[r] = s0[(32 + crow_(r, 0)) * 256];
      }
      int i = 0;
      const int gofs = opq(kh * 64 + 4 * hf);
      for (; i + 1 < sidx; i += 2) {
        const int ci = (((b * 8 + i) * 4 + hh) * 2 + dir), cj = (((b * 8 + i + 1) * 4 + hh) * 2 + dir);
        const float* sl = sloc + (long)ci * 128 * 256 + rb;
        const float* gs = gseg + ci * 128 + gofs;
        const float* sl2 = sloc + (long)cj * 128 * 256 + rb;
        const float* gs2 = gseg + cj * 128 + gofs;
        float la0[16], la1[16], ga0[16], ga1[16], lb0[16], lb1[16], gb0[16], gb1[16];
#pragma unroll
        for (int r = 0; r < 16; ++r) {
          ga0[r] = gs[crow_(r, 0)]; ga1[r] = gs[32 + crow_(r, 0)];
          la0[r] = sl[crow_(r, 0) * 256]; la1[r] = sl[(32 + crow_(r, 0)) * 256];
          gb0[r] = gs2[crow_(r, 0)]; gb1[r] = gs2[32 + crow_(r, 0)];
          lb0[r] = sl2[crow_(r, 0) * 256]; lb1[r] = sl2[(32 + crow_(r, 0)) * 256];
        }
#pragma unroll
        for (int r = 0; r < 16; ++r) {
          S0[r] = __expf(gb0[r]) * (__expf(ga0[r]) * S0[r] + la0[r]) + lb0[r];
          S1[r] = __expf(gb1[r]) * (__expf(ga1[r]) * S1[r] + la1[r]) + lb1[r];
        }
      }
      for (; i < sidx; ++i) {
        const int ci = (((b * 8 + i) * 4 + hh) * 2 + dir);
        const float* sl = sloc + (long)ci * 128 * 256 + rb;
        const float* gs = gseg + ci * 128 + gofs;
#pragma unroll
        for (int r = 0; r < 16; ++r) {
          S0[r] = __expf(gs[crow_(r, 0)]) * S0[r] + sl[crow_(r, 0) * 256];
          S1[r] = __expf(gs[32 + crow_(r, 0)]) * S1[r] + sl[(32 + crow_(r, 0)) * 256];
        }
      }
    }
    float gsum = 0.f;
    struct GlaRegs { uint4 q0, q1, k0, k1, v; float bl; };
    GlaRegs RA, RB;
    RA.q0 = make_uint4(0u, 0u, 0u, 0u); RA.q1 = RA.q0; RB.q0 = RA.q0; RB.q1 = RA.q0; RA.bl = 0.f; RB.bl = 0.f;
#define GLA_TOK(u_) ((long)tbase + (dir ? (L - 1 - (u_)) : (u_)))
    auto gla_load = [&](const int c_, GlaRegs& R) __attribute__((always_inline)) {
      const int ub = sidx * 256 + c_ * 32;
      const long TB = (long)tbase + (dir ? (L - 32 - ub) : ub);
      {
        const bf16_t* rp = ib + TB * istr + hh * 128 + offq;
        if (full) { R.q0 = *(const uint4*)rp; R.q1 = *(const uint4*)(rp + 8); }
        R.k0 = *(const uint4*)(rp + 512); R.k1 = *(const uint4*)(rp + 520);
      }
      R.v = *(const uint4*)(proj + TB * 3072 + 1024 + hh * 256 + vt * 64 + offv);
      if (tid < 128) R.bl = blast[((long)dir * (NTOK / 32) + (TB >> 5)) * 512 + hh * 128 + tid];
    };
    auto gla_chunk = [&](const int c, GlaRegs& R) __attribute__((always_inline)) {
      if (full) {
        *(uint4*)(sQ + irow * QS + icol) = R.q0; *(uint4*)(sQ + irow * QS + icol + 8) = R.q1;
      }
      *(uint4*)(sKb + kimg_off(irow, 2 * (tid & 7))) = R.k0;
      *(uint4*)(sKb + kimg_off(irow, 2 * (tid & 7) + 1)) = R.k1;
      *(uint4*)(sVb + kimg_off(irow, tid & 7)) = R.v;
      if (tid < 128) { sDec[tid] = __expf(R.bl); gsum += R.bl; }
      __syncthreads();
      if (c + 2 < 8) gla_load(c + 2, R);
#pragma unroll
      for (int r = 0; r < 16; ++r) {
        S0[r] *= sDec[kh * 64 + crow_(r, hf)];
        S1[r] *= sDec[kh * 64 + 32 + crow_(r, hf)];
      }
      f32x16 o;
      if (full) {
        f32x16 att;
#pragma unroll
        for (int r = 0; r < 16; ++r) { att[r] = 0.f; o[r] = 0.f; }
#pragma unroll
        for (int kk = 0; kk < 8; ++kk) {
          const bf16x8 a = *(const bf16x8*)(sKb + kimg_off(l31, 2 * kk + hf));
          const bf16x8 bq = *(const bf16x8*)(sQ + l31 * QS + kk * 16 + 8 * hf);
          att = __builtin_amdgcn_mfma_f32_32x32x16_bf16(a, bq, att, 0, 0, 0);
        }
#pragma unroll
        for (int r = 0; r < 16; ++r) if (crow_(r, hf) > l31) att[r] = 0.f;
#pragma unroll
        for (int st = 0; st < 2; ++st) {
          {
            const bf16_t* qa = sQ + l31 * QS + kh * 64 + 16 * st + 4 * hf;
            o = __builtin_amdgcn_mfma_f32_32x32x16_bf16(ld2x8(qa, qa + 8), pack8(S0, st), o, 0, 0, 0);
          }
          {
            const bf16_t* qa = sQ + l31 * QS + kh * 64 + 32 + 16 * st + 4 * hf;
            o = __builtin_amdgcn_mfma_f32_32x32x16_bf16(ld2x8(qa, qa + 8), pack8(S1, st), o, 0, 0, 0);
          }
        }
        {
          const bf16x8 pa0 = pack8(att, 0), pa1 = pack8(att, 1);
          const bf16x8 pa = kh ? pa1 : pa0;
          s16x4 u0, u1;
          asm volatile("ds_read_b64_tr_b16 %0, %2\n\tds_read_b64_tr_b16 %1, %3\n\ts_waitcnt lgkmcnt(0)"
                       : "=&v"(u0), "=&v"(u1) : "v"(vtrp0), "v"(vtrp1) : "memory");
          o = __builtin_amdgcn_mfma_f32_32x32x16_bf16(pa, __builtin_shufflevector(u0, u1, 0, 1, 2, 3, 4, 5, 6, 7), o, 0, 0, 0);
        }
        if (kh == 1) {
#pragma unroll
          for (int r = 0; r < 16; ++r) sOp[(nt * 32 + crow_(r, hf)) * 32 + l31] = o[r];
        }
      }
      {
        s16x4 t00, t01, t02, t03, t10, t11, t12, t13;
        s16x4 w0, w1, w2, w3;
        asm volatile(
            "ds_read_b64_tr_b16 %0, %12\n\t"
            "ds_read_b64_tr_b16 %1, %13\n\t"
            "ds_read_b64_tr_b16 %2, %14\n\t"
            "ds_read_b64_tr_b16 %3, %15\n\t"
            "ds_read_b64_tr_b16 %4, %16\n\t"
            "ds_read_b64_tr_b16 %5, %17\n\t"
            "ds_read_b64_tr_b16 %6, %18\n\t"
            "ds_read_b64_tr_b16 %7, %19\n\t"
            "ds_read_b64_tr_b16 %8, %20\n\t"
            "ds_read_b64_tr_b16 %9, %21\n\t"
            "ds_read_b64_tr_b16 %10, %22\n\t"
            "ds_read_b64_tr_b16 %11, %23\n\t"
            "s_waitcnt lgkmcnt(0)"
            : "=&v"(t00), "=&v"(t01), "=&v"(t02), "=&v"(t03), "=&v"(t10), "=&v"(t11), "=&v"(t12), "=&v"(t13),
              "=&v"(w0), "=&v"(w1), "=&v"(w2), "=&v"(w3)
            : "v"(ktr0), "v"(ktr1), "v"(ktr2), "v"(ktr3), "v"(ktr4), "v"(ktr5), "v"(ktr6), "v"(ktr7),
              "v"(vtr0), "v"(vtr1), "v"(vtr2), "v"(vtr3)
            : "memory");
        const bf16x8 a00 = __builtin_shufflevector(t00, t01, 0, 1, 2, 3, 4, 5, 6, 7);
        const bf16x8 a01 = __builtin_shufflevector(t02, t03, 0, 1, 2, 3, 4, 5, 6, 7);
        const bf16x8 a10 = __builtin_shufflevector(t10, t11, 0, 1, 2, 3, 4, 5, 6, 7);
        const bf16x8 a11 = __builtin_shufflevector(t12, t13, 0, 1, 2, 3, 4, 5, 6, 7);
        const bf16x8 bv0 = __builtin_shufflevector(w0, w1, 0, 1, 2, 3, 4, 5, 6, 7);
        const bf16x8 bv1 = __builtin_shufflevector(w2, w3, 0, 1, 2, 3, 4, 5, 6, 7);
        S0 = __builtin_amdgcn_mfma_f32_32x32x16_bf16(a00, bv0, S0, 0, 0, 0);
        S1 = __builtin_amdgcn_mfma_f32_32x32x16_bf16(a10, bv0, S1, 0, 0, 0);
        S0 = __builtin_amdgcn_mfma_f32_32x32x16_bf16(a01, bv1, S0, 0, 0, 0);
        S1 = __builtin_amdgcn_mfma_f32_32x32x16_bf16(a11, bv1, S1, 0, 0, 0);
      }
      __syncthreads();
      if (full && kh == 0) {
        const int ub = sidx * 256 + c * 32;
        const long TB = (long)tbase + (dir ? (L - 32 - ub) : ub);
#pragma unroll
        for (int r = 0; r < 16; ++r) {
          const int srow = crow_(r, hf);
          const float val = o[r] + sOp[(nt * 32 + srow) * 32 + l31];
          bf16_t* uo = obuf + (TB + sgn * (8 * (r >> 2) + (r & 3))) * 1024 + hh * 256;
          uo[offo] = f2bf(val);
        }
      }
    };
    gla_load(0, RA);
    gla_load(1, RB);
    __syncthreads();
    for (int c = 0; c < 8; c += 2) {
      gla_chunk(c, RA);
      gla_chunk(c + 1, RB);
    }
    const int rbo = opq((kh * 64 + 4 * hf) * 256 + vcol);
    if (!lat) {
      float* so = p.out + (long)NTOK * 1024 + ((((long)b * 2 + j) * 2 + dir) * 4 + hh) * 128 * 256 + rbo;
#pragma unroll
      for (int r = 0; r < 16; ++r) {
        so[crow_(r, 0) * 256] = S0[r];
        so[(32 + crow_(r, 0)) * 256] = S1[r];
      }
    } else if (pass == 0) {
      const int ci = (((b * 8 + sidx) * 4 + hh) * 2 + dir);
      float* sl = sloc + (long)ci * 128 * 256 + rbo;
#pragma unroll
      for (int r = 0; r < 16; ++r) {
        sl[crow_(r, 0) * 256] = S0[r];
        sl[(32 + crow_(r, 0)) * 256] = S1[r];
      }
      if (vt == 0 && tid < 128) gseg[ci * 128 + tid] = gsum;
    }
    __syncthreads();
  }
}

static __device__ __forceinline__ void phase_gla_combine(const Params& p, int j) {
  const int tid = opaque_tid(); const int bid = opaque_bid(); (void)tid; (void)bid;
  const int lane = tid & 63, wave = tid >> 6;
  const bf16_t* proj = GLA_PROJ(p);
  const bf16_t* of = GLA_OF(p);
  const bf16_t* ob = GLA_OB(p);
  const float* og = p.gla_onorm_g + j * 256;
  const float4 gg = *(const float4*)(og + lane * 4);
  const int stride = gridDim.x * 4;
  for (int it0 = bid * 4 + wave; it0 < NTOK * 4; it0 += 4 * stride) {
    uint2 a[4], b[4], r[4];
#pragma unroll
    for (int u = 0; u < 4; ++u) {
      const int it = it0 + u * stride;
      if (it < NTOK * 4) {
        const int t = it >> 2, hh = it & 3;
        const long base = (long)t * 1024 + hh * 256 + lane * 4;
        a[u] = *(const uint2*)(of + base);
        b[u] = *(const uint2*)(ob + base);
        r[u] = *(const uint2*)(proj + (long)t * 3072 + 2048 + hh * 256 + lane * 4);
      }
    }
#pragma unroll
    for (int u = 0; u < 4; ++u) {
      const int it = it0 + u * stride;
      if (it < NTOK * 4) {
        const int t = it >> 2, hh = it & 3;
        const long base = (long)t * 1024 + hh * 256 + lane * 4;
        float o[4];
        o[0] = bf2f(a[u].x & 0xffff) + bf2f(b[u].x & 0xffff);
        o[1] = bf2f(a[u].x >> 16) + bf2f(b[u].x >> 16);
        o[2] = bf2f(a[u].y & 0xffff) + bf2f(b[u].y & 0xffff);
        o[3] = bf2f(a[u].y >> 16) + bf2f(b[u].y >> 16);
        const float r0 = bf2f(r[u].x & 0xffff), r1 = bf2f(r[u].x >> 16), r2 = bf2f(r[u].y & 0xffff), r3 = bf2f(r[u].y >> 16);
        float ss = o[0] * o[0] + o[1] * o[1] + o[2] * o[2] + o[3] * o[3];
#pragma unroll
        for (int sft = 32; sft > 0; sft >>= 1) ss += __shfl_xor(ss, sft);
        const float rstd = rsqrtf(ss * (1.0f / 256.0f) + 1e-6f);
        uint2 w;
        w.x = pk2(o[0] * rstd * gg.x * siluf(r0), o[1] * rstd * gg.y * siluf(r1));
        w.y = pk2(o[2] * rstd * gg.z * siluf(r2), o[3] * rstd * gg.w * siluf(r3));
        *(uint2*)(p.h + base) = w;
      }
    }
  }
}

#define FN_PROJ(p) ((p).big)
#define FN_XCS_CTX(p) ((p).big + (long)NTOK * 2048)
#define FN_XCS_LAT(p) (FN_XCS_CTX(p) + (long)NCTX * 2048)

static __device__ __forceinline__ void phase_fn_in(const Params& p, char* smem) {
  const int tid = opaque_tid(); const int bid = opaque_bid(); (void)tid; (void)bid;
  bf16_t* sA = (bf16_t*)smem;
  GEMM_STAGE_DECL
  bool pre = false;
  bf16_t* proj = FN_PROJ(p);
  const int n_tiles = 96 * 16;
  for (int tile = bid; tile < n_tiles; tile += gridDim.x) {
    const int mt = tile % 96, nt = tile / 96;
    const int m0 = mt * 128, n0 = nt * 128;
    f32x16 acc[2][2];
    {
      const int tn = tile + gridDim.x;
      const bool hn = tn < n_tiles;
      gemm_tile(p.h + (long)m0 * 1024, 1024, p.wt_fn_in + (long)n0 * 1024, 1024, 1024, sA, acc, tid, GEMM_STAGE_ARGS, pre,
                hn ? p.h + (long)((tn % 96) * 128) * 1024 : nullptr, hn ? p.wt_fn_in + (long)((tn / 96) * 128) * 1024 : nullptr);
      pre = hn;
    }
    {
      bf16_t* tb = proj + (long)m0 * 2048 + n0;
      EPIS_BEGIN
        const unsigned lo = 2u * (unsigned)(e_rowl * 2048 + e_coll);
        *(bf16_t*)((char*)(tb + e_rowu * 2048 + e_colu) + lo) = f2bf(val);
      EPI_END
    }
  }
}

static __device__ __forceinline__ void phase_fn_a(const Params& p, char* smem) {
  const int tid = opaque_tid(); const int bid = opaque_bid(); (void)tid; (void)bid;
  bf16_t* sA = (bf16_t*)smem;
  GEMM_STAGE_DECL
  const bf16_t* proj = FN_PROJ(p);
  const int n_tiles = 4 * 96 * 4;
  for (int tile = bid; tile < n_tiles; tile += gridDim.x) {
    const int mt = tile & 3, g = (tile >> 2) & 3, tt = tile >> 4;
    const int m0 = mt * 128, t0 = tt * 128;
    f32x16 acc[2][2];
    gemm_tile(p.tabA + (long)m0 * 256, 256, proj + (long)t0 * 2048 + g * 256, 2048, 256, sA, acc, tid, GEMM_STAGE_ARGS, false, nullptr, nullptr);
    const bool lat = t0 >= NCTX;
    const int L = lat ? LLAT : LCTX;
    const int b = lat ? ((t0 - NCTX) >> 11) : (t0 >> 8);
    const int pos0 = lat ? ((t0 - NCTX) & 2047) : (t0 & 255);
    bf16_t* dst = lat ? FN_XCS_LAT(p) : FN_XCS_CTX(p);
    EPI_BEGIN_OPQ
      const int m = m0 + row;
      const int cs = m >> 8, co = m & 255;
      dst[((long)((b * 4 + g) * 256 + co)) * (2 * L) + cs * L + pos0 + col] = f2bf(val);
    EPI_END
  }
}

static __device__ __forceinline__ void phase_fn_b(const Params& p, char* smem) {
  const int tid = opaque_tid(); const int bid = opaque_bid(); (void)tid; (void)bid;
  bf16_t* sA = (bf16_t*)smem;
  GEMM_STAGE_DECL
  const bf16_t* proj = FN_PROJ(p);
  const int n_lat = 2 * 4 * 16 * 2;
  const int n_ctx = 32 * 4 * 2 * 2;
  const bool rebal = (gridDim.x == 512);
  for (int it_ = bid; it_ < (rebal ? 1024 : n_lat + n_ctx); it_ += gridDim.x) {
    int tile = it_;
    if (rebal) {
      if (it_ < 512) tile = (it_ < 256) ? it_ : (256 + 2 * (it_ - 256));
      else tile = (it_ - 512 < 256) ? -1 : (256 + 2 * (it_ - 768) + 1);
      if (tile < 0) continue;
    }
    int b, g, mt, nt, L, tbase;
    const bf16_t *tab, *xcs;
    if (tile < n_lat) {
      nt = tile & 1; mt = (tile >> 1) & 15; g = (tile >> 5) & 3; b = tile >> 7;
      L = LLAT; tbase = NCTX + b * LLAT; tab = p.tabB_lat; xcs = FN_XCS_LAT(p);
    } else {
      int t2 = tile - n_lat;
      nt = t2 & 1; mt = (t2 >> 1) & 1; g = (t2 >> 2) & 3; b = t2 >> 4;
      L = LCTX; tbase = b * LCTX; tab = p.tabB_ctx; xcs = FN_XCS_CTX(p);
    }
    const int m0 = mt * 128, n0 = nt * 128;
    f32x16 acc[2][2];
    gemm_tile(tab + (long)m0 * (2 * L), 2 * L, xcs + ((long)((b * 4 + g) * 256 + n0)) * (2 * L), 2 * L, 2 * L, sA, acc, tid, GEMM_STAGE_ARGS, false, nullptr, nullptr);
    const float scale = rsqrtf((float)L * 256.0f);
    {
      const int e_lane = tid & 63, e_wave = tid >> 6;
      const int e_wm = e_wave >> 1, e_wn = e_wave & 1;
#pragma unroll
      for (int e_i = 0; e_i < 2; ++e_i)
#pragma unroll
        for (int e_j = 0; e_j < 2; ++e_j) {
          const int rowb = opq(e_wm * 64 + e_i * 32 + 4 * (e_lane >> 5));
          const int ch = g * 256 + n0 + e_wn * 64 + e_j * 32 + (e_lane & 31);
          bf16_t zr[16];
#pragma unroll
          for (int e_r = 0; e_r < 16; ++e_r) zr[e_r] = proj[(long)(tbase + m0 + rowb + 8 * (e_r >> 2) + (e_r & 3)) * 2048 + 1024 + ch];
#pragma unroll
          for (int e_r = 0; e_r < 16; ++e_r)
            p.h[(long)(tbase + m0 + rowb + 8 * (e_r >> 2) + (e_r & 3)) * 1024 + ch] = f2bf(acc[e_i][e_j][e_r] * scale * siluf(bf2f(zr[e_r])));
        }
    }
  }
}

#define HY_UT(p) ((p).big)
#define HY_YT(p) ((p).big + (long)4096 * NTOK)

static __device__ __forceinline__ void phase_hy_in(const Params& p, char* smem) {
  const int tid = opaque_tid(); const int bid = opaque_bid(); (void)tid; (void)bid;
  bf16_t* sA = (bf16_t*)smem;
  GEMM_STAGE_DECL
  bool pre = false;
  bf16_t* uT = HY_UT(p);
  const int n_tiles = 32 * 96;
  for (int tile = bid; tile < n_tiles; tile += gridDim.x) {
    const int nt = tile % 96, mt = tile / 96;
    const int m0 = mt * 128, n0 = nt * 128;
    f32x16 acc[2][2];
    {
      const int tn = tile + gridDim.x;
      const bool hn = tn < n_tiles;
      gemm_tile(p.wt_hy_in + (long)m0 * 1024, 1024, p.h + (long)n0 * 1024, 1024, 1024, sA, acc, tid, GEMM_STAGE_ARGS, pre,
                hn ? p.wt_hy_in + (long)((tn / 96) * 128) * 1024 : nullptr, hn ? p.h + (long)((tn % 96) * 128) * 1024 : nullptr);
      pre = hn;
    }
    {
      bf16_t* tb = uT + (long)m0 * NTOK + n0;
      EPIS_BEGIN
        const unsigned lo = 2u * (unsigned)(e_rowl * NTOK + e_coll);
        *(bf16_t*)((char*)(tb + e_rowu * NTOK + e_colu) + lo) = f2bf(val);
      EPI_END
    }
  }
}

__device__ __forceinline__ int upad(int pos) { return pos + 8 * (pos >> 5); }
static __device__ __forceinline__ void phase_hy_conv(const Params& p, char* smem) {
  const int tid = opaque_tid(); const int bid = opaque_bid();
  bf16_t* sU = (bf16_t*)smem;
  bf16_t* sX1 = sU + 10240;
  bf16_t* sX2 = sX1 + 8192;
  bf16_t* sR0 = sX2 + 8192;
  bf16_t* sR1 = sR0 + 4128;
  const bf16_t* uT = HY_UT(p);
  bf16_t* yT = HY_YT(p);
  const int lane = tid & 63, wave = tid >> 6, l31 = lane & 31, hf = lane >> 5;
  const int n_items = 1024 + 1024;
  for (int it = bid; it < n_items; it += gridDim.x) {
    const bool lat = it < 1024;
    const int ch = lat ? it : (it - 1024);
    const int L = lat ? LLAT : LCTX;
    const int nb = L >> 5;
    const int tok0 = lat ? NCTX : 0;
    const int ntw = lat ? 1 : 2;
    const bf16_t* filt = (lat ? p.filt_lat : p.filt_ctx);
    __syncthreads();
    for (int pc = 0; pc < ntw; ++pc) {
      const int p0 = pc * 4096 + tid * 16;
      const bool has_l = (p0 & (L - 1)) != 0, has_r = ((p0 + 16) & (L - 1)) != 0;
#pragma unroll
      for (int g = 0; g < 3; ++g) {
        const int f = g * 1024 + ch;
        const bf16_t* row = uT + (long)f * NTOK + tok0 + p0;
        const uint4 v0 = *(const uint4*)row, v1 = *(const uint4*)(row + 8);
        float e[18];
        e[0] = has_l ? bf2f(row[-1]) : 0.f;
        e[17] = has_r ? bf2f(row[16]) : 0.f;
        const unsigned vv[8] = {v0.x, v0.y, v0.z, v0.w, v1.x, v1.y, v1.z, v1.w};
#pragma unroll
        for (int q = 0; q < 8; ++q) { e[1 + 2 * q] = bf2f((bf16_t)(vv[q] & 0xffffu)); e[2 + 2 * q] = bf2f((bf16_t)(vv[q] >> 16)); }
        const float w0 = p.hy_conv_w[f], w1 = p.hy_conv_w[3072 + f], w2 = p.hy_conv_w[6144 + f], bb = p.hy_conv_b[f];
        unsigned o[8];
#pragma unroll
        for (int q = 0; q < 8; ++q) {
          const float a0 = e[2 * q] * w0 + e[2 * q + 1] * w1 + e[2 * q + 2] * w2 + bb;
          const float a1 = e[2 * q + 1] * w0 + e[2 * q + 2] * w1 + e[2 * q + 3] * w2 + bb;
          o[q] = pk2(a0, a1);
        }
        bf16_t* dst = (g == 0) ? (sX1 + p0) : (g == 1) ? (sX2 + p0) : (sU + upad(p0));
        uint4 o0, o1;
        o0.x = o[0]; o0.y = o[1]; o0.z = o[2]; o0.w = o[3];
        o1.x = o[4]; o1.y = o[5]; o1.z = o[6]; o1.w = o[7];
        *(uint4*)dst = o0;
        *(uint4*)(dst + 8) = o1;
      }
    }
    const int xa = (L - 1) - l31 + 8 * hf;
    const bf16_t* Rp = (xa & 1) ? (sR1 - 1) : sR0;
    float y1r[2][16];
    for (int order = 0; order < 2; ++order) {
      const bf16_t* fsrc = filt + ((long)(order * 1024 + ch)) * (2 * L);
      for (int x8 = tid; x8 < (2 * L) / 8; x8 += NTHR) {
        const uint4 v = *(const uint4*)(fsrc + 8 * x8);
        *(uint4*)(sR0 + 8 * x8) = v;
        const unsigned vv[4] = {v.x, v.y, v.z, v.w};
#pragma unroll
        for (int q = 0; q < 4; ++q) {
          if (8 * x8 + 2 * q >= 1) sR1[8 * x8 + 2 * q - 1] = (bf16_t)(vv[q] & 0xffffu);
          sR1[8 * x8 + 2 * q] = (bf16_t)(vv[q] >> 16);
        }
      }
      __syncthreads();
      const float dsk = p.hy_d[order * 1024 + ch];
      const bf16_t* gate = order ? sX2 : sX1;
#pragma unroll
      for (int tt = 0; tt < 2; ++tt) {
        if (tt < ntw) {
          int bt, i_blk, dlo, dhi;
          if (lat) { bt = wave >> 1; const int i0 = 32 * (wave & 1); i_blk = i0 + l31; dlo = i0 - 63; dhi = i0 + 31; }
          else { bt = 4 * (2 * wave + tt) + (l31 >> 3); i_blk = l31 & 7; dlo = -7; dhi = 7; }
          const bf16_t* ubase = sU + upad(bt * L);
          const int pos_base = bt * L + 32 * i_blk + 4 * hf;
          f32x16 acc;
#pragma unroll
          for (int r = 0; r < 16; ++r) acc[r] = 0.f;
          for (int d = dlo; d <= dhi; ++d) {
            const int jb = i_blk - d;
            const bool valid = (unsigned)jb < (unsigned)nb;
            const int jc = valid ? jb : 0;
            const bf16_t* bp = ubase + 40 * jc + 8 * hf;
            const unsigned* ap = (const unsigned*)(Rp + (xa - 32 * d));
#pragma unroll
            for (int ks2 = 0; ks2 < 2; ++ks2) {
              union { unsigned u[4]; bf16x8 v; } A;
              A.u[0] = ap[8 * ks2 + 0]; A.u[1] = ap[8 * ks2 + 1]; A.u[2] = ap[8 * ks2 + 2]; A.u[3] = ap[8 * ks2 + 3];
              union { uint4 q; bf16x8 v; } B;
              B.q = *(const uint4*)(bp + 16 * ks2);
              if (!valid) { B.q.x = 0u; B.q.y = 0u; B.q.z = 0u; B.q.w = 0u; }
              acc = __builtin_amdgcn_mfma_f32_32x32x16_bf16(A.v, B.v, acc, 0, 0, 0);
            }
          }
#pragma unroll
          for (int g = 0; g < 4; ++g) {
            const int pos = pos_base + 8 * g;
            const uint2 gg = *(const uint2*)(gate + pos);
            const uint2 uo = *(const uint2*)(sU + upad(pos));
            const float g0 = bf2f((bf16_t)(gg.x & 0xffffu)), g1 = bf2f((bf16_t)(gg.x >> 16)), g2 = bf2f((bf16_t)(gg.y & 0xffffu)), g3 = bf2f((bf16_t)(gg.y >> 16));
            const float u0 = bf2f((bf16_t)(uo.x & 0xffffu)), u1 = bf2f((bf16_t)(uo.x >> 16)), u2 = bf2f((bf16_t)(uo.y & 0xffffu)), u3 = bf2f((bf16_t)(uo.y >> 16));
            y1r[tt][4 * g + 0] = g0 * (acc[4 * g + 0] + dsk * u0);
            y1r[tt][4 * g + 1] = g1 * (acc[4 * g + 1] + dsk * u1);
            y1r[tt][4 * g + 2] = g2 * (acc[4 * g + 2] + dsk * u2);
            y1r[tt][4 * g + 3] = g3 * (acc[4 * g + 3] + dsk * u3);
          }
        }
      }
      __syncthreads();
#pragma unroll
      for (int tt = 0; tt < 2; ++tt) {
        if (tt < ntw) {
          int bt, i_blk;
          if (lat) { bt = wave >> 1; i_blk = 32 * (wave & 1) + l31; }
          else { bt = 4 * (2 * wave + tt) + (l31 >> 3); i_blk = l31 & 7; }
          const int pos_base = bt * L + 32 * i_blk + 4 * hf;
          if (order == 0) {
#pragma unroll
            for (int g = 0; g < 4; ++g) {
              uint2 w;
              w.x = pk2(y1r[tt][4 * g + 0], y1r[tt][4 * g + 1]);
              w.y = pk2(y1r[tt][4 * g + 2], y1r[tt][4 * g + 3]);
              *(uint2*)(sU + upad(pos_base + 8 * g)) = w;
            }
          } else {
            uint2 zz[4];
#pragma unroll
            for (int g = 0; g < 4; ++g) zz[g] = *(const uint2*)(uT + (long)(3072 + ch) * NTOK + tok0 + pos_base + 8 * g);
#pragma unroll
            for (int g = 0; g < 4; ++g) {
              const long gp = (long)tok0 + pos_base + 8 * g;
              const float z0 = bf2f((bf16_t)(zz[g].x & 0xffffu)), z1 = bf2f((bf16_t)(zz[g].x >> 16)), z2 = bf2f((bf16_t)(zz[g].y & 0xffffu)), z3 = bf2f((bf16_t)(zz[g].y >> 16));
              uint2 w;
              w.x = pk2(y1r[tt][4 * g + 0] * siluf(z0), y1r[tt][4 * g + 1] * siluf(z1));
              w.y = pk2(y1r[tt][4 * g + 2] * siluf(z2), y1r[tt][4 * g + 3] * siluf(z3));
              *(uint2*)(yT + (long)ch * NTOK + gp) = w;
            }
          }
        }
      }
    }
  }
}

static __device__ __forceinline__ void phase_hy_transpose(const Params& p, char* smem) {
  const int tid = opaque_tid(); const int bid = opaque_bid(); (void)tid; (void)bid;
  bf16_t* t = (bf16_t*)smem;
  const bf16_t* yT = HY_YT(p);
  const int n_items = 16 * 192;
  for (int it = bid; it < n_items; it += gridDim.x) {
    const int ct = it & 15, tt = it >> 4;
    const int c0 = ct * 64, t0 = tt * 64;
    __syncthreads();
    for (int i = tid; i < 64 * 64; i += NTHR) {
      int r = i >> 6, cc = i & 63;
      t[cc * 66 + r] = yT[(long)(c0 + r) * NTOK + t0 + cc];
    }
    __syncthreads();
    for (int i = tid; i < 64 * 64; i += NTHR) {
      int r = i >> 6, cc = i & 63;
      p.h[(long)(t0 + r) * 1024 + c0 + cc] = t[r * 66 + cc];
    }
  }
}

#define XB_TMO      128
#define XB_XCNT(j)  (256  + 64 * (j))
#define XB_XSUB(j)  (1280 + 64 * (j))
#define XB_XGEN(j)  (2304 + 64 * (j))
#define XB_TOP      3328
#define XB_TOPGEN   3392
#define XCD_BAR_WORDS 3456
#define XB_SPIN_CAP (1u << 18)
#define LAS __attribute__((address_space(3)))
__device__ __forceinline__ unsigned xb_ld(unsigned* p)              { return __hip_atomic_load(p, __ATOMIC_RELAXED, __HIP_MEMORY_SCOPE_AGENT); }
__device__ __forceinline__ unsigned xb_add(unsigned* p, unsigned v) { return __hip_atomic_fetch_add(p, v, __ATOMIC_RELAXED, __HIP_MEMORY_SCOPE_AGENT); }
__device__ __forceinline__ unsigned xb_xcc_id() { return (unsigned)__builtin_amdgcn_s_getreg((3 << 11) | 20) & 0xFu; }
#define XB_SPIN(cond, bar) do { unsigned _sp = 0; while (cond) { __builtin_amdgcn_s_sleep(1); \
    if ((++_sp & 255u) == 0u) { if (xb_ld(&(bar)[XB_TMO])) break; if (_sp > XB_SPIN_CAP) { atomicAdd(&(bar)[XB_TMO], 1u); break; } } } } while (0)
struct XcdBarrier { unsigned* bar; unsigned x; volatile LAS unsigned* st; };
__device__ __forceinline__ XcdBarrier xcd_barrier_post(unsigned* bar, volatile LAS unsigned* st) {
    XcdBarrier b; b.bar = bar; b.x = xb_xcc_id(); b.st = st;
    if (threadIdx.x == 0) (void)xb_add(&bar[XB_XCNT(b.x)], 1u);
    return b;
}
__device__ __forceinline__ void xcd_barrier_complete(unsigned* bar, unsigned x, unsigned& nloc, unsigned& nx) {
    const unsigned G = gridDim.x * gridDim.y * gridDim.z;
    unsigned sum, cnt, mine, sp = 0u;
    for (;;) {
        sum = 0u; cnt = 0u; mine = 0u;
#pragma unroll
        for (unsigned j = 0; j < 16; ++j) { const unsigned c = xb_ld(&bar[XB_XCNT(j)]); sum += c; cnt += (c > 0u) ? 1u : 0u; mine = (j == x) ? c : mine; }
        if (sum == G) break;
        __builtin_amdgcn_s_sleep(1);
        if ((++sp & 255u) == 0u) { if (xb_ld(&bar[XB_TMO])) break; if (sp > XB_SPIN_CAP) { atomicAdd(&bar[XB_TMO], 1u); break; } }
    }
    nloc = mine > 0u ? mine : 1u; nx = cnt > 0u ? cnt : 1u;
}
__device__ __forceinline__ void xcd_barrier(const XcdBarrier& b) {
    asm volatile("s_waitcnt vmcnt(0)" ::: "memory");
    __syncthreads();
    if (threadIdx.x == 0) {
        unsigned* bar = b.bar;
        __builtin_amdgcn_s_waitcnt(0);
        unsigned nloc = b.st[0], nx = b.st[1];
        if (nloc == 0u) { xcd_barrier_complete(bar, b.x, nloc, nx); b.st[0] = nloc; b.st[1] = nx; }
        const unsigned old = xb_add(&bar[XB_XSUB(b.x)], 1u);
        const unsigned gen = old / nloc;
        if (old + 1u == (gen + 1u) * nloc) {
            __builtin_amdgcn_fence(__ATOMIC_RELEASE, "agent");
            asm volatile("s_waitcnt vmcnt(0)" ::: "memory");
            const unsigned og = xb_add(&bar[XB_TOP], 1u);
            const unsigned tg = og / nx;
            if (og + 1u == (tg + 1u) * nx) xb_add(&bar[XB_TOPGEN], 1u);
            else XB_SPIN(xb_ld(&bar[XB_TOPGEN]) == tg, bar);
            __builtin_amdgcn_fence(__ATOMIC_ACQUIRE, "agent");
            xb_add(&bar[XB_XGEN(b.x)], 1u);
            asm volatile("s_waitcnt vmcnt(0)" ::: "memory");
        } else {
            XB_SPIN(xb_ld(&bar[XB_XGEN(b.x)]) == gen, bar);
            __builtin_amdgcn_fence(__ATOMIC_ACQUIRE, "agent");
            asm volatile("s_waitcnt vmcnt(0)" ::: "memory");
        }
    }
    __syncthreads();
}

__global__ void __launch_bounds__(NTHR, 2) mega(Params p) {
  cg::grid_group grid = cg::this_grid();
  __shared__ __attribute__((aligned(16))) char smem[SMEM_BYTES];
  __shared__ uint4 xb_words;
  if (threadIdx.x == 0) xb_words = make_uint4(0u, 0u, 0u, 0u);
  __syncthreads();
  const XcdBarrier xb = xcd_barrier_post(p.bar, (volatile LAS unsigned*)&xb_words);
  if (p.use_cg) grid.sync();
#define GSYNC() xcd_barrier(xb)
#define REP(id) for (int rep##id = 0; rep##id < (PROBE == (id) ? 3 : 1); ++rep##id)
  REP(19) {
  REP(1) { p0_mod(p, smem); }
  REP(2) { p0_filt_mlp(p, smem); }
  REP(3) { p0_tables(p, smem); }
  REP(4) { p0_weights(p, smem); }
  GSYNC();
  }
  if (PROBE == 5) { for (int rep = 0; rep < 40; ++rep) GSYNC(); }
  for (int layer = 0; layer < 4; ++layer) {
    const int kind = layer % 3, j = layer / 3;
    REP(6) { phase_norm(p, layer); if (layer == 1) phase_filt_main(p, smem); GSYNC(); }
    const bf16_t* wt_out;
    if (kind == 0) {
      REP(7) { phase_gla_in(p, j ? p.wt_gla_in1 : p.wt_gla_in0, smem); GSYNC(); }
      for (int rep = 0; rep < (PROBE == 17 ? 3 : 1); ++rep) { phase_gla_prep(p, j, smem, rep + 1 < (PROBE == 17 ? 3 : 1)); GSYNC(); }
      REP(8) { phase_gla_scan(p, j, 0, smem); GSYNC(); }
      REP(9) { phase_gla_scan(p, j, 1, smem); GSYNC(); }
      REP(10) { phase_gla_combine(p, j); GSYNC(); }
      wt_out = j ? p.wt_gla_out1 : p.wt_gla_out0;
    } else if (kind == 1) {
      REP(11) { phase_fn_in(p, smem); GSYNC(); }
      REP(12) { phase_fn_a(p, smem); GSYNC(); }
      REP(13) { phase_fn_b(p, smem); GSYNC(); }
      wt_out = p.wt_fn_out;
    } else {
      REP(14) { phase_hy_in(p, smem); GSYNC(); }
      REP(15) { phase_hy_conv(p, smem); GSYNC(); }
      REP(16) { phase_hy_transpose(p, smem); GSYNC(); }
      wt_out = p.wt_hy_out;
    }
    for (int rep = 0; rep < (PROBE == 18 ? 3 : 1); ++rep) { phase_gemm_out(p, layer, wt_out, smem, rep + 1 < (PROBE == 18 ? 3 : 1)); GSYNC(); }
  }
  phase_final_norm(p);
}

static inline size_t align_up(size_t x) { return (x + 255) & ~(size_t)255; }

extern "C" void kernel_launch(void* const* d_in, const int* in_sizes, int n_in, void* d_out,
                              int out_size, void* d_ws, size_t ws_size, hipStream_t stream) {
  static int grid_blocks = 0;
  if (!grid_blocks) {
    int dev = 0, cus = 0, per_cu = 0;
    hipGetDevice(&dev);
    hipDeviceGetAttribute(&cus, hipDeviceAttributeMultiprocessorCount, dev);
    hipOccupancyMaxActiveBlocksPerMultiprocessor(&per_cu, mega, NTHR, 0);
    if (per_cu > 2) per_cu = 2;
    if (per_cu < 1) per_cu = 1;
    grid_blocks = cus * per_cu;
  }
  Params p{};
  const float* const* in = (const float* const*)d_in;
  p.x_prompt = in[0]; p.x_sample = in[1]; p.state_gla = in[2]; p.c = in[3]; p.c_ctx = in[4];
  p.mod_w = in[5]; p.mod_b = in[6]; p.norm_g = in[7]; p.final_norm_g = in[8];
  p.gla_w_in = in[9]; p.gla_w_dec = in[10]; p.gla_b_dec = in[11]; p.gla_onorm_g = in[12]; p.gla_w_out = in[13];
  p.fn_w_in = in[14]; p.fn_w_out = in[15];
  p.hy_w_in = in[16]; p.hy_conv_w = in[17]; p.hy_conv_b = in[18];
  p.hy_w1 = in[19]; p.hy_b1 = in[20]; p.hy_w2 = in[21]; p.hy_b2 = in[22]; p.hy_w3 = in[23]; p.hy_b3 = in[24];
  p.hy_w4 = in[25]; p.hy_freq = in[26]; p.hy_d = in[27]; p.hy_w_out = in[28];
  p.out = (float*)d_out;
  char* w = (char*)d_ws;
  size_t off = 0;
  auto take = [&](size_t bytes) { char* r = w + off; off = align_up(off + bytes); return r; };
  p.h = (bf16_t*)take((size_t)NTOK * 1024 * 2);
  p.big = (bf16_t*)take((size_t)156 * 1024 * 1024);
  p.wt_gla_in0 = (bf16_t*)take((size_t)3200 * 1024 * 2);
  p.wt_gla_in1 = (bf16_t*)take((size_t)3200 * 1024 * 2);
  p.wt_gla_out0 = (bf16_t*)take((size_t)1024 * 1024 * 2);
  p.wt_gla_out1 = (bf16_t*)take((size_t)1024 * 1024 * 2);
  p.wt_fn_in = (bf16_t*)take((size_t)2048 * 1024 * 2);
  p.wt_fn_out = (bf16_t*)take((size_t)1024 * 1024 * 2);
  p.wt_hy_in = (bf16_t*)take((size_t)4096 * 1024 * 2);
  p.wt_hy_out = (bf16_t*)take((size_t)1024 * 1024 * 2);
  p.tabA = (bf16_t*)take((size_t)512 * 256 * 2);
  p.tabB_ctx = (bf16_t*)take((size_t)256 * 512 * 2);
  p.tabB_lat = (bf16_t*)take((size_t)2048 * 4096 * 2);
  p.filt_ctx = (bf16_t*)take((size_t)2 * 1024 * 512 * 2);
  p.filt_lat = (bf16_t*)take((size_t)2 * 1024 * 4096 * 2);
  p.filt_a3 = (float*)take((size_t)2304 * 64 * 4);
  p.bar = (unsigned*)take((size_t)XCD_BAR_WORDS * 4 + (size_t)4 * 3 * 3072 * 4);
  p.modv = (float*)(p.bar + XCD_BAR_WORDS);
  p.use_cg = 0; p.pad = 0;
  hipMemsetAsync(p.bar, 0, (size_t)XCD_BAR_WORDS * 4 + (size_t)4 * 3 * 3072 * 4, stream);
  void* args[] = {&p};
  hipError_t e = hipLaunchCooperativeKernel((void*)mega, dim3(grid_blocks), dim3(NTHR), args, 0, stream);
  if (e != hipSuccess) fprintf(stderr, "cooperative launch failed: %s (grid %d, ws %zu need %zu)\n", hipGetErrorString(e), grid_blocks, ws_size, off);
}
```

```cpp
#include <hip/hip_runtime.h>
#include <hip/hip_cooperative_groups.h>
#include <cstdio>
namespace cg = cooperative_groups;

typedef unsigned short bf16_t;
typedef short bf16x8 __attribute__((ext_vector_type(8)));
typedef float f32x16 __attribute__((ext_vector_type(16)));

#ifndef PROBE
#define PROBE 0
#endif
#define NTOK 12288
#define NCTX 8192
#define DM 1024
#define LCTX 256
#define LLAT 2048
#define NTHR 256
#define SMEM_BYTES 73728
#define LDSS 72
#define TWO_PI 6.283185307179586f

struct Params {
  const float *x_prompt, *x_sample, *state_gla, *c, *c_ctx, *mod_w, *mod_b, *norm_g, *final_norm_g;
  const float *gla_w_in, *gla_w_dec, *gla_b_dec, *gla_onorm_g, *gla_w_out;
  const float *fn_w_in, *fn_w_out;
  const float *hy_w_in, *hy_conv_w, *hy_conv_b, *hy_w1, *hy_b1, *hy_w2, *hy_b2, *hy_w3, *hy_b3, *hy_w4, *hy_freq, *hy_d, *hy_w_out;
  float* out;
  bf16_t* h;
  bf16_t* big;
  float* modv;
  bf16_t* wt_gla_in0; bf16_t* wt_gla_in1; bf16_t* wt_gla_out0; bf16_t* wt_gla_out1;
  bf16_t* wt_fn_in; bf16_t* wt_fn_out; bf16_t* wt_hy_in; bf16_t* wt_hy_out;
  bf16_t* tabA; bf16_t* tabB_ctx; bf16_t* tabB_lat;
  bf16_t* filt_ctx; bf16_t* filt_lat;
  float* filt_a3;
  unsigned* bar;
  int use_cg; int pad;
};

typedef __bf16 bf16n2 __attribute__((ext_vector_type(2)));
typedef float f32n2 __attribute__((ext_vector_type(2)));
__device__ __forceinline__ unsigned pk2(float a, float b) {
  f32n2 v = {a, b};
  return __builtin_bit_cast(unsigned, __builtin_convertvector(v, bf16n2));
}
__device__ __forceinline__ bf16_t f2bf(float x) { return (bf16_t)(pk2(x, 0.f) & 0xffffu); }
__device__ __forceinline__ float bf2f(bf16_t b) { return __uint_as_float(((unsigned)b) << 16); }
__device__ __forceinline__ float siluf(float x) { return x / (1.f + expf(-x)); }
__device__ __forceinline__ float logsigf(float x) { return fminf(x, 0.f) - log1pf(expf(-fabsf(x))); }
__device__ __forceinline__ int opaque_tid() { int t = threadIdx.x; asm volatile("" : "+v"(t)); return t; }
__device__ __forceinline__ int opq(int t) { asm volatile("" : "+v"(t)); return t; }
__device__ __forceinline__ int opaque_bid() { int b = blockIdx.x; asm volatile("" : "+s"(b)); return b; }
__device__ __forceinline__ int first_item_(int bid, int off) {
  int G = gridDim.x;
  return (int)((bid + G - (off % G)) % G);
}
#define first_item(off) first_item_(bid, off)

#define GEMM_BUF (2 * 128 * LDSS)
#define GEMM_STAGE_DECL uint4 g_xa0, g_xa1, g_xa2, g_xa3, g_xb0, g_xb1, g_xb2, g_xb3, g_ya0, g_ya1, g_ya2, g_ya3, g_yb0, g_yb1, g_yb2, g_yb3;
#define GEMM_STAGE_ARGS g_xa0, g_xa1, g_xa2, g_xa3, g_xb0, g_xb1, g_xb2, g_xb3, g_ya0, g_ya1, g_ya2, g_ya3, g_yb0, g_yb1, g_yb2, g_yb3
__device__ __forceinline__ void gemm_tile(const bf16_t* __restrict__ A, long lda, const bf16_t* __restrict__ B, long ldb,
                                          int K, bf16_t* sbase, f32x16 (&acc)[2][2], const int tid,
                                          uint4& xa0, uint4& xa1, uint4& xa2, uint4& xa3, uint4& xb0, uint4& xb1, uint4& xb2, uint4& xb3, uint4& ya0, uint4& ya1, uint4& ya2, uint4& ya3, uint4& yb0, uint4& yb1, uint4& yb2, uint4& yb3,
                                          const bool preloaded, const bf16_t* An, const bf16_t* Bn) {
  const int lane = tid & 63, wave = tid >> 6;
  const int wm = wave >> 1, wn = wave & 1;
  const int lr = tid >> 3, lc = (tid & 7) * 8;
#pragma unroll
  for (int i = 0; i < 2; ++i)
#pragma unroll
    for (int j = 0; j < 2; ++j)
#pragma unroll
      for (int r = 0; r < 16; ++r) acc[i][j][r] = 0.f;
  const bf16_t* pa = A + (long)lr * lda + lc;
  const bf16_t* pb = B + (long)lr * ldb + lc;
  const bf16_t* pan = An + (long)lr * lda + lc;
  const bf16_t* pbn = Bn + (long)lr * ldb + lc;
#define GEMM_GLOAD_(S, PA, PB, ko)                            \
  S##a0 = *(const uint4*)(PA + (ko));                      \
  S##a1 = *(const uint4*)(PA + 32 * lda + (ko));           \
  S##a2 = *(const uint4*)(PA + 64 * lda + (ko));           \
  S##a3 = *(const uint4*)(PA + 96 * lda + (ko));           \
  S##b0 = *(const uint4*)(PB + (ko));                      \
  S##b1 = *(const uint4*)(PB + 32 * ldb + (ko));           \
  S##b2 = *(const uint4*)(PB + 64 * ldb + (ko));           \
  S##b3 = *(const uint4*)(PB + 96 * ldb + (ko));
#define GEMM_GLOAD(S, ko) GEMM_GLOAD_(S, pa, pb, ko)
#define GEMM_GLOADN(S, ko) GEMM_GLOAD_(S, pan, pbn, ko)
#define GEMM_LSTORE(S, buf)                                                                      \
  { bf16_t* wa = sbase + (buf) * GEMM_BUF + lr * LDSS + lc; bf16_t* wb = wa + 128 * LDSS;         \
    *(uint4*)(wa) = S##a0; *(uint4*)(wa + 32 * LDSS) = S##a1; *(uint4*)(wa + 64 * LDSS) = S##a2; *(uint4*)(wa + 96 * LDSS) = S##a3; \
    *(uint4*)(wb) = S##b0; *(uint4*)(wb + 32 * LDSS) = S##b1; *(uint4*)(wb + 64 * LDSS) = S##b2; *(uint4*)(wb + 96 * LDSS) = S##b3; }
#define GEMM_COMPUTE(buf)                                                                         \
  { __builtin_amdgcn_s_setprio(1); const bf16_t* ra = sbase + (buf) * GEMM_BUF + (wm * 64 + (lane & 31)) * LDSS + (lane >> 5) * 8; \
    const bf16_t* rb = sbase + (buf) * GEMM_BUF + 128 * LDSS + (wn * 64 + (lane & 31)) * LDSS + (lane >> 5) * 8; \
    _Pragma("unroll") for (int kk = 0; kk < 4; ++kk) {                                            \
      const bf16x8 af0 = *(const bf16x8*)(ra + kk * 16), af1 = *(const bf16x8*)(ra + 32 * LDSS + kk * 16); \
      const bf16x8 bf0 = *(const bf16x8*)(rb + kk * 16), bf1 = *(const bf16x8*)(rb + 32 * LDSS + kk * 16); \
      acc[0][0] = __builtin_amdgcn_mfma_f32_32x32x16_bf16(af0, bf0, acc[0][0], 0, 0, 0);         \
      acc[0][1] = __builtin_amdgcn_mfma_f32_32x32x16_bf16(af0, bf1, acc[0][1], 0, 0, 0);         \
      acc[1][0] = __builtin_amdgcn_mfma_f32_32x32x16_bf16(af1, bf0, acc[1][0], 0, 0, 0);         \
      acc[1][1] = __builtin_amdgcn_mfma_f32_32x32x16_bf16(af1, bf1, acc[1][1], 0, 0, 0);         \
    } __builtin_amdgcn_s_setprio(0); }
  const int nk = K >> 6;
  const bool hasn = (An != nullptr);
  if (!preloaded) {
    GEMM_GLOAD(x, 0)
    if (nk > 1) { GEMM_GLOAD(y, 64) }
  }
  __syncthreads();
  GEMM_LSTORE(x, 0)
  if (nk > 2) { GEMM_GLOAD(x, 128) }
  __syncthreads();
  for (int kt = 0; kt < nk; kt += 2) {
    GEMM_COMPUTE(0)
    if (kt + 1 < nk) { GEMM_LSTORE(y, 1) }
    if (kt + 3 < nk) { GEMM_GLOAD(y, (kt + 3) * 64) }
    else if (hasn && kt + 3 == nk + 1) { GEMM_GLOADN(y, 64) }
    __syncthreads();
    if (kt + 1 < nk) {
      GEMM_COMPUTE(1)
      if (kt + 2 < nk) { GEMM_LSTORE(x, 0) }
      if (kt + 4 < nk) { GEMM_GLOAD(x, (kt + 4) * 64) }
      else if (hasn && kt + 4 == nk) { GEMM_GLOADN(x, 0) }
      __syncthreads();
    }
  }
}

__device__ __forceinline__ void gemm_tile_h(const bf16_t* __restrict__ A, long lda, const bf16_t* __restrict__ B, long ldb,
                                            int K, bf16_t* sbase, f32x16 (&acc)[2], const int tid) {
  const int lane = tid & 63, wave = tid >> 6;
  const int wm = wave >> 1, wn = wave & 1;
  const int lr = tid >> 3, lc = (tid & 7) * 8;
#pragma unroll
  for (int i = 0; i < 2; ++i)
#pragma unroll
    for (int r = 0; r < 16; ++r) acc[i][r] = 0.f;
  const bf16_t* pa = A + (long)lr * lda + lc;
  const bf16_t* pb = B + (long)lr * ldb + lc;
  uint4 xa0, xa1, xa2, xa3, xb0, xb1;
  uint4 ya0, ya1, ya2, ya3, yb0, yb1;
#define GEMMH_GLOAD(S, ko)                                 \
  S##a0 = *(const uint4*)(pa + (ko));                      \
  S##a1 = *(const uint4*)(pa + 32 * lda + (ko));           \
  S##a2 = *(const uint4*)(pa + 64 * lda + (ko));           \
  S##a3 = *(const uint4*)(pa + 96 * lda + (ko));           \
  S##b0 = *(const uint4*)(pb + (ko));                      \
  S##b1 = *(const uint4*)(pb + 32 * ldb + (ko));
#define GEMMH_LSTORE(S, buf)                                                                     \
  { bf16_t* wa = sbase + (buf) * GEMM_BUF + lr * LDSS + lc; bf16_t* wb = wa + 128 * LDSS;         \
    *(uint4*)(wa) = S##a0; *(uint4*)(wa + 32 * LDSS) = S##a1; *(uint4*)(wa + 64 * LDSS) = S##a2; *(uint4*)(wa + 96 * LDSS) = S##a3; \
    *(uint4*)(wb) = S##b0; *(uint4*)(wb + 32 * LDSS) = S##b1; }
#define GEMMH_COMPUTE(buf)                                                                        \
  { const bf16_t* ra = sbase + (buf) * GEMM_BUF + (wm * 64 + (lane & 31)) * LDSS + (lane >> 5) * 8; \
    const bf16_t* rb = sbase + (buf) * GEMM_BUF + 128 * LDSS + (wn * 32 + (lane & 31)) * LDSS + (lane >> 5) * 8; \
    _Pragma("unroll") for (int kk = 0; kk < 4; ++kk) {                                            \
      const bf16x8 af0 = *(const bf16x8*)(ra + kk * 16), af1 = *(const bf16x8*)(ra + 32 * LDSS + kk * 16); \
      const bf16x8 bf0 = *(const bf16x8*)(rb + kk * 16);                                          \
      acc[0] = __builtin_amdgcn_mfma_f32_32x32x16_bf16(af0, bf0, acc[0], 0, 0, 0);               \
      acc[1] = __builtin_amdgcn_mfma_f32_32x32x16_bf16(af1, bf0, acc[1], 0, 0, 0);               \
    } }
  const int nk = K >> 6;
  GEMMH_GLOAD(x, 0)
  if (nk > 1) { GEMMH_GLOAD(y, 64) }
  __syncthreads();
  GEMMH_LSTORE(x, 0)
  if (nk > 2) { GEMMH_GLOAD(x, 128) }
  __syncthreads();
  for (int kt = 0; kt < nk; kt += 2) {
    if (kt + 1 < nk) { GEMMH_LSTORE(y, 1) }
    if (kt + 3 < nk) { GEMMH_GLOAD(y, (kt + 3) * 64) }
    GEMMH_COMPUTE(0)
    __syncthreads();
    if (kt + 1 < nk) {
      if (kt + 2 < nk) { GEMMH_LSTORE(x, 0) }
      if (kt + 4 < nk) { GEMMH_GLOAD(x, (kt + 4) * 64) }
      GEMMH_COMPUTE(1)
      __syncthreads();
    }
  }
}

#define EPI_BEGIN_(ROWEXPR)                                                        \
  {                                                                                \
    const int e_lane = tid & 63, e_wave = tid >> 6;                                \
    const int e_wm = e_wave >> 1, e_wn = e_wave & 1;                               \
    _Pragma("unroll") for (int e_i = 0; e_i < 2; ++e_i)                            \
    _Pragma("unroll") for (int e_j = 0; e_j < 2; ++e_j)                            \
    _Pragma("unroll") for (int e_r = 0; e_r < 16; ++e_r) {                         \
      const int row = ROWEXPR;                                                     \
      const int col = e_wn * 64 + e_j * 32 + (e_lane & 31);                        \
      const float val = acc[e_i][e_j][e_r];
#define EPI_BEGIN EPI_BEGIN_(e_wm * 64 + e_i * 32 + 8 * (e_r >> 2) + 4 * (e_lane >> 5) + (e_r & 3))
#define EPI_BEGIN_OPQ EPI_BEGIN_(opq(e_wm * 64 + e_i * 32 + 8 * (e_r >> 2) + 4 * (e_lane >> 5)) + (e_r & 3))
#define EPI_END }}
#define EPIS_BEGIN                                                                 \
  {                                                                                \
    const int e_lane = tid & 63, e_wave = tid >> 6;                                \
    const int e_rowl = (e_wave >> 1) * 64 + 4 * (e_lane >> 5);                     \
    const int e_coll = (e_wave & 1) * 64 + (e_lane & 31);                          \
    _Pragma("unroll") for (int e_i = 0; e_i < 2; ++e_i)                            \
    _Pragma("unroll") for (int e_j = 0; e_j < 2; ++e_j)                            \
    _Pragma("unroll") for (int e_r = 0; e_r < 16; ++e_r) {                         \
      const int e_rowu = e_i * 32 + 8 * (e_r >> 2) + (e_r & 3);                    \
      const int e_colu = e_j * 32;                                                 \
      const float val = acc[e_i][e_j][e_r];

__device__ __forceinline__ int tok_which(int t) { return t < NCTX ? 0 : 1 + ((t - NCTX) >> 11); }

static __device__ __forceinline__ void p0_mod(const Params& p, char* smem) {
  const int tid = opaque_tid(); const int bid = opaque_bid(); (void)tid; (void)bid;
  float* sc = (float*)smem;
  float* red = sc + 3 * 1024;
  for (int it = first_item(0); it < 192; it += gridDim.x) {
    __syncthreads();
    for (int i = tid; i < 3 * 1024; i += NTHR) {
      const int w = i >> 10, d = i & 1023;
      sc[i] = siluf((w == 0) ? p.c_ctx[d] : p.c[(w - 1) * 1024 + d]);
    }
    __syncthreads();
    const int l = it / 48, e0 = (it % 48) * 64;
    const int col = tid & 63, dq = tid >> 6;
    float a0 = 0.f, a1 = 0.f, a2 = 0.f;
    const float* wp = p.mod_w + ((long)l * 1024 + dq * 256) * 3072 + e0 + col;
    for (int db = 0; db < 256; db += 16) {
      float wv[16];
#pragma unroll
      for (int d = 0; d < 16; ++d) wv[d] = wp[(long)(db + d) * 3072];
#pragma unroll
      for (int d = 0; d < 16; ++d) {
        a0 += sc[dq * 256 + db + d] * wv[d];
        a1 += sc[1024 + dq * 256 + db + d] * wv[d];
        a2 += sc[2048 + dq * 256 + db + d] * wv[d];
      }
    }
    red[(dq * 3 + 0) * 64 + col] = a0;
    red[(dq * 3 + 1) * 64 + col] = a1;
    red[(dq * 3 + 2) * 64 + col] = a2;
    __syncthreads();
    if (tid < 192) {
      const int w = tid >> 6, cc = tid & 63;
      const float sum = red[(0 * 3 + w) * 64 + cc] + red[(1 * 3 + w) * 64 + cc] + red[(2 * 3 + w) * 64 + cc] + red[(3 * 3 + w) * 64 + cc];
      p.modv[(l * 3 + w) * 3072 + e0 + cc] = sum + p.mod_b[l * 3072 + e0 + cc];
    }
  }
}

static __device__ __forceinline__ void p0_filt_mlp(const Params& p, char* smem) {
  const int tid = opaque_tid(); const int bid = opaque_bid(); (void)tid; (void)bid;
  float* z = (float*)smem;
  float* a = z + 16 * 33;
  float* b = a + 1024;
  float* wS = b + 1024;
  for (int it = first_item(192); it < 144; it += gridDim.x) {
    const int lt = (it < 128) ? 1 : 0;
    const int L = lt ? LLAT : LCTX;
    const int p0 = (lt ? it : (it - 128)) * 16;
    float* a3 = p.filt_a3 + (long)(lt ? 256 : 0) * 64;
    __syncthreads();
    for (int i = tid; i < 16 * 33; i += NTHR) {
      const int pp = i / 33, j = i % 33;
      const int l = p0 + pp;
      const float t = (float)l / (float)(L - 1);
      const float w = TWO_PI * (float)l / (float)L;
      float v;
      if (j == 0) v = t;
      else {
        const int bi = (j - 1) & 15;
        const float f = 1e-4f + (float)bi * ((15.0f - 1e-4f) / 15.0f);
        v = (j <= 16) ? cosf(f * w) : -sinf(f * w);
      }
      z[i] = v;
    }
    const int n = opq(tid & 63), pg = opq(tid >> 6);
    const float fr = p.hy_freq[n];
    for (int i = tid; i < 2112; i += NTHR) wS[i] = p.hy_w1[i];
    __syncthreads();
    {
      float acc[4];
#pragma unroll
      for (int q = 0; q < 4; ++q) acc[q] = p.hy_b1[n];
#pragma unroll 3
      for (int jn = 0; jn < 33; ++jn) {
        const float w = wS[jn * 64 + n];
#pragma unroll
        for (int q = 0; q < 4; ++q) acc[q] += z[(pg * 4 + q) * 33 + jn] * w;
      }
#pragma unroll
      for (int q = 0; q < 4; ++q) a[(pg * 4 + q) * 64 + n] = sinf(fr * acc[q]);
    }
    __syncthreads();
    for (int i = tid; i < 4096; i += NTHR) wS[i] = p.hy_w2[i];
    __syncthreads();
    {
      float acc[4];
#pragma unroll
      for (int q = 0; q < 4; ++q) acc[q] = p.hy_b2[n];
#pragma unroll 4
      for (int jn = 0; jn < 64; ++jn) {
        const float w = wS[jn * 64 + n];
#pragma unroll
        for (int q = 0; q < 4; ++q) acc[q] += a[(pg * 4 + q) * 64 + jn] * w;
      }
#pragma unroll
      for (int q = 0; q < 4; ++q) b[(pg * 4 + q) * 64 + n] = sinf(fr * acc[q]);
    }
    __syncthreads();
    for (int i = tid; i < 4096; i += NTHR) wS[i] = p.hy_w3[i];
    __syncthreads();
    {
      float acc[4];
#pragma unroll
      for (int q = 0; q < 4; ++q) acc[q] = p.hy_b3[n];
#pragma unroll 4
      for (int jn = 0; jn < 64; ++jn) {
        const float w = wS[jn * 64 + n];
#pragma unroll
        for (int q = 0; q < 4; ++q) acc[q] += b[(pg * 4 + q) * 64 + jn] * w;
      }
#pragma unroll
      for (int q = 0; q < 4; ++q) a3[(long)(p0 + pg * 4 + q) * 64 + n] = sinf(fr * acc[q]);
    }
  }
}

static __device__ __forceinline__ void phase_filt_main(const Params& p, char* smem) {
  const int tid = opaque_tid(); const int bid = opaque_bid(); (void)tid; (void)bid;
  float* a = (float*)smem;
  const float dmin = -3.0701134573253945f;
  const float dmax = -15.350567286626973f;
  for (int it = bid; it < 36 * 16; it += gridDim.x) {
    const int pc = it >> 4, cb = it & 15;
    const int lt = (pc < 32) ? 1 : 0;
    const int L = lt ? LLAT : LCTX;
    const int p0 = (lt ? pc : (pc - 32)) * 64;
    bf16_t* filt = lt ? p.filt_lat : p.filt_ctx;
    const float* a3 = p.filt_a3 + ((long)(lt ? 256 : 0) + p0) * 64;
    __syncthreads();
    for (int i = tid; i < 1024; i += NTHR) ((float4*)a)[i] = ((const float4*)a3)[i];
    const int cidx = cb * 256 + opq(tid);
    float w4[64];
#pragma unroll
    for (int k = 0; k < 64; ++k) w4[k] = p.hy_w4[k * 4096 + cidx];
    __syncthreads();
    const int ch = cidx & 1023, od = cidx >> 10, order = od >> 1, dir = od & 1;
    const float delta = fabsf(dmin + (float)ch * ((dmax - dmin) / 1023.0f));
    bf16_t* dst = filt + ((long)(order * 1024 + ch)) * (2 * L);
#pragma unroll 1
    for (int pp = 0; pp < 64; ++pp) {
      const float4* ap = (const float4*)(a + pp * 64);
      float acc = 0.f;
#pragma unroll
      for (int k4 = 0; k4 < 16; ++k4) {
        const float4 av = ap[k4];
        acc += av.x * w4[4 * k4 + 0] + av.y * w4[4 * k4 + 1] + av.z * w4[4 * k4 + 2] + av.w * w4[4 * k4 + 3];
      }
      const int l = p0 + pp;
      const float t = (float)l / (float)(L - 1);
      const float v = acc * expf(-t * delta);
      if (dir == 0) dst[L - 1 - l] = f2bf(v);
      else { if (l == 0) dst[2 * L - 1] = 0; else dst[L - 1 + l] = f2bf(v); }
    }
  }
}

static __device__ __forceinline__ void p0_tables(const Params& p, char* smem) {
  const int tid = opaque_tid(); const int bid = opaque_bid(); (void)tid; (void)bid;
  float2* T = (float2*)smem;
  __syncthreads();
  for (int m = tid; m < 2048; m += NTHR) {
    float sv, cv;
    sincosf(TWO_PI * (float)m / 2048.0f, &sv, &cv);
    T[m] = make_float2(cv, sv);
  }
  __syncthreads();
  const int n_items = 64 + 64 + 4096;
  for (int it = first_item(320); it < n_items; it += gridDim.x) {
    unsigned short vals[8];
    if (it < 64) {
#pragma unroll
      for (int q = 0; q < 8; ++q) {
        const int e = it * 2048 + tid * 8 + q;
        const int m = e >> 8, k = e & 255;
        const int cs = m >> 8, co = m & 255;
        const float2 tv = T[((co * k) & 255) * 8];
        vals[q] = f2bf(cs ? tv.y : tv.x);
      }
      *(uint4*)(p.tabA + (long)it * 2048 + tid * 8) = make_uint4(vals[0] | (vals[1] << 16), vals[2] | (vals[3] << 16), vals[4] | (vals[5] << 16), vals[6] | (vals[7] << 16));
    } else if (it < 128) {
#pragma unroll
      for (int q = 0; q < 8; ++q) {
        const int e = (it - 64) * 2048 + tid * 8 + q;
        const int pp = e >> 9, k = e & 511;
        const int cs = k >> 8, pi = k & 255;
        const float2 tv = T[((pp * pi) & 255) * 8];
        vals[q] = f2bf(cs ? -tv.y : tv.x);
      }
      *(uint4*)(p.tabB_ctx + (long)(it - 64) * 2048 + tid * 8) = make_uint4(vals[0] | (vals[1] << 16), vals[2] | (vals[3] << 16), vals[4] | (vals[5] << 16), vals[6] | (vals[7] << 16));
    } else {
#pragma unroll
      for (int q = 0; q < 8; ++q) {
        const int e = (it - 128) * 2048 + tid * 8 + q;
        const int pp = e >> 12, k = e & 4095;
        const int cs = k >> 11, pi = k & 2047;
        const float2 tv = T[(pp * pi) & 2047];
        vals[q] = f2bf(cs ? -tv.y : tv.x);
      }
      *(uint4*)(p.tabB_lat + (long)(it - 128) * 2048 + tid * 8) = make_uint4(vals[0] | (vals[1] << 16), vals[2] | (vals[3] << 16), vals[4] | (vals[5] << 16), vals[6] | (vals[7] << 16));
    }
  }
}

static __device__ __forceinline__ void wt_transpose_items(const float* __restrict__ W, bf16_t* __restrict__ Wt, int N, int Npad, int off, char* smem) {
  const int tid = opaque_tid(); const int bid = opaque_bid(); (void)tid; (void)bid;
  float* t = (float*)smem;
  const int ntn = Npad / 64;
  const int n_items = ntn * 16;
  for (int it = first_item(off); it < n_items; it += gridDim.x) {
    const int nt = it % ntn, kt = it / ntn;
    const int n0 = nt * 64, k0 = kt * 64;
    __syncthreads();
    const int tx = tid & 63, ty = tid >> 6;
    float v[16];
#pragma unroll
    for (int i = 0; i < 16; ++i) v[i] = (n0 + tx < N) ? W[(long)(k0 + ty + 4 * i) * N + n0 + tx] : 0.f;
#pragma unroll
    for (int i = 0; i < 16; ++i) t[tx * 65 + ty + 4 * i] = v[i];
    __syncthreads();
    const int r = tid >> 2, cch = (tid & 3) * 16;
    unsigned w[8];
#pragma unroll
    for (int q = 0; q < 8; ++q) w[q] = pk2(t[r * 65 + cch + 2 * q], t[r * 65 + cch + 2 * q + 1]);
    uint4* dp = (uint4*)(Wt + (long)(n0 + r) * 1024 + k0 + cch);
    dp[0] = make_uint4(w[0], w[1], w[2], w[3]);
    dp[1] = make_uint4(w[4], w[5], w[6], w[7]);
  }
}

static __device__ __forceinline__ void p0_weights(const Params& p, char* smem) {
  wt_transpose_items(p.gla_w_in, p.wt_gla_in0, 3104, 3200, 0, smem);
  wt_transpose_items(p.gla_w_out, p.wt_gla_out0, 1024, 1024, 288, smem);
  wt_transpose_items(p.fn_w_in, p.wt_fn_in, 2048, 2048, 32, smem);
  wt_transpose_items(p.fn_w_out, p.wt_fn_out, 1024, 1024, 32, smem);
  wt_transpose_items(p.hy_w_in, p.wt_hy_in, 4096, 4096, 288, smem);
  wt_transpose_items(p.hy_w_out, p.wt_hy_out, 1024, 1024, 288, smem);
  wt_transpose_items(p.gla_w_in + (long)1024 * 3104, p.wt_gla_in1, 3104, 3200, 32, smem);
  wt_transpose_items(p.gla_w_out + (long)1024 * 1024, p.wt_gla_out1, 1024, 1024, 288, smem);
}

static __device__ __forceinline__ void phase_norm(const Params& p, int layer) {
  const int tid = opaque_tid(); const int bid = opaque_bid(); (void)tid; (void)bid;
  const int lane = tid & 63, wave = tid >> 6;
  const float* g = p.norm_g + layer * 1024;
  const int stride = gridDim.x * 4;
  for (int t0 = bid * 4 + wave; t0 < NTOK; t0 += 2 * stride) {
    float4 v[2][4];
#pragma unroll
    for (int u = 0; u < 2; ++u) {
      const int t = t0 + u * stride;
      if (t < NTOK) {
        const float* xr;
        if (layer == 0) xr = (t < NCTX) ? (p.x_prompt + (long)t * 1024) : (p.x_sample + (long)(t - NCTX) * 1024);
        else xr = p.out + (long)t * 1024;
#pragma unroll
        for (int i = 0; i < 4; ++i) v[u][i] = *(const float4*)(xr + lane * 4 + 256 * i);
      }
    }
#pragma unroll
    for (int u = 0; u < 2; ++u) {
      const int t = t0 + u * stride;
      if (t < NTOK) {
        const float* mv = p.modv + (layer * 3 + tok_which(t)) * 3072;
        float ss = 0.f;
#pragma unroll
        for (int i = 0; i < 4; ++i) ss += v[u][i].x * v[u][i].x + v[u][i].y * v[u][i].y + v[u][i].z * v[u][i].z + v[u][i].w * v[u][i].w;
#pragma unroll
        for (int o = 32; o > 0; o >>= 1) ss += __shfl_xor(ss, o);
        const float rstd = rsqrtf(ss * (1.0f / 1024.0f) + 1e-6f);
#pragma unroll
        for (int i = 0; i < 4; ++i) {
          const int c0 = lane * 4 + 256 * i;
          const float4 gg = *(const float4*)(g + c0);
          const float4 sh = *(const float4*)(mv + c0);
          const float4 sc = *(const float4*)(mv + 1024 + c0);
          uint2 w;
          w.x = pk2((v[u][i].x * rstd * gg.x) * (1.f + sc.x) + sh.x, (v[u][i].y * rstd * gg.y) * (1.f + sc.y) + sh.y);
          w.y = pk2((v[u][i].z * rstd * gg.z) * (1.f + sc.z) + sh.z, (v[u][i].w * rstd * gg.w) * (1.f + sc.w) + sh.w);
          *(uint2*)(p.h + (long)t * 1024 + c0) = w;
        }
      }
    }
  }
}

static __device__ __forceinline__ void phase_final_norm(const Params& p) {
  const int tid = opaque_tid(); const int bid = opaque_bid(); (void)tid; (void)bid;
  const int lane = tid & 63, wave = tid >> 6;
  for (int t = bid * 4 + wave; t < NTOK; t += gridDim.x * 4) {
    float* xr = p.out + (long)t * 1024;
    float4 v[4];
    float ss = 0.f;
#pragma unroll
    for (int i = 0; i < 4; ++i) {
      v[i] = *(const float4*)(xr + lane * 4 + 256 * i);
      ss += v[i].x * v[i].x + v[i].y * v[i].y + v[i].z * v[i].z + v[i].w * v[i].w;
    }
#pragma unroll
    for (int o = 32; o > 0; o >>= 1) ss += __shfl_xor(ss, o);
    const float rstd = rsqrtf(ss * (1.0f / 1024.0f) + 1e-6f);
#pragma unroll
    for (int i = 0; i < 4; ++i) {
      const int c0 = lane * 4 + 256 * i;
      float4 gg = *(const float4*)(p.final_norm_g + c0);
      float4 o;
      o.x = v[i].x * rstd * gg.x; o.y = v[i].y * rstd * gg.y; o.z = v[i].z * rstd * gg.z; o.w = v[i].w * rstd * gg.w;
      *(float4*)(xr + c0) = o;
    }
  }
}

static __device__ __forceinline__ void phase_gemm_out(const Params& p, int layer, const bf16_t* Wt, char* smem, const int dummy) {
  const int tid = opaque_tid(); const int bid = opaque_bid(); (void)tid; (void)bid;
  bf16_t* sA = (bf16_t*)smem;
  GEMM_STAGE_DECL
  float* outp = dummy ? (float*)p.big : p.out;
  const int n_tiles = 96 * 8;
  const int nfull = (gridDim.x == 512) ? 512 : n_tiles;
  const int n_items = nfull + 2 * (n_tiles - nfull);
  for (int item = bid; item < n_items; item += gridDim.x) {
    const bool is_half = item >= nfull;
    const int tile = is_half ? nfull + ((item - nfull) >> 1) : item;
    const int hsel = is_half ? ((item - nfull) & 1) : 0;
    const int mt = tile % 96, nt = tile / 96;
    const int m0 = mt * 128, n0 = nt * 128 + hsel * 64;
    const float* gate = p.modv + (layer * 3 + tok_which(m0)) * 3072 + 2048;
    const float* xsrc = (layer == 0) ? ((m0 < NCTX) ? p.x_prompt : (p.x_sample - (long)NCTX * 1024)) : p.out;
    const int e_lane = tid & 63, e_wave = tid >> 6;
    const int e_wm = e_wave >> 1, e_wn = e_wave & 1;
    if (!is_half) {
      f32x16 acc[2][2];
      gemm_tile(p.h + (long)m0 * 1024, 1024, Wt + (long)n0 * 1024, 1024, 1024, sA, acc, tid, GEMM_STAGE_ARGS, false, nullptr, nullptr);
      float xo[2][2][16];
      const float* xb = xsrc + (long)m0 * 1024 + n0;
      float* ob = outp + (long)m0 * 1024 + n0;
      EPIS_BEGIN
        (void)val;
        const unsigned lo = 4u * (unsigned)(e_rowl * 1024 + e_coll);
        xo[e_i][e_j][e_r] = *(const float*)((const char*)(xb + e_rowu * 1024 + e_colu) + lo);
      EPI_END
      EPIS_BEGIN
        const unsigned lo = 4u * (unsigned)(e_rowl * 1024 + e_coll);
        *(float*)((char*)(ob + e_rowu * 1024 + e_colu) + lo) = xo[e_i][e_j][e_r] + gate[n0 + e_coll + e_colu] * val;
      EPI_END
    } else {
      f32x16 acc[2];
      gemm_tile_h(p.h + (long)m0 * 1024, 1024, Wt + (long)n0 * 1024, 1024, 1024, sA, acc, tid);
      const int n = n0 + e_wn * 32 + (e_lane & 31);
      const float gn = gate[n];
      float xo[2][16];
#pragma unroll
      for (int e_i = 0; e_i < 2; ++e_i)
#pragma unroll
        for (int e_r = 0; e_r < 16; ++e_r) {
          const int row = e_wm * 64 + e_i * 32 + 8 * (e_r >> 2) + 4 * (e_lane >> 5) + (e_r & 3);
          xo[e_i][e_r] = xsrc[(long)(m0 + row) * 1024 + n];
        }
#pragma unroll
      for (int e_i = 0; e_i < 2; ++e_i)
#pragma unroll
        for (int e_r = 0; e_r < 16; ++e_r) {
          const int row = e_wm * 64 + e_i * 32 + 8 * (e_r >> 2) + 4 * (e_lane >> 5) + (e_r & 3);
          outp[(long)(m0 + row) * 1024 + n] = xo[e_i][e_r] + gn * acc[e_i][e_r];
        }
    }
  }
}

#define GLA_PROJ(p) ((p).big)
#define GLA_LR(p) ((float*)((p).big + (long)NTOK * 3072))
#define GLA_OF(p) ((p).big + (long)NTOK * 3072 + (long)NTOK * 64)
#define GLA_OB(p) (GLA_OF(p) + (long)NTOK * 1024)

static __device__ __forceinline__ void phase_gla_in(const Params& p, const bf16_t* Wt, char* smem) {
  const int tid = opaque_tid(); const int bid = opaque_bid(); (void)tid; (void)bid;
  bf16_t* sA = (bf16_t*)smem;
  GEMM_STAGE_DECL
  bool pre = false;
  bf16_t* proj = GLA_PROJ(p);
  float* lrb = GLA_LR(p);
  const int n_tiles = 96 * 25;
  for (int tile = bid; tile < n_tiles; tile += gridDim.x) {
    const int mt = tile % 96, nt = tile / 96;
    const int m0 = mt * 128, n0 = nt * 128;
    f32x16 acc[2][2];
    {
      const int tn = tile + gridDim.x;
      const bool hn = tn < n_tiles;
      gemm_tile(p.h + (long)m0 * 1024, 1024, Wt + (long)n0 * 1024, 1024, 1024, sA, acc, tid, GEMM_STAGE_ARGS, pre,
                hn ? p.h + (long)((tn % 96) * 128) * 1024 : nullptr, hn ? Wt + (long)((tn / 96) * 128) * 1024 : nullptr);
      pre = hn;
    }
    if (n0 < 3072) {
      bf16_t* tb = proj + (long)m0 * 3072 + n0;
      EPIS_BEGIN
        const unsigned lo = 2u * (unsigned)(e_rowl * 3072 + e_coll);
        *(bf16_t*)((char*)(tb + e_rowu * 3072 + e_colu) + lo) = f2bf(val);
      EPI_END
    } else {
      EPI_BEGIN
        const int t = m0 + row, n = n0 + col;
        if (n < 3104) lrb[(long)t * 32 + (n - 3072)] = val;
      EPI_END
    }
  }
}

#define GLA_IMG1(p) (GLA_OB(p) + (long)NTOK * 1024)
#define GLA_BLAST(p) ((float*)(GLA_IMG1(p) + (long)NTOK * 1024))
static __device__ __forceinline__ void phase_gla_prep(const Params& p, int j, char* smem, const int dummy) {
  const int tid = opaque_tid(); const int bid = opaque_bid();
  float* sLR = (float*)smem;
  bf16_t* proj = GLA_PROJ(p);
  bf16_t* img1 = GLA_IMG1(p);
  const float* lrb = GLA_LR(p);
  float* blast = GLA_BLAST(p);
  const int dkp = tid & 127, dir = tid >> 7;
  for (int it = bid; it < (NTOK / 32) * 2; it += gridDim.x) {
    const int tb = it >> 1, hp = it & 1;
    const int dk = hp * 256 + 2 * dkp;
    __syncthreads();
    ((float4*)sLR)[tid] = *(const float4*)(lrb + ((long)tb * 32 + (tid >> 3)) * 32 + (tid & 7) * 4);
    unsigned rq[32], rk[32];
    {
      const bf16_t* rp = proj + ((long)tb * 32 + (dir ? 31 : 0)) * 3072 + dk;
      const long rstep = dir ? -3072 : 3072;
#pragma unroll
      for (int s_ = 0; s_ < 32; ++s_) {
        rq[s_] = *(const unsigned*)rp;
        rk[s_] = *(const unsigned*)(rp + 512);
        rp += rstep;
      }
    }
    float wd0[16], wd1[16];
    const float* wdp = p.gla_w_dec + ((long)(j * 2 + dir) * 16) * 512 + dk;
#pragma unroll
    for (int r = 0; r < 16; ++r) { const float2 w2 = *(const float2*)(wdp + r * 512); wd0[r] = w2.x; wd1[r] = w2.y; }
    const float2 bd = *(const float2*)(p.gla_b_dec + (j * 2 + dir) * 512 + dk);
    __syncthreads();
    float2* sC = (float2*)(sLR + 1024) + tid;
    float run0 = 0.f, run1 = 0.f;
#pragma unroll
    for (int s_ = 0; s_ < 32; ++s_) {
      const int pos = dir ? 31 - s_ : s_;
      const float4* lp = (const float4*)(sLR + pos * 32 + dir * 16);
      float lg0 = bd.x, lg1 = bd.y;
#pragma unroll
      for (int r4 = 0; r4 < 4; ++r4) {
        const float4 l4 = lp[r4];
        lg0 += l4.x * wd0[r4 * 4 + 0] + l4.y * wd0[r4 * 4 + 1] + l4.z * wd0[r4 * 4 + 2] + l4.w * wd0[r4 * 4 + 3];
        lg1 += l4.x * wd1[r4 * 4 + 0] + l4.y * wd1[r4 * 4 + 1] + l4.z * wd1[r4 * 4 + 2] + l4.w * wd1[r4 * 4 + 3];
      }
      run0 += (fminf(lg0, 0.f) - __logf(1.f + __expf(-fabsf(lg0)))) * (1.0f / 16.0f);
      run1 += (fminf(lg1, 0.f) - __logf(1.f + __expf(-fabsf(lg1)))) * (1.0f / 16.0f);
      sC[s_ * 256] = make_float2(run0, run1);
    }
    *(float2*)(blast + ((long)dir * (NTOK / 32) + tb) * 512 + dk) = make_float2(run0, run1);
    bf16_t* dst = dir ? img1 : (dummy ? GLA_OF(p) : proj);
    const long dstr = (dir || dummy) ? 1024 : 3072;
    {
      bf16_t* wp = dst + ((long)tb * 32 + (dir ? 31 : 0)) * dstr + dk;
      const long wstep = dir ? -dstr : dstr;
#pragma unroll
      for (int s_ = 0; s_ < 32; ++s_) {
        const float2 cc = sC[s_ * 256];
        const float e0 = cc.x - run0, e1 = cc.y - run1;
        const float qs0 = 0.08838834764831845f * __expf(fminf(e0, 80.f)), qs1 = 0.08838834764831845f * __expf(fminf(e1, 80.f));
        const float ks0 = __expf(-e0), ks1 = __expf(-e1);
        *(unsigned*)wp = pk2(bf2f((bf16_t)(rq[s_] & 0xffffu)) * qs0, bf2f((bf16_t)(rq[s_] >> 16)) * qs1);
        *(unsigned*)(wp + 512) = pk2(bf2f((bf16_t)(rk[s_] & 0xffffu)) * ks0, bf2f((bf16_t)(rk[s_] >> 16)) * ks1);
        wp += wstep;
      }
    }
  }
}

#define QS 136
#define TS 40
#define GLA_SLOC(p) ((float*)((p).h))
#define GLA_GSEG(p) (((float*)((p).h)) + (long)128 * 128 * 256)
__device__ __forceinline__ int crow_(int r, int hf) { return (r & 3) + 8 * (r >> 2) + 4 * hf; }
__device__ __forceinline__ bf16x8 pack8(const f32x16& x, const int st) {
  union { unsigned u[4]; bf16x8 v; } c;
  c.u[0] = pk2(x[8 * st + 0], x[8 * st + 1]);
  c.u[1] = pk2(x[8 * st + 2], x[8 * st + 3]);
  c.u[2] = pk2(x[8 * st + 4], x[8 * st + 5]);
  c.u[3] = pk2(x[8 * st + 6], x[8 * st + 7]);
  return c.v;
}
__device__ __forceinline__ bf16x8 ld2x8(const bf16_t* a, const bf16_t* b) {
  union { uint2 d[2]; bf16x8 v; } c;
  c.d[0] = *(const uint2*)a;
  c.d[1] = *(const uint2*)b;
  return c.v;
}

__device__ __forceinline__ unsigned kimg_off(unsigned row, unsigned ch) { return 256u * row + 16u * (ch ^ (((row & 3u) << 2) | ((row >> 2) & 3u))); }
__device__ __forceinline__ unsigned kimg_tr(unsigned lane, unsigned c, unsigned ks, unsigned t) {
  const unsigned h = lane >> 5, blk = (lane >> 4) & 1u, q = (lane & 15u) >> 2, pp = lane & 3u;
  return kimg_off(16u * ks + 8u * h + 4u * t + q, 4u * c + 2u * blk + (pp >> 1)) + 8u * (pp & 1u);
}
typedef short s16x4 __attribute__((ext_vector_type(4)));

static __device__ __forceinline__ void phase_gla_scan(const Params& p, int j, int pass, char* smem) {
  const int tid = opaque_tid(); const int bid = opaque_bid();
  bf16_t* sQ = (bf16_t*)smem;
  bf16_t* sK = sQ + 32 * QS;
  bf16_t* sKT = sK + 32 * QS;
  bf16_t* sVT = sKT + 128 * TS;
  float* sDec = (float*)(sVT + 64 * TS);
  float* sOp = sDec + 128;
  const bf16_t* proj = GLA_PROJ(p);
  const bf16_t* img1 = GLA_IMG1(p);
  const float* blast = GLA_BLAST(p);
  float* sloc = GLA_SLOC(p);
  float* gseg = GLA_GSEG(p);
  const int lane = tid & 63, wave = tid >> 6, l31 = lane & 31, hf = lane >> 5;
  const int kh = wave >> 1, nt = wave & 1;
  const int dk0 = (tid & 63) * 2, sg = tid >> 6;
  const int vp = tid & 31, sg8 = tid >> 5;
  const int irow = tid >> 3, icol = (tid & 7) * 16;
  char* sKb = (char*)sK;
  char* sVb = (char*)sKT;
  const unsigned vbase = (unsigned)(size_t)sVb;
  const unsigned vtr0 = vbase + kimg_tr(lane, nt, 0, 0), vtr1 = vbase + kimg_tr(lane, nt, 0, 1);
  const unsigned vtr2 = vbase + kimg_tr(lane, nt, 1, 0), vtr3 = vbase + kimg_tr(lane, nt, 1, 1);
  const unsigned vq_ = (lane & 15) >> 2, vch_ = 4 * nt + 2 * ((lane >> 4) & 1) + ((lane & 3) >> 1), vb8_ = 8 * (lane & 1);
  const unsigned vtrp0 = vbase + kimg_off(16 * kh + 4 * hf + vq_, vch_) + vb8_;
  const unsigned vtrp1 = vbase + kimg_off(16 * kh + 8 + 4 * hf + vq_, vch_) + vb8_;
  const unsigned kbase = (unsigned)(size_t)sKb;
  const unsigned ktr0 = kbase + kimg_tr(lane, 2 * kh + 0, 0, 0), ktr1 = kbase + kimg_tr(lane, 2 * kh + 0, 0, 1);
  const unsigned ktr2 = kbase + kimg_tr(lane, 2 * kh + 0, 1, 0), ktr3 = kbase + kimg_tr(lane, 2 * kh + 0, 1, 1);
  const unsigned ktr4 = kbase + kimg_tr(lane, 2 * kh + 1, 0, 0), ktr5 = kbase + kimg_tr(lane, 2 * kh + 1, 0, 1);
  const unsigned ktr6 = kbase + kimg_tr(lane, 2 * kh + 1, 1, 0), ktr7 = kbase + kimg_tr(lane, 2 * kh + 1, 1, 1);
  const int n_items = pass == 0 ? (1024 + 512) : 512;
  for (int it = bid; it < n_items; it += gridDim.x) {
    int b, hh, dir, vt, sidx, L, tbase;
    bool full, lat;
    if (pass == 0 && it < 1024) {
      vt = it & 3; const int combo = it >> 2;
      dir = combo & 1; hh = (combo >> 1) & 3; b = combo >> 3; sidx = 0;
      L = LCTX; tbase = b * LCTX; full = true; lat = false;
    } else {
      const int i2 = pass == 0 ? it - 1024 : it;
      vt = i2 & 3; const int combo = i2 >> 2;
      dir = combo & 1; hh = (combo >> 1) & 3; sidx = (combo >> 3) & 7; b = combo >> 6;
      L = LLAT; tbase = NCTX + b * LLAT; full = (pass == 1); lat = true;
    }
    bf16_t* obuf = dir ? GLA_OB(p) : GLA_OF(p);
    const bf16_t* ib = dir ? img1 : proj;
    const long istr = dir ? 1024 : 3072;
    const int vcol = vt * 64 + nt * 32 + l31;
    const int sgn = dir ? -1 : 1;
    const int offq = (dir ? 31 - irow : irow) * (int)istr + icol;
    const int offv = (dir ? 31 - irow : irow) * 3072 + (tid & 7) * 8;
    const int offo = (dir ? 31 - 4 * hf : 4 * hf) * 1024 + vcol;
    f32x16 S0, S1;
    if (pass == 0) {
#pragma unroll
      for (int r = 0; r < 16; ++r) { S0[r] = 0.f; S1[r] = 0.f; }
    } else {
      const int rb = opq((kh * 64 + 4 * hf) * 256 + vcol);
      const float* s0 = p.state_gla + ((((long)b * 2 + j) * 2 + dir) * 4 + hh) * 128 * 256 + rb;
#pragma unroll
      for (int r = 0; r < 16; ++r) {
        S0[r] = s0[crow_(r, 0) * 256];
        S1[r] = s0[(32 + crow_(r, 0)) * 256];
      }
      int i = 0;
      const int gofs = opq(kh * 64 + 4 * hf);
      for (; i + 1 < sidx; i += 2) {
        const int ci = (((b * 8 + i) * 4 + hh) * 2 + dir), cj = (((b * 8 + i + 1) * 4 + hh) * 2 + dir);
        const float* sl = sloc + (long)ci * 128 * 256 + rb;
        const float* gs = gseg + ci * 128 + gofs;
        const float* sl2 = sloc + (long)cj * 128 * 256 + rb;
        const float* gs2 = gseg + cj * 128 + gofs;
        float la0[16], la1[16], ga0[16], ga1[16], lb0[16], lb1[16], gb0[16], gb1[16];
#pragma unroll
        for (int r = 0; r < 16; ++r) {
          ga0[r] = gs[crow_(r, 0)]; ga1[r] = gs[32 + crow_(r, 0)];
          la0[r] = sl[crow_(r, 0) * 256]; la1[r] = sl[(32 + crow_(r, 0)) * 256];
          gb0[r] = gs2[crow_(r, 0)]; gb1[r] = gs2[32 + crow_(r, 0)];
          lb0[r] = sl2[crow_(r, 0) * 256]; lb1[r] = sl2[(32 + crow_(r, 0)) * 256];
        }
#pragma unroll
        for (int r = 0; r < 16; ++r) {
          S0[r] = __expf(gb0[r]) * (__expf(ga0[r]) * S0[r] + la0[r]) + lb0[r];
          S1[r] = __expf(gb1[r]) * (__expf(ga1[r]) * S1[r] + la1[r]) + lb1[r];
        }
      }
      for (; i < sidx; ++i) {
        const int ci = (((b * 8 + i) * 4 + hh) * 2 + dir);
        const float* sl = sloc + (long)ci * 128 * 256 + rb;
        const float* gs = gseg + ci * 128 + gofs;
#pragma unroll
        for (int r = 0; r < 16; ++r) {
          S0[r] = __expf(gs[crow_(r, 0)]) * S0[r] + sl[crow_(r, 0) * 256];
          S1[r] = __expf(gs[32 + crow_(r, 0)]) * S1[r] + sl[(32 + crow_(r, 0)) * 256];
        }
      }
    }
    float gsum = 0.f;
    struct GlaRegs { uint4 q0, q1, k0, k1, v; float bl; };
    GlaRegs RA, RB;
    RA.q0 = make_uint4(0u, 0u, 0u, 0u); RA.q1 = RA.q0; RB.q0 = RA.q0; RB.q1 = RA.q0; RA.bl = 0.f; RB.bl = 0.f;
#define GLA_TOK(u_) ((long)tbase + (dir ? (L - 1 - (u_)) : (u_)))
    auto gla_load = [&](const int c_, GlaRegs& R) __attribute__((always_inline)) {
      const int ub = sidx * 256 + c_ * 32;
      const long TB = (long)tbase + (dir ? (L - 32 - ub) : ub);
      {
        const bf16_t* rp = ib + TB * istr + hh * 128 + offq;
        if (full) { R.q0 = *(const uint4*)rp; R.q1 = *(const uint4*)(rp + 8); }
        R.k0 = *(const uint4*)(rp + 512); R.k1 = *(const uint4*)(rp + 520);
      }
      R.v = *(const uint4*)(proj + TB * 3072 + 1024 + hh * 256 + vt * 64 + offv);
      if (tid < 128) R.bl = blast[((long)dir * (NTOK / 32) + (TB >> 5)) * 512 + hh * 128 + tid];
    };
    auto gla_chunk = [&](const int c, GlaRegs& R) __attribute__((always_inline)) {
      if (full) {
        *(uint4*)(sQ + irow * QS + icol) = R.q0; *(uint4*)(sQ + irow * QS + icol + 8) = R.q1;
      }
      *(uint4*)(sKb + kimg_off(irow, 2 * (tid & 7))) = R.k0;
      *(uint4*)(sKb + kimg_off(irow, 2 * (tid & 7) + 1)) = R.k1;
      *(uint4*)(sVb + kimg_off(irow, tid & 7)) = R.v;
      if (tid < 128) { sDec[tid] = __expf(R.bl); gsum += R.bl; }
      __syncthreads();
      if (c + 2 < 8) gla_load(c + 2, R);
#pragma unroll
      for (int r = 0; r < 16; ++r) {
        S0[r] *= sDec[kh * 64 + crow_(r, hf)];
        S1[r] *= sDec[kh * 64 + 32 + crow_(r, hf)];
      }
      f32x16 o;
      if (full) {
        f32x16 att;
#pragma unroll
        for (int r = 0; r < 16; ++r) { att[r] = 0.f; o[r] = 0.f; }
#pragma unroll
        for (int kk = 0; kk < 8; ++kk) {
          const bf16x8 a = *(const bf16x8*)(sKb + kimg_off(l31, 2 * kk + hf));
          const bf16x8 bq = *(const bf16x8*)(sQ + l31 * QS + kk * 16 + 8 * hf);
          att = __builtin_amdgcn_mfma_f32_32x32x16_bf16(a, bq, att, 0, 0, 0);
        }
#pragma unroll
        for (int r = 0; r < 16; ++r) if (crow_(r, hf) > l31) att[r] = 0.f;
#pragma unroll
        for (int st = 0; st < 2; ++st) {
          {
            const bf16_t* qa = sQ + l31 * QS + kh * 64 + 16 * st + 4 * hf;
            o = __builtin_amdgcn_mfma_f32_32x32x16_bf16(ld2x8(qa, qa + 8), pack8(S0, st), o, 0, 0, 0);
          }
          {
            const bf16_t* qa = sQ + l31 * QS + kh * 64 + 32 + 16 * st + 4 * hf;
            o = __builtin_amdgcn_mfma_f32_32x32x16_bf16(ld2x8(qa, qa + 8), pack8(S1, st), o, 0, 0, 0);
          }
        }
        {
          const bf16x8 pa0 = pack8(att, 0), pa1 = pack8(att, 1);
          const bf16x8 pa = kh ? pa1 : pa0;
          s16x4 u0, u1;
          asm volatile("ds_read_b64_tr_b16 %0, %2\n\tds_read_b64_tr_b16 %1, %3\n\ts_waitcnt lgkmcnt(0)"
                       : "=&v"(u0), "=&v"(u1) : "v"(vtrp0), "v"(vtrp1) : "memory");
          o = __builtin_amdgcn_mfma_f32_32x32x16_bf16(pa, __builtin_shufflevector(u0, u1, 0, 1, 2, 3, 4, 5, 6, 7), o, 0, 0, 0);
        }
        if (kh == 1) {
#pragma unroll
          for (int r = 0; r < 16; ++r) sOp[(nt * 32 + crow_(r, hf)) * 32 + l31] = o[r];
        }
      }
      {
        s16x4 t00, t01, t02, t03, t10, t11, t12, t13;
        s16x4 w0, w1, w2, w3;
        asm volatile(
            "ds_read_b64_tr_b16 %0, %12\n\t"
            "ds_read_b64_tr_b16 %1, %13\n\t"
            "ds_read_b64_tr_b16 %2, %14\n\t"
            "ds_read_b64_tr_b16 %3, %15\n\t"
            "ds_read_b64_tr_b16 %4, %16\n\t"
            "ds_read_b64_tr_b16 %5, %17\n\t"
            "ds_read_b64_tr_b16 %6, %18\n\t"
            "ds_read_b64_tr_b16 %7, %19\n\t"
            "ds_read_b64_tr_b16 %8, %20\n\t"
            "ds_read_b64_tr_b16 %9, %21\n\t"
            "ds_read_b64_tr_b16 %10, %22\n\t"
            "ds_read_b64_tr_b16 %11, %23\n\t"
            "s_waitcnt lgkmcnt(0)"
            : "=&v"(t00), "=&v"(t01), "=&v"(t02), "=&v"(t03), "=&v"(t10), "=&v"(t11), "=&v"(t12), "=&v"(t13),
              "=&v"(w0), "=&v"(w1), "=&v"(w2), "=&v"(w3)
            : "v"(ktr0), "v"(ktr1), "v"(ktr2), "v"(ktr3), "v"(ktr4), "v"(ktr5), "v"(ktr6), "v"(ktr7),
              "v"(vtr0), "v"(vtr1), "v"(vtr2), "v"(vtr3)
            : "memory");
        const bf16x8 a00 = __builtin_shufflevector(t00, t01, 0, 1, 2, 3, 4, 5, 6, 7);
        const bf16x8 a01 = __builtin_shufflevector(t02, t03, 0, 1, 2, 3, 4, 5, 6, 7);
        const bf16x8 a10 = __builtin_shufflevector(t10, t11, 0, 1, 2, 3, 4, 5, 6, 7);
        const bf16x8 a11 = __builtin_shufflevector(t12, t13, 0, 1, 2, 3, 4, 5, 6, 7);
        const bf16x8 bv0 = __builtin_shufflevector(w0, w1, 0, 1, 2, 3, 4, 5, 6, 7);
        const bf16x8 bv1 = __builtin_shufflevector(w2, w3, 0, 1, 2, 3, 4, 5, 6, 7);
        S0 = __builtin_amdgcn_mfma_f32_32x32x16_bf16(a00, bv0, S0, 0, 0, 0);
        S1 = __builtin_amdgcn_mfma_f32_32x32x16_bf16(a10, bv0, S1, 0, 0, 0);
        S0 = __builtin_amdgcn_mfma_f32_32x32x16_bf16(a01, bv1, S0, 0, 0, 0);
        S1 = __builtin_amdgcn_mfma_f32_32x32x16_bf16(a11, bv1, S1, 0, 0, 0);
      }
      __syncthreads();
      if (full && kh == 0) {
        const int ub = sidx * 256 + c * 32;
        const long TB = (long)tbase + (dir ? (L - 32 - ub) : ub);
#pragma unroll
        for (int r = 0; r < 16; ++r) {
          const int srow = crow_(r, hf);
          const float val = o[r] + sOp[(nt * 32 + srow) * 32 + l31];
          bf16_t* uo = obuf + (TB + sgn * (8 * (r >> 2) + (r & 3))) * 1024 + hh * 256;
          uo[offo] = f2bf(val);
        }
      }
    };
    gla_load(0, RA);
    gla_load(1, RB);
    __syncthreads();
    for (int c = 0; c < 8; c += 2) {
      gla_chunk(c, RA);
      gla_chunk(c + 1, RB);
    }
    const int rbo = opq((kh * 64 + 4 * hf) * 256 + vcol);
    if (!lat) {
      float* so = p.out + (long)NTOK * 1024 + ((((long)b * 2 + j) * 2 + dir) * 4 + hh) * 128 * 256 + rbo;
#pragma unroll
      for (int r = 0; r < 16; ++r) {
        so[crow_(r, 0) * 256] = S0[r];
        so[(32 + crow_(r, 0)) * 256] = S1[r];
      }
    } else if (pass == 0) {
      const int ci = (((b * 8 + sidx) * 4 + hh) * 2 + dir);
      float* sl = sloc + (long)ci * 128 * 256 + rbo;
#pragma unroll
      for (int r = 0; r < 16; ++r) {
        sl[crow_(r, 0) * 256] = S0[r];
        sl[(32 + crow_(r, 0)) * 256] = S1[r];
      }
      if (vt == 0 && tid < 128) gseg[ci * 128 + tid] = gsum;
    }
    __syncthreads();
  }
}

static __device__ __forceinline__ void phase_gla_combine(const Params& p, int j) {
  const int tid = opaque_tid(); const int bid = opaque_bid(); (void)tid; (void)bid;
  const int lane = tid & 63, wave = tid >> 6;
  const bf16_t* proj = GLA_PROJ(p);
  const bf16_t* of = GLA_OF(p);
  const bf16_t* ob = GLA_OB(p);
  const float* og = p.gla_onorm_g + j * 256;
  const float4 gg = *(const float4*)(og + lane * 4);
  const int stride = gridDim.x * 4;
  for (int it0 = bid * 4 + wave; it0 < NTOK * 4; it0 += 4 * stride) {
    uint2 a[4], b[4], r[4];
#pragma unroll
    for (int u = 0; u < 4; ++u) {
      const int it = it0 + u * stride;
      if (it < NTOK * 4) {
        const int t = it >> 2, hh = it & 3;
        const long base = (long)t * 1024 + hh * 256 + lane * 4;
        a[u] = *(const uint2*)(of + base);
        b[u] = *(const uint2*)(ob + base);
        r[u] = *(const uint2*)(proj + (long)t * 3072 + 2048 + hh * 256 + lane * 4);
      }
    }
#pragma unroll
    for (int u = 0; u < 4; ++u) {
      const int it = it0 + u * stride;
      if (it < NTOK * 4) {
        const int t = it >> 2, hh = it & 3;
        const long base = (long)t * 1024 + hh * 256 + lane * 4;
        float o[4];
        o[0] = bf2f(a[u].x & 0xffff) + bf2f(b[u].x & 0xffff);
        o[1] = bf2f(a[u].x >> 16) + bf2f(b[u].x >> 16);
        o[2] = bf2f(a[u].y & 0xffff) + bf2f(b[u].y & 0xffff);
        o[3] = bf2f(a[u].y >> 16) + bf2f(b[u].y >> 16);
        const float r0 = bf2f(r[u].x & 0xffff), r1 = bf2f(r[u].x >> 16), r2 = bf2f(r[u].y & 0xffff), r3 = bf2f(r[u].y >> 16);
        float ss = o[0] * o[0] + o[1] * o[1] + o[2] * o[2] + o[3] * o[3];
#pragma unroll
        for (int sft = 32; sft > 0; sft >>= 1) ss += __shfl_xor(ss, sft);
        const float rstd = rsqrtf(ss * (1.0f / 256.0f) + 1e-6f);
        uint2 w;
        w.x = pk2(o[0] * rstd * gg.x * siluf(r0), o[1] * rstd * gg.y * siluf(r1));
        w.y = pk2(o[2] * rstd * gg.z * siluf(r2), o[3] * rstd * gg.w * siluf(r3));
        *(uint2*)(p.h + base) = w;
      }
    }
  }
}

#define FN_PROJ(p) ((p).big)
#define FN_XCS_CTX(p) ((p).big + (long)NTOK * 2048)
#define FN_XCS_LAT(p) (FN_XCS_CTX(p) + (long)NCTX * 2048)

static __device__ __forceinline__ void phase_fn_in(const Params& p, char* smem) {
  const int tid = opaque_tid(); const int bid = opaque_bid(); (void)tid; (void)bid;
  bf16_t* sA = (bf16_t*)smem;
  GEMM_STAGE_DECL
  bool pre = false;
  bf16_t* proj = FN_PROJ(p);
  const int n_tiles = 96 * 16;
  for (int tile = bid; tile < n_tiles; tile += gridDim.x) {
    const int mt = tile % 96, nt = tile / 96;
    const int m0 = mt * 128, n0 = nt * 128;
    f32x16 acc[2][2];
    {
      const int tn = tile + gridDim.x;
      const bool hn = tn < n_tiles;
      gemm_tile(p.h + (long)m0 * 1024, 1024, p.wt_fn_in + (long)n0 * 1024, 1024, 1024, sA, acc, tid, GEMM_STAGE_ARGS, pre,
                hn ? p.h + (long)((tn % 96) * 128) * 1024 : nullptr, hn ? p.wt_fn_in + (long)((tn / 96) * 128) * 1024 : nullptr);
      pre = hn;
    }
    {
      bf16_t* tb = proj + (long)m0 * 2048 + n0;
      EPIS_BEGIN
        const unsigned lo = 2u * (unsigned)(e_rowl * 2048 + e_coll);
        *(bf16_t*)((char*)(tb + e_rowu * 2048 + e_colu) + lo) = f2bf(val);
      EPI_END
    }
  }
}

static __device__ __forceinline__ void phase_fn_a(const Params& p, char* smem) {
  const int tid = opaque_tid(); const int bid = opaque_bid(); (void)tid; (void)bid;
  bf16_t* sA = (bf16_t*)smem;
  GEMM_STAGE_DECL
  const bf16_t* proj = FN_PROJ(p);
  const int n_tiles = 4 * 96 * 4;
  for (int tile = bid; tile < n_tiles; tile += gridDim.x) {
    const int mt = tile & 3, g = (tile >> 2) & 3, tt = tile >> 4;
    const int m0 = mt * 128, t0 = tt * 128;
    f32x16 acc[2][2];
    gemm_tile(p.tabA + (long)m0 * 256, 256, proj + (long)t0 * 2048 + g * 256, 2048, 256, sA, acc, tid, GEMM_STAGE_ARGS, false, nullptr, nullptr);
    const bool lat = t0 >= NCTX;
    const int L = lat ? LLAT : LCTX;
    const int b = lat ? ((t0 - NCTX) >> 11) : (t0 >> 8);
    const int pos0 = lat ? ((t0 - NCTX) & 2047) : (t0 & 255);
    bf16_t* dst = lat ? FN_XCS_LAT(p) : FN_XCS_CTX(p);
    EPI_BEGIN_OPQ
      const int m = m0 + row;
      const int cs = m >> 8, co = m & 255;
      dst[((long)((b * 4 + g) * 256 + co)) * (2 * L) + cs * L + pos0 + col] = f2bf(val);
    EPI_END
  }
}

static __device__ __forceinline__ void phase_fn_b(const Params& p, char* smem) {
  const int tid = opaque_tid(); const int bid = opaque_bid(); (void)tid; (void)bid;
  bf16_t* sA = (bf16_t*)smem;
  GEMM_STAGE_DECL
  const bf16_t* proj = FN_PROJ(p);
  const int n_lat = 2 * 4 * 16 * 2;
  const int n_ctx = 32 * 4 * 2 * 2;
  const bool rebal = (gridDim.x == 512);
  for (int it_ = bid; it_ < (rebal ? 1024 : n_lat + n_ctx); it_ += gridDim.x) {
    int tile = it_;
    if (rebal) {
      if (it_ < 512) tile = (it_ < 256) ? it_ : (256 + 2 * (it_ - 256));
      else tile = (it_ - 512 < 256) ? -1 : (256 + 2 * (it_ - 768) + 1);
      if (tile < 0) continue;
    }
    int b, g, mt, nt, L, tbase;
    const bf16_t *tab, *xcs;
    if (tile < n_lat) {
      nt = tile & 1; mt = (tile >> 1) & 15; g = (tile >> 5) & 3; b = tile >> 7;
      L = LLAT; tbase = NCTX + b * LLAT; tab = p.tabB_lat; xcs = FN_XCS_LAT(p);
    } else {
      int t2 = tile - n_lat;
      nt = t2 & 1; mt = (t2 >> 1) & 1; g = (t2 >> 2) & 3; b = t2 >> 4;
      L = LCTX; tbase = b * LCTX; tab = p.tabB_ctx; xcs = FN_XCS_CTX(p);
    }
    const int m0 = mt * 128, n0 = nt * 128;
    f32x16 acc[2][2];
    gemm_tile(tab + (long)m0 * (2 * L), 2 * L, xcs + ((long)((b * 4 + g) * 256 + n0)) * (2 * L), 2 * L, 2 * L, sA, acc, tid, GEMM_STAGE_ARGS, false, nullptr, nullptr);
    const float scale = rsqrtf((float)L * 256.0f);
    {
      const int e_lane = tid & 63, e_wave = tid >> 6;
      const int e_wm = e_wave >> 1, e_wn = e_wave & 1;
#pragma unroll
      for (int e_i = 0; e_i < 2; ++e_i)
#pragma unroll
        for (int e_j = 0; e_j < 2; ++e_j) {
          const int rowb = opq(e_wm * 64 + e_i * 32 + 4 * (e_lane >> 5));
          const int ch = g * 256 + n0 + e_wn * 64 + e_j * 32 + (e_lane & 31);
          bf16_t zr[16];
#pragma unroll
          for (int e_r = 0; e_r < 16; ++e_r) zr[e_r] = proj[(long)(tbase + m0 + rowb + 8 * (e_r >> 2) + (e_r & 3)) * 2048 + 1024 + ch];
#pragma unroll
          for (int e_r = 0; e_r < 16; ++e_r)
            p.h[(long)(tbase + m0 + rowb + 8 * (e_r >> 2) + (e_r & 3)) * 1024 + ch] = f2bf(acc[e_i][e_j][e_r] * scale * siluf(bf2f(zr[e_r])));
        }
    }
  }
}

#define HY_UT(p) ((p).big)
#define HY_YT(p) ((p).big + (long)4096 * NTOK)

static __device__ __forceinline__ void phase_hy_in(const Params& p, char* smem) {
  const int tid = opaque_tid(); const int bid = opaque_bid(); (void)tid; (void)bid;
  bf16_t* sA = (bf16_t*)smem;
  GEMM_STAGE_DECL
  bool pre = false;
  bf16_t* uT = HY_UT(p);
  const int n_tiles = 32 * 96;
  for (int tile = bid; tile < n_tiles; tile += gridDim.x) {
    const int nt = tile % 96, mt = tile / 96;
    const int m0 = mt * 128, n0 = nt * 128;
    f32x16 acc[2][2];
    {
      const int tn = tile + gridDim.x;
      const bool hn = tn < n_tiles;
      gemm_tile(p.wt_hy_in + (long)m0 * 1024, 1024, p.h + (long)n0 * 1024, 1024, 1024, sA, acc, tid, GEMM_STAGE_ARGS, pre,
                hn ? p.wt_hy_in + (long)((tn / 96) * 128) * 1024 : nullptr, hn ? p.h + (long)((tn % 96) * 128) * 1024 : nullptr);
      pre = hn;
    }
    {
      bf16_t* tb = uT + (long)m0 * NTOK + n0;
      EPIS_BEGIN
        const unsigned lo = 2u * (unsigned)(e_rowl * NTOK + e_coll);
        *(bf16_t*)((char*)(tb + e_rowu * NTOK + e_colu) + lo) = f2bf(val);
      EPI_END
    }
  }
}

__device__ __forceinline__ int upad(int pos) { return pos + 8 * (pos >> 5); }
static __device__ __forceinline__ void phase_hy_conv(const Params& p, char* smem) {
  const int tid = opaque_tid(); const int bid = opaque_bid();
  bf16_t* sU = (bf16_t*)smem;
  bf16_t* sX1 = sU + 10240;
  bf16_t* sX2 = sX1 + 8192;
  bf16_t* sR0 = sX2 + 8192;
  bf16_t* sR1 = sR0 + 4128;
  const bf16_t* uT = HY_UT(p);
  bf16_t* yT = HY_YT(p);
  const int lane = tid & 63, wave = tid >> 6, l31 = lane & 31, hf = lane >> 5;
  const int n_items = 1024 + 1024;
  for (int it = bid; it < n_items; it += gridDim.x) {
    const bool lat = it < 1024;
    const int ch = lat ? it : (it - 1024);
    const int L = lat ? LLAT : LCTX;
    const int nb = L >> 5;
    const int tok0 = lat ? NCTX : 0;
    const int ntw = lat ? 1 : 2;
    const bf16_t* filt = (lat ? p.filt_lat : p.filt_ctx);
    __syncthreads();
    for (int pc = 0; pc < ntw; ++pc) {
      const int p0 = pc * 4096 + tid * 16;
      const bool has_l = (p0 & (L - 1)) != 0, has_r = ((p0 + 16) & (L - 1)) != 0;
#pragma unroll
      for (int g = 0; g < 3; ++g) {
        const int f = g * 1024 + ch;
        const bf16_t* row = uT + (long)f * NTOK + tok0 + p0;
        const uint4 v0 = *(const uint4*)row, v1 = *(const uint4*)(row + 8);
        float e[18];
        e[0] = has_l ? bf2f(row[-1]) : 0.f;
        e[17] = has_r ? bf2f(row[16]) : 0.f;
        const unsigned vv[8] = {v0.x, v0.y, v0.z, v0.w, v1.x, v1.y, v1.z, v1.w};
#pragma unroll
        for (int q = 0; q < 8; ++q) { e[1 + 2 * q] = bf2f((bf16_t)(vv[q] & 0xffffu)); e[2 + 2 * q] = bf2f((bf16_t)(vv[q] >> 16)); }
        const float w0 = p.hy_conv_w[f], w1 = p.hy_conv_w[3072 + f], w2 = p.hy_conv_w[6144 + f], bb = p.hy_conv_b[f];
        unsigned o[8];
#pragma unroll
        for (int q = 0; q < 8; ++q) {
          const float a0 = e[2 * q] * w0 + e[2 * q + 1] * w1 + e[2 * q + 2] * w2 + bb;
          const float a1 = e[2 * q + 1] * w0 + e[2 * q + 2] * w1 + e[2 * q + 3] * w2 + bb;
          o[q] = pk2(a0, a1);
        }
        bf16_t* dst = (g == 0) ? (sX1 + p0) : (g == 1) ? (sX2 + p0) : (sU + upad(p0));
        uint4 o0, o1;
        o0.x = o[0]; o0.y = o[1]; o0.z = o[2]; o0.w = o[3];
        o1.x = o[4]; o1.y = o[5]; o1.z = o[6]; o1.w = o[7];
        *(uint4*)dst = o0;
        *(uint4*)(dst + 8) = o1;
      }
    }
    const int xa = (L - 1) - l31 + 8 * hf;
    const bf16_t* Rp = (xa & 1) ? (sR1 - 1) : sR0;
    float y1r[2][16];
    for (int order = 0; order < 2; ++order) {
      const bf16_t* fsrc = filt + ((long)(order * 1024 + ch)) * (2 * L);
      for (int x8 = tid; x8 < (2 * L) / 8; x8 += NTHR) {
        const uint4 v = *(const uint4*)(fsrc + 8 * x8);
        *(uint4*)(sR0 + 8 * x8) = v;
        const unsigned vv[4] = {v.x, v.y, v.z, v.w};
#pragma unroll
        for (int q = 0; q < 4; ++q) {
          if (8 * x8 + 2 * q >= 1) sR1[8 * x8 + 2 * q - 1] = (bf16_t)(vv[q] & 0xffffu);
          sR1[8 * x8 + 2 * q] = (bf16_t)(vv[q] >> 16);
        }
      }
      __syncthreads();
      const float dsk = p.hy_d[order * 1024 + ch];
      const bf16_t* gate = order ? sX2 : sX1;
#pragma unroll
      for (int tt = 0; tt < 2; ++tt) {
        if (tt < ntw) {
          int bt, i_blk, dlo, dhi;
          if (lat) { bt = wave >> 1; const int i0 = 32 * (wave & 1); i_blk = i0 + l31; dlo = i0 - 63; dhi = i0 + 31; }
          else { bt = 4 * (2 * wave + tt) + (l31 >> 3); i_blk = l31 & 7; dlo = -7; dhi = 7; }
          const bf16_t* ubase = sU + upad(bt * L);
          const int pos_base = bt * L + 32 * i_blk + 4 * hf;
          f32x16 acc;
#pragma unroll
          for (int r = 0; r < 16; ++r) acc[r] = 0.f;
          for (int d = dlo; d <= dhi; ++d) {
            const int jb = i_blk - d;
            const bool valid = (unsigned)jb < (unsigned)nb;
            const int jc = valid ? jb : 0;
            const bf16_t* bp = ubase + 40 * jc + 8 * hf;
            const unsigned* ap = (const unsigned*)(Rp + (xa - 32 * d));
#pragma unroll
            for (int ks2 = 0; ks2 < 2; ++ks2) {
              union { unsigned u[4]; bf16x8 v; } A;
              A.u[0] = ap[8 * ks2 + 0]; A.u[1] = ap[8 * ks2 + 1]; A.u[2] = ap[8 * ks2 + 2]; A.u[3] = ap[8 * ks2 + 3];
              union { uint4 q; bf16x8 v; } B;
              B.q = *(const uint4*)(bp + 16 * ks2);
              if (!valid) { B.q.x = 0u; B.q.y = 0u; B.q.z = 0u; B.q.w = 0u; }
              acc = __builtin_amdgcn_mfma_f32_32x32x16_bf16(A.v, B.v, acc, 0, 0, 0);
            }
          }
#pragma unroll
          for (int g = 0; g < 4; ++g) {
            const int pos = pos_base + 8 * g;
            const uint2 gg = *(const uint2*)(gate + pos);
            const uint2 uo = *(const uint2*)(sU + upad(pos));
            const float g0 = bf2f((bf16_t)(gg.x & 0xffffu)), g1 = bf2f((bf16_t)(gg.x >> 16)), g2 = bf2f((bf16_t)(gg.y & 0xffffu)), g3 = bf2f((bf16_t)(gg.y >> 16));
            const float u0 = bf2f((bf16_t)(uo.x & 0xffffu)), u1 = bf2f((bf16_t)(uo.x >> 16)), u2 = bf2f((bf16_t)(uo.y & 0xffffu)), u3 = bf2f((bf16_t)(uo.y >> 16));
            y1r[tt][4 * g + 0] = g0 * (acc[4 * g + 0] + dsk * u0);
            y1r[tt][4 * g + 1] = g1 * (acc[4 * g + 1] + dsk * u1);
            y1r[tt][4 * g + 2] = g2 * (acc[4 * g + 2] + dsk * u2);
            y1r[tt][4 * g + 3] = g3 * (acc[4 * g + 3] + dsk * u3);
          }
        }
      }
      __syncthreads();
#pragma unroll
      for (int tt = 0; tt < 2; ++tt) {
        if (tt < ntw) {
          int bt, i_blk;
          if (lat) { bt = wave >> 1; i_blk = 32 * (wave & 1) + l31; }
          else { bt = 4 * (2 * wave + tt) + (l31 >> 3); i_blk = l31 & 7; }
          const int pos_base = bt * L + 32 * i_blk + 4 * hf;
          if (order == 0) {
#pragma unroll
            for (int g = 0; g < 4; ++g) {
              uint2 w;
              w.x = pk2(y1r[tt][4 * g + 0], y1r[tt][4 * g + 1]);
              w.y = pk2(y1r[tt][4 * g + 2], y1r[tt][4 * g + 3]);
              *(uint2*)(sU + upad(pos_base + 8 * g)) = w;
            }
          } else {
            uint2 zz[4];
#pragma unroll
            for (int g = 0; g < 4; ++g) zz[g] = *(const uint2*)(uT + (long)(3072 + ch) * NTOK + tok0 + pos_base + 8 * g);
#pragma unroll
            for (int g = 0; g < 4; ++g) {
              const long gp = (long)tok0 + pos_base + 8 * g;
              const float z0 = bf2f((bf16_t)(zz[g].x & 0xffffu)), z1 = bf2f((bf16_t)(zz[g].x >> 16)), z2 = bf2f((bf16_t)(zz[g].y & 0xffffu)), z3 = bf2f((bf16_t)(zz[g].y >> 16));
              uint2 w;
              w.x = pk2(y1r[tt][4 * g + 0] * siluf(z0), y1r[tt][4 * g + 1] * siluf(z1));
              w.y = pk2(y1r[tt][4 * g + 2] * siluf(z2), y1r[tt][4 * g + 3] * siluf(z3));
              *(uint2*)(yT + (long)ch * NTOK + gp) = w;
            }
          }
        }
      }
    }
  }
}

static __device__ __forceinline__ void phase_hy_transpose(const Params& p, char* smem) {
  const int tid = opaque_tid(); const int bid = opaque_bid(); (void)tid; (void)bid;
  bf16_t* t = (bf16_t*)smem;
  const bf16_t* yT = HY_YT(p);
  const int n_items = 16 * 192;
  for (int it = bid; it < n_items; it += gridDim.x) {
    const int ct = it & 15, tt = it >> 4;
    const int c0 = ct * 64, t0 = tt * 64;
    __syncthreads();
    for (int i = tid; i < 64 * 64; i += NTHR) {
      int r = i >> 6, cc = i & 63;
      t[cc * 66 + r] = yT[(long)(c0 + r) * NTOK + t0 + cc];
    }
    __syncthreads();
    for (int i = tid; i < 64 * 64; i += NTHR) {
      int r = i >> 6, cc = i & 63;
      p.h[(long)(t0 + r) * 1024 + c0 + cc] = t[r * 66 + cc];
    }
  }
}

#define XB_TMO      128
#define XB_XCNT(j)  (256  + 64 * (j))
#define XB_XSUB(j)  (1280 + 64 * (j))
#define XB_XGEN(j)  (2304 + 64 * (j))
#define XB_TOP      3328
#define XB_TOPGEN   3392
#define XCD_BAR_WORDS 3456
#define XB_SPIN_CAP (1u << 18)
#define LAS __attribute__((address_space(3)))
__device__ __forceinline__ unsigned xb_ld(unsigned* p)              { return __hip_atomic_load(p, __ATOMIC_RELAXED, __HIP_MEMORY_SCOPE_AGENT); }
__device__ __forceinline__ unsigned xb_add(unsigned* p, unsigned v) { return __hip_atomic_fetch_add(p, v, __ATOMIC_RELAXED, __HIP_MEMORY_SCOPE_AGENT); }
__device__ __forceinline__ unsigned xb_xcc_id() { return (unsigned)__builtin_amdgcn_s_getreg((3 << 11) | 20) & 0xFu; }
#define XB_SPIN(cond, bar) do { unsigned _sp = 0; while (cond) { __builtin_amdgcn_s_sleep(1); \
    if ((++_sp & 255u) == 0u) { if (xb_ld(&(bar)[XB_TMO])) break; if (_sp > XB_SPIN_CAP) { atomicAdd(&(bar)[XB_TMO], 1u); break; } } } } while (0)
struct XcdBarrier { unsigned* bar; unsigned x; volatile LAS unsigned* st; };
__device__ __forceinline__ XcdBarrier xcd_barrier_post(unsigned* bar, volatile LAS unsigned* st) {
    XcdBarrier b; b.bar = bar; b.x = xb_xcc_id(); b.st = st;
    if (threadIdx.x == 0) (void)xb_add(&bar[XB_XCNT(b.x)], 1u);
    return b;
}
__device__ __forceinline__ void xcd_barrier_complete(unsigned* bar, unsigned x, unsigned& nloc, unsigned& nx) {
    const unsigned G = gridDim.x * gridDim.y * gridDim.z;
    unsigned sum, cnt, mine, sp = 0u;
    for (;;) {
        sum = 0u; cnt = 0u; mine = 0u;
#pragma unroll
        for (unsigned j = 0; j < 16; ++j) { const unsigned c = xb_ld(&bar[XB_XCNT(j)]); sum += c; cnt += (c > 0u) ? 1u : 0u; mine = (j == x) ? c : mine; }
        if (sum == G) break;
        __builtin_amdgcn_s_sleep(1);
        if ((++sp & 255u) == 0u) { if (xb_ld(&bar[XB_TMO])) break; if (sp > XB_SPIN_CAP) { atomicAdd(&bar[XB_TMO], 1u); break; } }
    }
    nloc = mine > 0u ? mine : 1u; nx = cnt > 0u ? cnt : 1u;
}
__device__ __forceinline__ void xcd_barrier(const XcdBarrier& b) {
    asm volatile("s_waitcnt vmcnt(0)" ::: "memory");
    __syncthreads();
    if (threadIdx.x == 0) {
        unsigned* bar = b.bar;
        __builtin_amdgcn_s_waitcnt(0);
        unsigned nloc = b.st[0], nx = b.st[1];
        if (nloc == 0u) { xcd_barrier_complete(bar, b.x, nloc, nx); b.st[0] = nloc; b.st[1] = nx; }
        const unsigned old = xb_add(&bar[XB_XSUB(b.x)], 1u);
        const unsigned gen = old / nloc;
        if (old + 1u == (gen + 1u) * nloc) {
            __builtin_amdgcn_fence(__ATOMIC_RELEASE, "agent");
            asm volatile("s_waitcnt vmcnt(0)" ::: "memory");
            const unsigned og = xb_add(&bar[XB_TOP], 1u);
            const unsigned tg = og / nx;
            if (og + 1u == (tg + 1u) * nx) xb_add(&bar[XB_TOPGEN], 1u);
            else XB_SPIN(xb_ld(&bar[XB_TOPGEN]) == tg, bar);
            __builtin_amdgcn_fence(__ATOMIC_ACQUIRE, "agent");
            xb_add(&bar[XB_XGEN(b.x)], 1u);
            asm volatile("s_waitcnt vmcnt(0)" ::: "memory");
        } else {
            XB_SPIN(xb_ld(&bar[XB_XGEN(b.x)]) == gen, bar);
            __builtin_amdgcn_fence(__ATOMIC_ACQUIRE, "agent");
            asm volatile("s_waitcnt vmcnt(0)" ::: "memory");
        }
    }
    __syncthreads();
}

__global__ void __launch_bounds__(NTHR, 2) mega(Params p) {
  cg::grid_group grid = cg::this_grid();
  __shared__ __attribute__((aligned(16))) char smem[SMEM_BYTES];
  __shared__ uint4 xb_words;
  if (threadIdx.x == 0) xb_words = make_uint4(0u, 0u, 0u, 0u);
  __syncthreads();
  const XcdBarrier xb = xcd_barrier_post(p.bar, (volatile LAS unsigned*)&xb_words);
  if (p.use_cg) grid.sync();
#define GSYNC() xcd_barrier(xb)
#define REP(id) for (int rep##id = 0; rep##id < (PROBE == (id) ? 3 : 1); ++rep##id)
  REP(19) {
  REP(1) { p0_mod(p, smem); }
  REP(2) { p0_filt_mlp(p, smem); }
  REP(3) { p0_tables(p, smem); }
  REP(4) { p0_weights(p, smem); }
  GSYNC();
  }
  if (PROBE == 5) { for (int rep = 0; rep < 40; ++rep) GSYNC(); }
  for (int layer = 0; layer < 4; ++layer) {
    const int kind = layer % 3, j = layer / 3;
    REP(6) { phase_norm(p, layer); if (layer == 1) phase_filt_main(p, smem); GSYNC(); }
    const bf16_t* wt_out;
    if (kind == 0) {
      REP(7) { phase_gla_in(p, j ? p.wt_gla_in1 : p.wt_gla_in0, smem); GSYNC(); }
      for (int rep = 0; rep < (PROBE == 17 ? 3 : 1); ++rep) { phase_gla_prep(p, j, smem, rep + 1 < (PROBE == 17 ? 3 : 1)); GSYNC(); }
      REP(8) { phase_gla_scan(p, j, 0, smem); GSYNC(); }
      REP(9) { phase_gla_scan(p, j, 1, smem); GSYNC(); }
      REP(10) { phase_gla_combine(p, j); GSYNC(); }
      wt_out = j ? p.wt_gla_out1 : p.wt_gla_out0;
    } else if (kind == 1) {
      REP(11) { phase_fn_in(p, smem); GSYNC(); }
      REP(12) { phase_fn_a(p, smem); GSYNC(); }
      REP(13) { phase_fn_b(p, smem); GSYNC(); }
      wt_out = p.wt_fn_out;
    } else {
      REP(14) { phase_hy_in(p, smem); GSYNC(); }
      REP(15) { phase_hy_conv(p, smem); GSYNC(); }
      REP(16) { phase_hy_transpose(p, smem); GSYNC(); }
      wt_out = p.wt_hy_out;
    }
    for (int rep = 0; rep < (PROBE == 18 ? 3 : 1); ++rep) { phase_gemm_out(p, layer, wt_out, smem, rep + 1 < (PROBE == 18 ? 3 : 1)); GSYNC(); }
  }
  phase_final_norm(p);
}

static inline size_t align_up(size_t x) { return (x + 255) & ~(size_t)255; }

extern "C" void kernel_launch(void* const* d_in, const int* in_sizes, int n_in, void* d_out,
                              int out_size, void* d_ws, size_t ws_size, hipStream_t stream) {
  static int grid_blocks = 0;
  if (!grid_blocks) {
    int dev = 0, cus = 0, per_cu = 0;
    hipGetDevice(&dev);
    hipDeviceGetAttribute(&cus, hipDeviceAttributeMultiprocessorCount, dev);
    hipOccupancyMaxActiveBlocksPerMultiprocessor(&per_cu, mega, NTHR, 0);
    if (per_cu > 2) per_cu = 2;
    if (per_cu < 1) per_cu = 1;
    grid_blocks = cus * per_cu;
  }
  Params p{};
  const float* const* in = (const float* const*)d_in;
  p.x_prompt = in[0]; p.x_sample = in[1]; p.state_gla = in[2]; p.c = in[3]; p.c_ctx = in[4];
  p.mod_w = in[5]; p.mod_b = in[6]; p.norm_g = in[7]; p.final_norm_g = in[8];
  p.gla_w_in = in[9]; p.gla_w_dec = in[10]; p.gla_b_dec = in[11]; p.gla_onorm_g = in[12]; p.gla_w_out = in[13];
  p.fn_w_in = in[14]; p.fn_w_out = in[15];
  p.hy_w_in = in[16]; p.hy_conv_w = in[17]; p.hy_conv_b = in[18];
  p.hy_w1 = in[19]; p.hy_b1 = in[20]; p.hy_w2 = in[21]; p.hy_b2 = in[22]; p.hy_w3 = in[23]; p.hy_b3 = in[24];
  p.hy_w4 = in[25]; p.hy_freq = in[26]; p.hy_d = in[27]; p.hy_w_out = in[28];
  p.out = (float*)d_out;
  char* w = (char*)d_ws;
  size_t off = 0;
  auto take = [&](size_t bytes) { char* r = w + off; off = align_up(off + bytes); return r; };
  p.h = (bf16_t*)take((size_t)NTOK * 1024 * 2);
  p.big = (bf16_t*)take((size_t)156 * 1024 * 1024);
  p.wt_gla_in0 = (bf16_t*)take((size_t)3200 * 1024 * 2);
  p.wt_gla_in1 = (bf16_t*)take((size_t)3200 * 1024 * 2);
  p.wt_gla_out0 = (bf16_t*)take((size_t)1024 * 1024 * 2);
  p.wt_gla_out1 = (bf16_t*)take((size_t)1024 * 1024 * 2);
  p.wt_fn_in = (bf16_t*)take((size_t)2048 * 1024 * 2);
  p.wt_fn_out = (bf16_t*)take((size_t)1024 * 1024 * 2);
  p.wt_hy_in = (bf16_t*)take((size_t)4096 * 1024 * 2);
  p.wt_hy_out = (bf16_t*)take((size_t)1024 * 1024 * 2);
  p.tabA = (bf16_t*)take((size_t)512 * 256 * 2);
  p.tabB_ctx = (bf16_t*)take((size_t)256 * 512 * 2);
  p.tabB_lat = (bf16_t*)take((size_t)2048 * 4096 * 2);
  p.filt_ctx = (bf16_t*)take((size_t)2 * 1024 * 512 * 2);
  p.filt_lat = (bf16_t*)take((size_t)2 * 1024 * 4096 * 2);
  p.filt_a3 = (float*)take((size_t)2304 * 64 * 4);
  p.bar = (unsigned*)take((size_t)XCD_BAR_WORDS * 4 + (size_t)4 * 3 * 3072 * 4);
  p.modv = (float*)(p.bar + XCD_BAR_WORDS);
  p.use_cg = 0; p.pad = 0;
  hipMemsetAsync(p.bar, 0, (size_t)XCD_BAR_WORDS * 4 + (size_t)4 * 3 * 3072 * 4, stream);
  void* args[] = {&p};
  hipError_t e = hipLaunchCooperativeKernel((void*)mega, dim3(grid_blocks), dim3(NTHR), args, 0, stream);
  if (e != hipSuccess) fprintf(stderr, "cooperative launch failed: %s (grid %d, ws %zu need %zu)\n", hipGetErrorString(e), grid_blocks, ws_size, off);
}
```

```cpp
#include <hip/hip_runtime.h>
#include <hip/hip_cooperative_groups.h>
#include <cstdio>
namespace cg = cooperative_groups;

typedef unsigned short bf16_t;
typedef short bf16x8 __attribute__((ext_vector_type(8)));
typedef float f32x16 __attribute__((ext_vector_type(16)));

#ifndef PROBE
#define PROBE 0
#endif
#define NTOK 12288
#define NCTX 8192
#define DM 1024
#define LCTX 256
#define LLAT 2048
#define NTHR 256
#define SMEM_BYTES 73728
#define LDSS 72
#define TWO_PI 6.283185307179586f

struct Params {
  const float *x_prompt, *x_sample, *state_gla, *c, *c_ctx, *mod_w, *mod_b, *norm_g, *final_norm_g;
  const float *gla_w_in, *gla_w_dec, *gla_b_dec, *gla_onorm_g, *gla_w_out;
  const float *fn_w_in, *fn_w_out;
  const float *hy_w_in, *hy_conv_w, *hy_conv_b, *hy_w1, *hy_b1, *hy_w2, *hy_b2, *hy_w3, *hy_b3, *hy_w4, *hy_freq, *hy_d, *hy_w_out;
  float* out;
  bf16_t* h;
  bf16_t* big;
  float* modv;
  bf16_t* wt_gla_in0; bf16_t* wt_gla_in1; bf16_t* wt_gla_out0; bf16_t* wt_gla_out1;
  bf16_t* wt_fn_in; bf16_t* wt_fn_out; bf16_t* wt_hy_in; bf16_t* wt_hy_out;
  bf16_t* tabA; bf16_t* tabB_ctx; bf16_t* tabB_lat;
  bf16_t* filt_ctx; bf16_t* filt_lat;
  float* filt_a3;
  unsigned* bar;
  int use_cg; int pad;
};

typedef __bf16 bf16n2 __attribute__((ext_vector_type(2)));
typedef float f32n2 __attribute__((ext_vector_type(2)));
__device__ __forceinline__ unsigned pk2(float a, float b) {
  f32n2 v = {a, b};
  return __builtin_bit_cast(unsigned, __builtin_convertvector(v, bf16n2));
}
__device__ __forceinline__ bf16_t f2bf(float x) { return (bf16_t)(pk2(x, 0.f) & 0xffffu); }
__device__ __forceinline__ float bf2f(bf16_t b) { return __uint_as_float(((unsigned)b) << 16); }
__device__ __forceinline__ float siluf(float x) { return x / (1.f + expf(-x)); }
__device__ __forceinline__ float logsigf(float x) { return fminf(x, 0.f) - log1pf(expf(-fabsf(x))); }
__device__ __forceinline__ int opaque_tid() { int t = threadIdx.x; asm volatile("" : "+v"(t)); return t; }
__device__ __forceinline__ int opq(int t) { asm volatile("" : "+v"(t)); return t; }
__device__ __forceinline__ int opaque_bid() { int b = blockIdx.x; asm volatile("" : "+s"(b)); return b; }
__device__ __forceinline__ int first_item_(int bid, int off) {
  int G = gridDim.x;
  return (int)((bid + G - (off % G)) % G);
}
#define first_item(off) first_item_(bid, off)

#define GEMM_BUF (2 * 128 * LDSS)
#define GEMM_STAGE_DECL uint4 g_xa0, g_xa1, g_xa2, g_xa3, g_xb0, g_xb1, g_xb2, g_xb3, g_ya0, g_ya1, g_ya2, g_ya3, g_yb0, g_yb1, g_yb2, g_yb3;
#define GEMM_STAGE_ARGS g_xa0, g_xa1, g_xa2, g_xa3, g_xb0, g_xb1, g_xb2, g_xb3, g_ya0, g_ya1, g_ya2, g_ya3, g_yb0, g_yb1, g_yb2, g_yb3
__device__ __forceinline__ void gemm_tile(const bf16_t* __restrict__ A, long lda, const bf16_t* __restrict__ B, long ldb,
                                          int K, bf16_t* sbase, f32x16 (&acc)[2][2], const int tid,
                                          uint4& xa0, uint4& xa1, uint4& xa2, uint4& xa3, uint4& xb0, uint4& xb1, uint4& xb2, uint4& xb3, uint4& ya0, uint4& ya1, uint4& ya2, uint4& ya3, uint4& yb0, uint4& yb1, uint4& yb2, uint4& yb3,
                                          const bool preloaded, const bf16_t* An, const bf16_t* Bn) {
  const int lane = tid & 63, wave = tid >> 6;
  const int wm = wave >> 1, wn = wave & 1;
  const int lr = tid >> 3, lc = (tid & 7) * 8;
#pragma unroll
  for (int i = 0; i < 2; ++i)
#pragma unroll
    for (int j = 0; j < 2; ++j)
#pragma unroll
      for (int r = 0; r < 16; ++r) acc[i][j][r] = 0.f;
  const bf16_t* pa = A + (long)lr * lda + lc;
  const bf16_t* pb = B + (long)lr * ldb + lc;
  const bf16_t* pan = An + (long)lr * lda + lc;
  const bf16_t* pbn = Bn + (long)lr * ldb + lc;
#define GEMM_GLOAD_(S, PA, PB, ko)                            \
  S##a0 = *(const uint4*)(PA + (ko));                      \
  S##a1 = *(const uint4*)(PA + 32 * lda + (ko));           \
  S##a2 = *(const uint4*)(PA + 64 * lda + (ko));           \
  S##a3 = *(const uint4*)(PA + 96 * lda + (ko));           \
  S##b0 = *(const uint4*)(PB + (ko));                      \
  S##b1 = *(const uint4*)(PB + 32 * ldb + (ko));           \
  S##b2 = *(const uint4*)(PB + 64 * ldb + (ko));           \
  S##b3 = *(const uint4*)(PB + 96 * ldb + (ko));
#define GEMM_GLOAD(S, ko) GEMM_GLOAD_(S, pa, pb, ko)
#define GEMM_GLOADN(S, ko) GEMM_GLOAD_(S, pan, pbn, ko)
#define GEMM_LSTORE(S, buf)                                                                      \
  { bf16_t* wa = sbase + (buf) * GEMM_BUF + lr * LDSS + lc; bf16_t* wb = wa + 128 * LDSS;         \
    *(uint4*)(wa) = S##a0; *(uint4*)(wa + 32 * LDSS) = S##a1; *(uint4*)(wa + 64 * LDSS) = S##a2; *(uint4*)(wa + 96 * LDSS) = S##a3; \
    *(uint4*)(wb) = S##b0; *(uint4*)(wb + 32 * LDSS) = S##b1; *(uint4*)(wb + 64 * LDSS) = S##b2; *(uint4*)(wb + 96 * LDSS) = S##b3; }
#define GEMM_COMPUTE(buf)                                                                         \
  { __builtin_amdgcn_s_setprio(1); const bf16_t* ra = sbase + (buf) * GEMM_BUF + (wm * 64 + (lane & 31)) * LDSS + (lane >> 5) * 8; \
    const bf16_t* rb = sbase + (buf) * GEMM_BUF + 128 * LDSS + (wn * 64 + (lane & 31)) * LDSS + (lane >> 5) * 8; \
    _Pragma("unroll") for (int kk = 0; kk < 4; ++kk) {                                            \
      const bf16x8 af0 = *(const bf16x8*)(ra + kk * 16), af1 = *(const bf16x8*)(ra + 32 * LDSS + kk * 16); \
      const bf16x8 bf0 = *(const bf16x8*)(rb + kk * 16), bf1 = *(const bf16x8*)(rb + 32 * LDSS + kk * 16); \
      acc[0][0] = __builtin_amdgcn_mfma_f32_32x32x16_bf16(af0, bf0, acc[0][0], 0, 0, 0);         \
      acc[0][1] = __builtin_amdgcn_mfma_f32_32x32x16_bf16(af0, bf1, acc[0][1], 0, 0, 0);         \
      acc[1][0] = __builtin_amdgcn_mfma_f32_32x32x16_bf16(af1, bf0, acc[1][0], 0, 0, 0);         \
      acc[1][1] = __builtin_amdgcn_mfma_f32_32x32x16_bf16(af1, bf1, acc[1][1], 0, 0, 0);         \
    } __builtin_amdgcn_s_setprio(0); }
  const int nk = K >> 6;
  const bool hasn = (An != nullptr);
  if (!preloaded) {
    GEMM_GLOAD(x, 0)
    if (nk > 1) { GEMM_GLOAD(y, 64) }
  }
  __syncthreads();
  GEMM_LSTORE(x, 0)
  if (nk > 2) { GEMM_GLOAD(x, 128) }
  __syncthreads();
  for (int kt = 0; kt < nk; kt += 2) {
    GEMM_COMPUTE(0)
    if (kt + 1 < nk) { GEMM_LSTORE(y, 1) }
    if (kt + 3 < nk) { GEMM_GLOAD(y, (kt + 3) * 64) }
    else if (hasn && kt + 3 == nk + 1) { GEMM_GLOADN(y, 64) }
    __syncthreads();
    if (kt + 1 < nk) {
      GEMM_COMPUTE(1)
      if (kt + 2 < nk) { GEMM_LSTORE(x, 0) }
      if (kt + 4 < nk) { GEMM_GLOAD(x, (kt + 4) * 64) }
      else if (hasn && kt + 4 == nk) { GEMM_GLOADN(x, 0) }
      __syncthreads();
    }
  }
}

__device__ __forceinline__ void gemm_tile_h(const bf16_t* __restrict__ A, long lda, const bf16_t* __restrict__ B, long ldb,
                                            int K, bf16_t* sbase, f32x16 (&acc)[2], const int tid) {
  const int lane = tid & 63, wave = tid >> 6;
  const int wm = wave >> 1, wn = wave & 1;
  const int lr = tid >> 3, lc = (tid & 7) * 8;
#pragma unroll
  for (int i = 0; i < 2; ++i)
#pragma unroll
    for (int r = 0; r < 16; ++r) acc[i][r] = 0.f;
  const bf16_t* pa = A + (long)lr * lda + lc;
  const bf16_t* pb = B + (long)lr * ldb + lc;
  uint4 xa0, xa1, xa2, xa3, xb0, xb1;
  uint4 ya0, ya1, ya2, ya3, yb0, yb1;
#define GEMMH_GLOAD(S, ko)                                 \
  S##a0 = *(const uint4*)(pa + (ko));                      \
  S##a1 = *(const uint4*)(pa + 32 * lda + (ko));           \
  S##a2 = *(const uint4*)(pa + 64 * lda + (ko));           \
  S##a3 = *(const uint4*)(pa + 96 * lda + (ko));           \
  S##b0 = *(const uint4*)(pb + (ko));                      \
  S##b1 = *(const uint4*)(pb + 32 * ldb + (ko));
#define GEMMH_LSTORE(S, buf)                                                                     \
  { bf16_t* wa = sbase + (buf) * GEMM_BUF + lr * LDSS + lc; bf16_t* wb = wa + 128 * LDSS;         \
    *(uint4*)(wa) = S##a0; *(uint4*)(wa + 32 * LDSS) = S##a1; *(uint4*)(wa + 64 * LDSS) = S##a2; *(uint4*)(wa + 96 * LDSS) = S##a3; \
    *(uint4*)(wb) = S##b0; *(uint4*)(wb + 32 * LDSS) = S##b1; }
#define GEMMH_COMPUTE(buf)                                                                        \
  { const bf16_t* ra = sbase + (buf) * GEMM_BUF + (wm * 64 + (lane & 31)) * LDSS + (lane >> 5) * 8; \
    const bf16_t* rb = sbase + (buf) * GEMM_BUF + 128 * LDSS + (wn * 32 + (lane & 31)) * LDSS + (lane >> 5) * 8; \
    _Pragma("unroll") for (int kk = 0; kk < 4; ++kk) {                                            \
      const bf16x8 af0 = *(const bf16x8*)(ra + kk * 16), af1 = *(const bf16x8*)(ra + 32 * LDSS + kk * 16); \
      const bf16x8 bf0 = *(const bf16x8*)(rb + kk * 16);                                          \
      acc[0] = __builtin_amdgcn_mfma_f32_32x32x16_bf16(af0, bf0, acc[0], 0, 0, 0);               \
      acc[1] = __builtin_amdgcn_mfma_f32_32x32x16_bf16(af1, bf0, acc[1], 0, 0, 0);               \
    } }
  const int nk = K >> 6;
  GEMMH_GLOAD(x, 0)
  if (nk > 1) { GEMMH_GLOAD(y, 64) }
  __syncthreads();
  GEMMH_LSTORE(x, 0)
  if (nk > 2) { GEMMH_GLOAD(x, 128) }
  __syncthreads();
  for (int kt = 0; kt < nk; kt += 2) {
    if (kt + 1 < nk) { GEMMH_LSTORE(y, 1) }
    if (kt + 3 < nk) { GEMMH_GLOAD(y, (kt + 3) * 64) }
    GEMMH_COMPUTE(0)
    __syncthreads();
    if (kt + 1 < nk) {
      if (kt + 2 < nk) { GEMMH_LSTORE(x, 0) }
      if (kt + 4 < nk) { GEMMH_GLOAD(x, (kt + 4) * 64) }
      GEMMH_COMPUTE(1)
      __syncthreads();
    }
  }
}

#define EPI_BEGIN_(ROWEXPR)                                                        \
  {                                                                                \
    const int e_lane = tid & 63, e_wave = tid >> 6;                                \
    const int e_wm = e_wave >> 1, e_wn = e_wave & 1;                               \
    _Pragma("unroll") for (int e_i = 0; e_i < 2; ++e_i)                            \
    _Pragma("unroll") for (int e_j = 0; e_j < 2; ++e_j)                            \
    _Pragma("unroll") for (int e_r = 0; e_r < 16; ++e_r) {                         \
      const int row = ROWEXPR;                                                     \
      const int col = e_wn * 64 + e_j * 32 + (e_lane & 31);                        \
      const float val = acc[e_i][e_j][e_r];
#define EPI_BEGIN EPI_BEGIN_(e_wm * 64 + e_i * 32 + 8 * (e_r >> 2) + 4 * (e_lane >> 5) + (e_r & 3))
#define EPI_BEGIN_OPQ EPI_BEGIN_(opq(e_wm * 64 + e_i * 32 + 8 * (e_r >> 2) + 4 * (e_lane >> 5)) + (e_r & 3))
#define EPI_END }}
#define EPIS_BEGIN                                                                 \
  {                                                                                \
    const int e_lane = tid & 63, e_wave = tid >> 6;                                \
    const int e_rowl = (e_wave >> 1) * 64 + 4 * (e_lane >> 5);                     \
    const int e_coll = (e_wave & 1) * 64 + (e_lane & 31);                          \
    _Pragma("unroll") for (int e_i = 0; e_i < 2; ++e_i)                            \
    _Pragma("unroll") for (int e_j = 0; e_j < 2; ++e_j)                            \
    _Pragma("unroll") for (int e_r = 0; e_r < 16; ++e_r) {                         \
      const int e_rowu = e_i * 32 + 8 * (e_r >> 2) + (e_r & 3);                    \
      const int e_colu = e_j * 32;                                                 \
      const float val = acc[e_i][e_j][e_r];

__device__ __forceinline__ int tok_which(int t) { return t < NCTX ? 0 : 1 + ((t - NCTX) >> 11); }

static __device__ __forceinline__ void p0_mod(const Params& p, char* smem) {
  const int tid = opaque_tid(); const int bid = opaque_bid(); (void)tid; (void)bid;
  float* sc = (float*)smem;
  float* red = sc + 3 * 1024;
  for (int it = first_item(0); it < 192; it += gridDim.x) {
    __syncthreads();
    for (int i = tid; i < 3 * 1024; i += NTHR) {
      const int w = i >> 10, d = i & 1023;
      sc[i] = siluf((w == 0) ? p.c_ctx[d] : p.c[(w - 1) * 1024 + d]);
    }
    __syncthreads();
    const int l = it / 48, e0 = (it % 48) * 64;
    const int col = tid & 63, dq = tid >> 6;
    float a0 = 0.f, a1 = 0.f, a2 = 0.f;
    const float* wp = p.mod_w + ((long)l * 1024 + dq * 256) * 3072 + e0 + col;
    for (int db = 0; db < 256; db += 16) {
      float wv[16];
#pragma unroll
      for (int d = 0; d < 16; ++d) wv[d] = __builtin_nontemporal_load(&wp[(long)(db + d) * 3072]);
#pragma unroll
      for (int d = 0; d < 16; ++d) {
        a0 += sc[dq * 256 + db + d] * wv[d];
        a1 += sc[1024 + dq * 256 + db + d] * wv[d];
        a2 += sc[2048 + dq * 256 + db + d] * wv[d];
      }
    }
    red[(dq * 3 + 0) * 64 + col] = a0;
    red[(dq * 3 + 1) * 64 + col] = a1;
    red[(dq * 3 + 2) * 64 + col] = a2;
    __syncthreads();
    if (tid < 192) {
      const int w = tid >> 6, cc = tid & 63;
      const float sum = red[(0 * 3 + w) * 64 + cc] + red[(1 * 3 + w) * 64 + cc] + red[(2 * 3 + w) * 64 + cc] + red[(3 * 3 + w) * 64 + cc];
      p.modv[(l * 3 + w) * 3072 + e0 + cc] = sum + p.mod_b[l * 3072 + e0 + cc];
    }
  }
}

static __device__ __forceinline__ void p0_filt_mlp(const Params& p, char* smem) {
  const int tid = opaque_tid(); const int bid = opaque_bid(); (void)tid; (void)bid;
  float* z = (float*)smem;
  float* a = z + 16 * 33;
  float* b = a + 1024;
  float* wS = b + 1024;
  for (int it = first_item(192); it < 144; it += gridDim.x) {
    const int lt = (it < 128) ? 1 : 0;
    const int L = lt ? LLAT : LCTX;
    const int p0 = (lt ? it : (it - 128)) * 16;
    float* a3 = p.filt_a3 + (long)(lt ? 256 : 0) * 64;
    __syncthreads();
    for (int i = tid; i < 16 * 33; i += NTHR) {
      const int pp = i / 33, j = i % 33;
      const int l = p0 + pp;
      const float t = (float)l / (float)(L - 1);
      const float w = TWO_PI * (float)l / (float)L;
      float v;
      if (j == 0) v = t;
      else {
        const int bi = (j - 1) & 15;
        const float f = 1e-4f + (float)bi * ((15.0f - 1e-4f) / 15.0f);
        v = (j <= 16) ? cosf(f * w) : -sinf(f * w);
      }
      z[i] = v;
    }
    const int n = opq(tid & 63), pg = opq(tid >> 6);
    const float fr = p.hy_freq[n];
    for (int i = tid; i < 2112; i += NTHR) wS[i] = p.hy_w1[i];
    __syncthreads();
    {
      float acc[4];
#pragma unroll
      for (int q = 0; q < 4; ++q) acc[q] = p.hy_b1[n];
#pragma unroll 3
      for (int jn = 0; jn < 33; ++jn) {
        const float w = wS[jn * 64 + n];
#pragma unroll
        for (int q = 0; q < 4; ++q) acc[q] += z[(pg * 4 + q) * 33 + jn] * w;
      }
#pragma unroll
      for (int q = 0; q < 4; ++q) a[(pg * 4 + q) * 64 + n] = sinf(fr * acc[q]);
    }
    __syncthreads();
    for (int i = tid; i < 4096; i += NTHR) wS[i] = p.hy_w2[i];
    __syncthreads();
    {
      float acc[4];
#pragma unroll
      for (int q = 0; q < 4; ++q) acc[q] = p.hy_b2[n];
#pragma unroll 4
      for (int jn = 0; jn < 64; ++jn) {
        const float w = wS[jn * 64 + n];
#pragma unroll
        for (int q = 0; q < 4; ++q) acc[q] += a[(pg * 4 + q) * 64 + jn] * w;
      }
#pragma unroll
      for (int q = 0; q < 4; ++q) b[(pg * 4 + q) * 64 + n] = sinf(fr * acc[q]);
    }
    __syncthreads();
    for (int i = tid; i < 4096; i += NTHR) wS[i] = p.hy_w3[i];
    __syncthreads();
    {
      float acc[4];
#pragma unroll
      for (int q = 0; q < 4; ++q) acc[q] = p.hy_b3[n];
#pragma unroll 4
      for (int jn = 0; jn < 64; ++jn) {
        const float w = wS[jn * 64 + n];
#pragma unroll
        for (int q = 0; q < 4; ++q) acc[q] += b[(pg * 4 + q) * 64 + jn] * w;
      }
#pragma unroll
      for (int q = 0; q < 4; ++q) a3[(long)(p0 + pg * 4 + q) * 64 + n] = sinf(fr * acc[q]);
    }
  }
}

static __device__ __forceinline__ void phase_filt_main(const Params& p, char* smem) {
  const int tid = opaque_tid(); const int bid = opaque_bid(); (void)tid; (void)bid;
  float* a = (float*)smem;
  const float dmin = -3.0701134573253945f;
  const float dmax = -15.350567286626973f;
  for (int it = bid; it < 36 * 16; it += gridDim.x) {
    const int pc = it >> 4, cb = it & 15;
    const int lt = (pc < 32) ? 1 : 0;
    const int L = lt ? LLAT : LCTX;
    const int p0 = (lt ? pc : (pc - 32)) * 64;
    bf16_t* filt = lt ? p.filt_lat : p.filt_ctx;
    const float* a3 = p.filt_a3 + ((long)(lt ? 256 : 0) + p0) * 64;
    __syncthreads();
    for (int i = tid; i < 1024; i += NTHR) ((float4*)a)[i] = ((const float4*)a3)[i];
    const int cidx = cb * 256 + opq(tid);
    float w4[64];
#pragma unroll
    for (int k = 0; k < 64; ++k) w4[k] = p.hy_w4[k * 4096 + cidx];
    __syncthreads();
    const int ch = cidx & 1023, od = cidx >> 10, order = od >> 1, dir = od & 1;
    const float delta = fabsf(dmin + (float)ch * ((dmax - dmin) / 1023.0f));
    bf16_t* dst = filt + ((long)(order * 1024 + ch)) * (2 * L);
#pragma unroll 1
    for (int pp = 0; pp < 64; ++pp) {
      const float4* ap = (const float4*)(a + pp * 64);
      float acc = 0.f;
#pragma unroll
      for (int k4 = 0; k4 < 16; ++k4) {
        const float4 av = ap[k4];
        acc += av.x * w4[4 * k4 + 0] + av.y * w4[4 * k4 + 1] + av.z * w4[4 * k4 + 2] + av.w * w4[4 * k4 + 3];
      }
      const int l = p0 + pp;
      const float t = (float)l / (float)(L - 1);
      const float v = acc * expf(-t * delta);
      if (dir == 0) dst[L - 1 - l] = f2bf(v);
      else { if (l == 0) dst[2 * L - 1] = 0; else dst[L - 1 + l] = f2bf(v); }
    }
  }
}

static __device__ __forceinline__ void p0_tables(const Params& p, char* smem) {
  const int tid = opaque_tid(); const int bid = opaque_bid(); (void)tid; (void)bid;
  float2* T = (float2*)smem;
  __syncthreads();
  for (int m = tid; m < 2048; m += NTHR) {
    float sv, cv;
    sincosf(TWO_PI * (float)m / 2048.0f, &sv, &cv);
    T[m] = make_float2(cv, sv);
  }
  __syncthreads();
  const int n_items = 64 + 64 + 4096;
  for (int it = first_item(320); it < n_items; it += gridDim.x) {
    unsigned short vals[8];
    if (it < 64) {
#pragma unroll
      for (int q = 0; q < 8; ++q) {
        const int e = it * 2048 + tid * 8 + q;
        const int m = e >> 8, k = e & 255;
        const int cs = m >> 8, co = m & 255;
        const float2 tv = T[((co * k) & 255) * 8];
        vals[q] = f2bf(cs ? tv.y : tv.x);
      }
      *(uint4*)(p.tabA + (long)it * 2048 + tid * 8) = make_uint4(vals[0] | (vals[1] << 16), vals[2] | (vals[3] << 16), vals[4] | (vals[5] << 16), vals[6] | (vals[7] << 16));
    } else if (it < 128) {
#pragma unroll
      for (int q = 0; q < 8; ++q) {
        const int e = (it - 64) * 2048 + tid * 8 + q;
        const int pp = e >> 9, k = e & 511;
        const int cs = k >> 8, pi = k & 255;
        const float2 tv = T[((pp * pi) & 255) * 8];
        vals[q] = f2bf(cs ? -tv.y : tv.x);
      }
      *(uint4*)(p.tabB_ctx + (long)(it - 64) * 2048 + tid * 8) = make_uint4(vals[0] | (vals[1] << 16), vals[2] | (vals[3] << 16), vals[4] | (vals[5] << 16), vals[6] | (vals[7] << 16));
    } else {
#pragma unroll
      for (int q = 0; q < 8; ++q) {
        const int e = (it - 128) * 2048 + tid * 8 + q;
        const int pp = e >> 12, k = e & 4095;
        const int cs = k >> 11, pi = k & 2047;
        const float2 tv = T[(pp * pi) & 2047];
        vals[q] = f2bf(cs ? -tv.y : tv.x);
      }
      *(uint4*)(p.tabB_lat + (long)(it - 128) * 2048 + tid * 8) = make_uint4(vals[0] | (vals[1] << 16), vals[2] | (vals[3] << 16), vals[4] | (vals[5] << 16), vals[6] | (vals[7] << 16));
    }
  }
}

static __device__ __forceinline__ void wt_transpose_items(const float* __restrict__ W, bf16_t* __restrict__ Wt, int N, int Npad, int off, char* smem) {
  const int tid = opaque_tid(); const int bid = opaque_bid(); (void)tid; (void)bid;
  float* t = (float*)smem;
  const int ntn = Npad / 64;
  const int n_items = ntn * 16;
  for (int it = first_item(off); it < n_items; it += gridDim.x) {
    const int nt = it % ntn, kt = it / ntn;
    const int n0 = nt * 64, k0 = kt * 64;
    __syncthreads();
    const int tx = tid & 63, ty = tid >> 6;
    float v[16];
#pragma unroll
    for (int i = 0; i < 16; ++i) v[i] = (n0 + tx < N) ? __builtin_nontemporal_load(&W[(long)(k0 + ty + 4 * i) * N + n0 + tx]) : 0.f;
#pragma unroll
    for (int i = 0; i < 16; ++i) t[tx * 65 + ty + 4 * i] = v[i];
    __syncthreads();
    const int r = tid >> 2, cch = (tid & 3) * 16;
    unsigned w[8];
#pragma unroll
    for (int q = 0; q < 8; ++q) w[q] = pk2(t[r * 65 + cch + 2 * q], t[r * 65 + cch + 2 * q + 1]);
    uint4* dp = (uint4*)(Wt + (long)(n0 + r) * 1024 + k0 + cch);
    dp[0] = make_uint4(w[0], w[1], w[2], w[3]);
    dp[1] = make_uint4(w[4], w[5], w[6], w[7]);
  }
}

static __device__ __forceinline__ void p0_weights(const Params& p, char* smem) {
  wt_transpose_items(p.gla_w_in, p.wt_gla_in0, 3104, 3200, 0, smem);
  wt_transpose_items(p.gla_w_out, p.wt_gla_out0, 1024, 1024, 288, smem);
  wt_transpose_items(p.fn_w_in, p.wt_fn_in, 2048, 2048, 32, smem);
  wt_transpose_items(p.fn_w_out, p.wt_fn_out, 1024, 1024, 32, smem);
  wt_transpose_items(p.hy_w_in, p.wt_hy_in, 4096, 4096, 288, smem);
  wt_transpose_items(p.hy_w_out, p.wt_hy_out, 1024, 1024, 288, smem);
  wt_transpose_items(p.gla_w_in + (long)1024 * 3104, p.wt_gla_in1, 3104, 3200, 32, smem);
  wt_transpose_items(p.gla_w_out + (long)1024 * 1024, p.wt_gla_out1, 1024, 1024, 288, smem);
}

static __device__ __forceinline__ void phase_norm(const Params& p, int layer) {
  const int tid = opaque_tid(); const int bid = opaque_bid(); (void)tid; (void)bid;
  const int lane = tid & 63, wave = tid >> 6;
  const float* g = p.norm_g + layer * 1024;
  const int stride = gridDim.x * 4;
  for (int t0 = bid * 4 + wave; t0 < NTOK; t0 += 2 * stride) {
    float4 v[2][4];
#pragma unroll
    for (int u = 0; u < 2; ++u) {
      const int t = t0 + u * stride;
      if (t < NTOK) {
        const float* xr;
        if (layer == 0) xr = (t < NCTX) ? (p.x_prompt + (long)t * 1024) : (p.x_sample + (long)(t - NCTX) * 1024);
        else xr = p.out + (long)t * 1024;
#pragma unroll
        for (int i = 0; i < 4; ++i) v[u][i] = *(const float4*)(xr + lane * 4 + 256 * i);
      }
    }
#pragma unroll
    for (int u = 0; u < 2; ++u) {
      const int t = t0 + u * stride;
      if (t < NTOK) {
        const float* mv = p.modv + (layer * 3 + tok_which(t)) * 3072;
        float ss = 0.f;
#pragma unroll
        for (int i = 0; i < 4; ++i) ss += v[u][i].x * v[u][i].x + v[u][i].y * v[u][i].y + v[u][i].z * v[u][i].z + v[u][i].w * v[u][i].w;
#pragma unroll
        for (int o = 32; o > 0; o >>= 1) ss += __shfl_xor(ss, o);
        const float rstd = rsqrtf(ss * (1.0f / 1024.0f) + 1e-6f);
#pragma unroll
        for (int i = 0; i < 4; ++i) {
          const int c0 = lane * 4 + 256 * i;
          const float4 gg = *(const float4*)(g + c0);
          const float4 sh = *(const float4*)(mv + c0);
          const float4 sc = *(const float4*)(mv + 1024 + c0);
          uint2 w;
          w.x = pk2((v[u][i].x * rstd * gg.x) * (1.f + sc.x) + sh.x, (v[u][i].y * rstd * gg.y) * (1.f + sc.y) + sh.y);
          w.y = pk2((v[u][i].z * rstd * gg.z) * (1.f + sc.z) + sh.z, (v[u][i].w * rstd * gg.w) * (1.f + sc.w) + sh.w);
          *(uint2*)(p.h + (long)t * 1024 + c0) = w;
        }
      }
    }
  }
}

static __device__ __forceinline__ void phase_final_norm(const Params& p) {
  const int tid = opaque_tid(); const int bid = opaque_bid(); (void)tid; (void)bid;
  const int lane = tid & 63, wave = tid >> 6;
  for (int t = bid * 4 + wave; t < NTOK; t += gridDim.x * 4) {
    float* xr = p.out + (long)t * 1024;
    float4 v[4];
    float ss = 0.f;
#pragma unroll
    for (int i = 0; i < 4; ++i) {
      v[i] = *(const float4*)(xr + lane * 4 + 256 * i);
      ss += v[i].x * v[i].x + v[i].y * v[i].y + v[i].z * v[i].z + v[i].w * v[i].w;
    }
#pragma unroll
    for (int o = 32; o > 0; o >>= 1) ss += __shfl_xor(ss, o);
    const float rstd = rsqrtf(ss * (1.0f / 1024.0f) + 1e-6f);
#pragma unroll
    for (int i = 0; i < 4; ++i) {
      const int c0 = lane * 4 + 256 * i;
      float4 gg = *(const float4*)(p.final_norm_g + c0);
      float4 o;
      o.x = v[i].x * rstd * gg.x; o.y = v[i].y * rstd * gg.y; o.z = v[i].z * rstd * gg.z; o.w = v[i].w * rstd * gg.w;
      __builtin_nontemporal_store(o.x, xr + c0); __builtin_nontemporal_store(o.y, xr + c0 + 1);
      __builtin_nontemporal_store(o.z, xr + c0 + 2); __builtin_nontemporal_store(o.w, xr + c0 + 3);
    }
  }
}

static __device__ __forceinline__ void phase_gemm_out(const Params& p, int layer, const bf16_t* Wt, char* smem, const int dummy) {
  const int tid = opaque_tid(); const int bid = opaque_bid(); (void)tid; (void)bid;
  bf16_t* sA = (bf16_t*)smem;
  GEMM_STAGE_DECL
  float* outp = dummy ? (float*)p.big : p.out;
  const int n_tiles = 96 * 8;
  const int nfull = (gridDim.x == 512) ? 512 : n_tiles;
  const int n_items = nfull + 2 * (n_tiles - nfull);
  for (int item = bid; item < n_items; item += gridDim.x) {
    const bool is_half = item >= nfull;
    const int tile = is_half ? nfull + ((item - nfull) >> 1) : item;
    const int hsel = is_half ? ((item - nfull) & 1) : 0;
    const int mt = tile % 96, nt = tile / 96;
    const int m0 = mt * 128, n0 = nt * 128 + hsel * 64;
    const float* gate = p.modv + (layer * 3 + tok_which(m0)) * 3072 + 2048;
    const float* xsrc = (layer == 0) ? ((m0 < NCTX) ? p.x_prompt : (p.x_sample - (long)NCTX * 1024)) : p.out;
    const int e_lane = tid & 63, e_wave = tid >> 6;
    const int e_wm = e_wave >> 1, e_wn = e_wave & 1;
    if (!is_half) {
      f32x16 acc[2][2];
      gemm_tile(p.h + (long)m0 * 1024, 1024, Wt + (long)n0 * 1024, 1024, 1024, sA, acc, tid, GEMM_STAGE_ARGS, false, nullptr, nullptr);
      float xo[2][2][16];
      const float* xb = xsrc + (long)m0 * 1024 + n0;
      float* ob = outp + (long)m0 * 1024 + n0;
      EPIS_BEGIN
        (void)val;
        const unsigned lo = 4u * (unsigned)(e_rowl * 1024 + e_coll);
        xo[e_i][e_j][e_r] = *(const float*)((const char*)(xb + e_rowu * 1024 + e_colu) + lo);
      EPI_END
      EPIS_BEGIN
        const unsigned lo = 4u * (unsigned)(e_rowl * 1024 + e_coll);
        *(float*)((char*)(ob + e_rowu * 1024 + e_colu) + lo) = xo[e_i][e_j][e_r] + gate[n0 + e_coll + e_colu] * val;
      EPI_END
    } else {
      f32x16 acc[2];
      gemm_tile_h(p.h + (long)m0 * 1024, 1024, Wt + (long)n0 * 1024, 1024, 1024, sA, acc, tid);
      const int n = n0 + e_wn * 32 + (e_lane & 31);
      const float gn = gate[n];
      float xo[2][16];
#pragma unroll
      for (int e_i = 0; e_i < 2; ++e_i)
#pragma unroll
        for (int e_r = 0; e_r < 16; ++e_r) {
          const int row = e_wm * 64 + e_i * 32 + 8 * (e_r >> 2) + 4 * (e_lane >> 5) + (e_r & 3);
          xo[e_i][e_r] = xsrc[(long)(m0 + row) * 1024 + n];
        }
#pragma unroll
      for (int e_i = 0; e_i < 2; ++e_i)
#pragma unroll
        for (int e_r = 0; e_r < 16; ++e_r) {
          const int row = e_wm * 64 + e_i * 32 + 8 * (e_r >> 2) + 4 * (e_lane >> 5) + (e_r & 3);
          outp[(long)(m0 + row) * 1024 + n] = xo[e_i][e_r] + gn * acc[e_i][e_r];
        }
    }
  }
}

#define GLA_PROJ(p) ((p).big)
#define GLA_LR(p) ((float*)((p).big + (long)NTOK * 3072))
#define GLA_OF(p) ((p).big + (long)NTOK * 3072 + (long)NTOK * 64)
#define GLA_OB(p) (GLA_OF(p) + (long)NTOK * 1024)

static __device__ __forceinline__ void phase_gla_in(const Params& p, const bf16_t* Wt, char* smem) {
  const int tid = opaque_tid(); const int bid = opaque_bid(); (void)tid; (void)bid;
  bf16_t* sA = (bf16_t*)smem;
  GEMM_STAGE_DECL
  bool pre = false;
  bf16_t* proj = GLA_PROJ(p);
  float* lrb = GLA_LR(p);
  const int n_tiles = 96 * 25;
  for (int tile = bid; tile < n_tiles; tile += gridDim.x) {
    const int mt = tile % 96, nt = tile / 96;
    const int m0 = mt * 128, n0 = nt * 128;
    f32x16 acc[2][2];
    {
      const int tn = tile + gridDim.x;
      const bool hn = tn < n_tiles;
      gemm_tile(p.h + (long)m0 * 1024, 1024, Wt + (long)n0 * 1024, 1024, 1024, sA, acc, tid, GEMM_STAGE_ARGS, pre,
                hn ? p.h + (long)((tn % 96) * 128) * 1024 : nullptr, hn ? Wt + (long)((tn / 96) * 128) * 1024 : nullptr);
      pre = hn;
    }
    if (n0 < 3072) {
      bf16_t* tb = proj + (long)m0 * 3072 + n0;
      EPIS_BEGIN
        const unsigned lo = 2u * (unsigned)(e_rowl * 3072 + e_coll);
        *(bf16_t*)((char*)(tb + e_rowu * 3072 + e_colu) + lo) = f2bf(val);
      EPI_END
    } else {
      EPI_BEGIN
        const int t = m0 + row, n = n0 + col;
        if (n < 3104) lrb[(long)t * 32 + (n - 3072)] = val;
      EPI_END
    }
  }
}

#define GLA_IMG1(p) (GLA_OB(p) + (long)NTOK * 1024)
#define GLA_BLAST(p) ((float*)(GLA_IMG1(p) + (long)NTOK * 1024))
static __device__ __forceinline__ void phase_gla_prep(const Params& p, int j, char* smem, const int dummy) {
  const int tid = opaque_tid(); const int bid = opaque_bid();
  float* sLR = (float*)smem;
  bf16_t* proj = GLA_PROJ(p);
  bf16_t* img1 = GLA_IMG1(p);
  const float* lrb = GLA_LR(p);
  float* blast = GLA_BLAST(p);
  const int dkp = tid & 127, dir = tid >> 7;
  for (int it = bid; it < (NTOK / 32) * 2; it += gridDim.x) {
    const int tb = it >> 1, hp = it & 1;
    const int dk = hp * 256 + 2 * dkp;
    __syncthreads();
    ((float4*)sLR)[tid] = *(const float4*)(lrb + ((long)tb * 32 + (tid >> 3)) * 32 + (tid & 7) * 4);
    unsigned rq[32], rk[32];
    {
      const bf16_t* rp = proj + ((long)tb * 32 + (dir ? 31 : 0)) * 3072 + dk;
      const long rstep = dir ? -3072 : 3072;
#pragma unroll
      for (int s_ = 0; s_ < 32; ++s_) {
        rq[s_] = *(const unsigned*)rp;
        rk[s_] = *(const unsigned*)(rp + 512);
        rp += rstep;
      }
    }
    float wd0[16], wd1[16];
    const float* wdp = p.gla_w_dec + ((long)(j * 2 + dir) * 16) * 512 + dk;
#pragma unroll
    for (int r = 0; r < 16; ++r) { const float2 w2 = *(const float2*)(wdp + r * 512); wd0[r] = w2.x; wd1[r] = w2.y; }
    const float2 bd = *(const float2*)(p.gla_b_dec + (j * 2 + dir) * 512 + dk);
    __syncthreads();
    float2* sC = (float2*)(sLR + 1024) + tid;
    float run0 = 0.f, run1 = 0.f;
#pragma unroll
    for (int s_ = 0; s_ < 32; ++s_) {
      const int pos = dir ? 31 - s_ : s_;
      const float4* lp = (const float4*)(sLR + pos * 32 + dir * 16);
      float lg0 = bd.x, lg1 = bd.y;
#pragma unroll
      for (int r4 = 0; r4 < 4; ++r4) {
        const float4 l4 = lp[r4];
        lg0 += l4.x * wd0[r4 * 4 + 0] + l4.y * wd0[r4 * 4 + 1] + l4.z * wd0[r4 * 4 + 2] + l4.w * wd0[r4 * 4 + 3];
        lg1 += l4.x * wd1[r4 * 4 + 0] + l4.y * wd1[r4 * 4 + 1] + l4.z * wd1[r4 * 4 + 2] + l4.w * wd1[r4 * 4 + 3];
      }
      run0 += (fminf(lg0, 0.f) - __logf(1.f + __expf(-fabsf(lg0)))) * (1.0f / 16.0f);
      run1 += (fminf(lg1, 0.f) - __logf(1.f + __expf(-fabsf(lg1)))) * (1.0f / 16.0f);
      sC[s_ * 256] = make_float2(run0, run1);
    }
    *(float2*)(blast + ((long)dir * (NTOK / 32) + tb) * 512 + dk) = make_float2(run0, run1);
    bf16_t* dst = dir ? img1 : (dummy ? GLA_OF(p) : proj);
    const long dstr = (dir || dummy) ? 1024 : 3072;
    {
      bf16_t* wp = dst + ((long)tb * 32 + (dir ? 31 : 0)) * dstr + dk;
      const long wstep = dir ? -dstr : dstr;
#pragma unroll
      for (int s_ = 0; s_ < 32; ++s_) {
        const float2 cc = sC[s_ * 256];
        const float e0 = cc.x - run0, e1 = cc.y - run1;
        const float qs0 = 0.08838834764831845f * __expf(fminf(e0, 80.f)), qs1 = 0.08838834764831845f * __expf(fminf(e1, 80.f));
        const float ks0 = __expf(-e0), ks1 = __expf(-e1);
        *(unsigned*)wp = pk2(bf2f((bf16_t)(rq[s_] & 0xffffu)) * qs0, bf2f((bf16_t)(rq[s_] >> 16)) * qs1);
        *(unsigned*)(wp + 512) = pk2(bf2f((bf16_t)(rk[s_] & 0xffffu)) * ks0, bf2f((bf16_t)(rk[s_] >> 16)) * ks1);
        wp += wstep;
      }
    }
  }
}

#define QS 136
#define TS 40
#define GLA_SLOC(p) ((float*)((p).h))
#define GLA_GSEG(p) (((float*)((p).h)) + (long)128 * 128 * 256)
__device__ __forceinline__ int crow_(int r, int hf) { return (r & 3) + 8 * (r >> 2) + 4 * hf; }
__device__ __forceinline__ bf16x8 pack8(const f32x16& x, const int st) {
  union { unsigned u[4]; bf16x8 v; } c;
  c.u[0] = pk2(x[8 * st + 0], x[8 * st + 1]);
  c.u[1] = pk2(x[8 * st + 2], x[8 * st + 3]);
  c.u[2] = pk2(x[8 * st + 4], x[8 * st + 5]);
  c.u[3] = pk2(x[8 * st + 6], x[8 * st + 7]);
  return c.v;
}
__device__ __forceinline__ bf16x8 ld2x8(const bf16_t* a, const bf16_t* b) {
  union { uint2 d[2]; bf16x8 v; } c;
  c.d[0] = *(const uint2*)a;
  c.d[1] = *(const uint2*)b;
  return c.v;
}

__device__ __forceinline__ unsigned kimg_off(unsigned row, unsigned ch) { return 256u * row + 16u * (ch ^ (((row & 3u) << 2) | ((row >> 2) & 3u))); }
__device__ __forceinline__ unsigned kimg_tr(unsigned lane, unsigned c, unsigned ks, unsigned t) {
  const unsigned h = lane >> 5, blk = (lane >> 4) & 1u, q = (lane & 15u) >> 2, pp = lane & 3u;
  return kimg_off(16u * ks + 8u * h + 4u * t + q, 4u * c + 2u * blk + (pp >> 1)) + 8u * (pp & 1u);
}
typedef short s16x4 __attribute__((ext_vector_type(4)));

static __device__ __forceinline__ void phase_gla_scan(const Params& p, int j, int pass, char* smem) {
  const int tid = opaque_tid(); const int bid = opaque_bid();
  bf16_t* sQ = (bf16_t*)smem;
  bf16_t* sK = sQ + 32 * QS;
  bf16_t* sKT = sK + 32 * QS;
  bf16_t* sVT = sKT + 128 * TS;
  float* sDec = (float*)(sVT + 64 * TS);
  float* sOp = sDec + 128;
  const bf16_t* proj = GLA_PROJ(p);
  const bf16_t* img1 = GLA_IMG1(p);
  const float* blast = GLA_BLAST(p);
  float* sloc = GLA_SLOC(p);
  float* gseg = GLA_GSEG(p);
  const int lane = tid & 63, wave = tid >> 6, l31 = lane & 31, hf = lane >> 5;
  const int kh = wave >> 1, nt = wave & 1;
  const int dk0 = (tid & 63) * 2, sg = tid >> 6;
  const int vp = tid & 31, sg8 = tid >> 5;
  const int irow = tid >> 3, icol = (tid & 7) * 16;
  char* sKb = (char*)sK;
  char* sVb = (char*)sKT;
  const unsigned vbase = (unsigned)(size_t)sVb;
  const unsigned vtr0 = vbase + kimg_tr(lane, nt, 0, 0), vtr1 = vbase + kimg_tr(lane, nt, 0, 1);
  const unsigned vtr2 = vbase + kimg_tr(lane, nt, 1, 0), vtr3 = vbase + kimg_tr(lane, nt, 1, 1);
  const unsigned vq_ = (lane & 15) >> 2, vch_ = 4 * nt + 2 * ((lane >> 4) & 1) + ((lane & 3) >> 1), vb8_ = 8 * (lane & 1);
  const unsigned vtrp0 = vbase + kimg_off(16 * kh + 4 * hf + vq_, vch_) + vb8_;
  const unsigned vtrp1 = vbase + kimg_off(16 * kh + 8 + 4 * hf + vq_, vch_) + vb8_;
  const unsigned kbase = (unsigned)(size_t)sKb;
  const unsigned ktr0 = kbase + kimg_tr(lane, 2 * kh + 0, 0, 0), ktr1 = kbase + kimg_tr(lane, 2 * kh + 0, 0, 1);
  const unsigned ktr2 = kbase + kimg_tr(lane, 2 * kh + 0, 1, 0), ktr3 = kbase + kimg_tr(lane, 2 * kh + 0, 1, 1);
  const unsigned ktr4 = kbase + kimg_tr(lane, 2 * kh + 1, 0, 0), ktr5 = kbase + kimg_tr(lane, 2 * kh + 1, 0, 1);
  const unsigned ktr6 = kbase + kimg_tr(lane, 2 * kh + 1, 1, 0), ktr7 = kbase + kimg_tr(lane, 2 * kh + 1, 1, 1);
  const int n_items = pass == 0 ? (1024 + 512) : 512;
  for (int it = bid; it < n_items; it += gridDim.x) {
    int b, hh, dir, vt, sidx, L, tbase;
    bool full, lat;
    if (pass == 0 && it < 1024) {
      vt = it & 3; const int combo = it >> 2;
      dir = combo & 1; hh = (combo >> 1) & 3; b = combo >> 3; sidx = 0;
      L = LCTX; tbase = b * LCTX; full = true; lat = false;
    } else {
      const int i2 = pass == 0 ? it - 1024 : it;
      vt = i2 & 3; const int combo = i2 >> 2;
      dir = combo & 1; hh = (combo >> 1) & 3; sidx = (combo >> 3) & 7; b = combo >> 6;
      L = LLAT; tbase = NCTX + b * LLAT; full = (pass == 1); lat = true;
    }
    bf16_t* obuf = dir ? GLA_OB(p) : GLA_OF(p);
    const bf16_t* ib = dir ? img1 : proj;
    const long istr = dir ? 1024 : 3072;
    const int vcol = vt * 64 + nt * 32 + l31;
    const int sgn = dir ? -1 : 1;
    const int offq = (dir ? 31 - irow : irow) * (int)istr + icol;
    const int offv = (dir ? 31 - irow : irow) * 3072 + (tid & 7) * 8;
    const int offo = (dir ? 31 - 4 * hf : 4 * hf) * 1024 + vcol;
    f32x16 S0, S1;
    if (pass == 0) {
#pragma unroll
      for (int r = 0; r < 16; ++r) { S0[r] = 0.f; S1[r] = 0.f; }
    } else {
      const int rb = opq((kh * 64 + 4 * hf) * 256 + vcol);
      const float* s0 = p.state_gla + ((((long)b * 2 + j) * 2 + dir) * 4 + hh) * 128 * 256 + rb;
#pragma unroll
      for (int r = 0; r < 16; ++r) {
        S0[r] = s0[crow_(r, 0) * 256];
        S1[r] = s0[(32 + crow_(r, 0)) * 256];
      }
      int i = 0;
      const int gofs = opq(kh * 64 + 4 * hf);
      for (; i + 1 < sidx; i += 2) {
        const int ci = (((b * 8 + i) * 4 + hh) * 2 + dir), cj = (((b * 8 + i + 1) * 4 + hh) * 2 + dir);
        const float* sl = sloc + (long)ci * 128 * 256 + rb;
        const float* gs = gseg + ci * 128 + gofs;
        const float* sl2 = sloc + (long)cj * 128 * 256 + rb;
        const float* gs2 = gseg + cj * 128 + gofs;
        float la0[16], la1[16], ga0[16], ga1[16], lb0[16], lb1[16], gb0[16], gb1[16];
#pragma unroll
        for (int r = 0; r < 16; ++r) {
          ga0[r] = gs[crow_(r, 0)]; ga1[r] = gs[32 + crow_(r, 0)];
          la0[r] = sl[crow_(r, 0) * 256]; la1[r] = sl[(32 + crow_(r, 0)) * 256];
          gb0[r] = gs2[crow_(r, 0)]; gb1[r] = gs2[32 + crow_(r, 0)];
          lb0[r] = sl2[crow_(r, 0) * 256]; lb1[r] = sl2[(32 + crow_(r, 0)) * 256];
        }
#pragma unroll
        for (int r = 0; r < 16; ++r) {
          S0[r] = __expf(gb0[r]) * (__expf(ga0[r]) * S0[r] + la0[r]) + lb0[r];
          S1[r] = __expf(gb1[r]) * (__expf(ga1[r]) * S1[r] + la1[r]) + lb1[r];
        }
      }
      for (; i < sidx; ++i) {
        const int ci = (((b * 8 + i) * 4 + hh) * 2 + dir);
        const float* sl = sloc + (long)ci * 128 * 256 + rb;
        const float* gs = gseg + ci * 128 + gofs;
#pragma unroll
        for (int r = 0; r < 16; ++r) {
          S0[r] = __expf(gs[crow_(r, 0)]) * S0[r] + sl[crow_(r, 0) * 256];
          S1[r] = __expf(gs[32 + crow_(r, 0)]) * S1[r] + sl[(32 + crow_(r, 0)) * 256];
        }
      }
    }
    float gsum = 0.f;
    struct GlaRegs { uint4 q0, q1, k0, k1, v; float bl; };
    GlaRegs RA, RB;
    RA.q0 = make_uint4(0u, 0u, 0u, 0u); RA.q1 = RA.q0; RB.q0 = RA.q0; RB.q1 = RA.q0; RA.bl = 0.f; RB.bl = 0.f;
#define GLA_TOK(u_) ((long)tbase + (dir ? (L - 1 - (u_)) : (u_)))
    auto gla_load = [&](const int c_, GlaRegs& R) __attribute__((always_inline)) {
      const int ub = sidx * 256 + c_ * 32;
      const long TB = (long)tbase + (dir ? (L - 32 - ub) : ub);
      {
        const bf16_t* rp = ib + TB * istr + hh * 128 + offq;
        if (full) { R.q0 = *(const uint4*)rp; R.q1 = *(const uint4*)(rp + 8); }
        R.k0 = *(const uint4*)(rp + 512); R.k1 = *(const uint4*)(rp + 520);
      }
      R.v = *(const uint4*)(proj + TB * 3072 + 1024 + hh * 256 + vt * 64 + offv);
      if (tid < 128) R.bl = blast[((long)dir * (NTOK / 32) + (TB >> 5)) * 512 + hh * 128 + tid];
    };
    auto gla_chunk = [&](const int c, GlaRegs& R) __attribute__((always_inline)) {
      if (full) {
        *(uint4*)(sQ + irow * QS + icol) = R.q0; *(uint4*)(sQ + irow * QS + icol + 8) = R.q1;
      }
      *(uint4*)(sKb + kimg_off(irow, 2 * (tid & 7))) = R.k0;
      *(uint4*)(sKb + kimg_off(irow, 2 * (tid & 7) + 1)) = R.k1;
      *(uint4*)(sVb + kimg_off(irow, tid & 7)) = R.v;
      if (tid < 128) { sDec[tid] = __expf(R.bl); gsum += R.bl; }
      __syncthreads();
      if (c + 2 < 8) gla_load(c + 2, R);
#pragma unroll
      for (int r = 0; r < 16; ++r) {
        S0[r] *= sDec[kh * 64 + crow_(r, hf)];
        S1[r] *= sDec[kh * 64 + 32 + crow_(r, hf)];
      }
      f32x16 o;
      if (full) {
        f32x16 att;
#pragma unroll
        for (int r = 0; r < 16; ++r) { att[r] = 0.f; o[r] = 0.f; }
#pragma unroll
        for (int kk = 0; kk < 8; ++kk) {
          const bf16x8 a = *(const bf16x8*)(sKb + kimg_off(l31, 2 * kk + hf));
          const bf16x8 bq = *(const bf16x8*)(sQ + l31 * QS + kk * 16 + 8 * hf);
          att = __builtin_amdgcn_mfma_f32_32x32x16_bf16(a, bq, att, 0, 0, 0);
        }
#pragma unroll
        for (int r = 0; r < 16; ++r) if (crow_(r, hf) > l31) att[r] = 0.f;
#pragma unroll
        for (int st = 0; st < 2; ++st) {
          {
            const bf16_t* qa = sQ + l31 * QS + kh * 64 + 16 * st + 4 * hf;
            o = __builtin_amdgcn_mfma_f32_32x32x16_bf16(ld2x8(qa, qa + 8), pack8(S0, st), o, 0, 0, 0);
          }
          {
            const bf16_t* qa = sQ + l31 * QS + kh * 64 + 32 + 16 * st + 4 * hf;
            o = __builtin_amdgcn_mfma_f32_32x32x16_bf16(ld2x8(qa, qa + 8), pack8(S1, st), o, 0, 0, 0);
          }
        }
        {
          const bf16x8 pa0 = pack8(att, 0), pa1 = pack8(att, 1);
          const bf16x8 pa = kh ? pa1 : pa0;
          s16x4 u0, u1;
          asm volatile("ds_read_b64_tr_b16 %0, %2\n\tds_read_b64_tr_b16 %1, %3\n\ts_waitcnt lgkmcnt(0)"
                       : "=&v"(u0), "=&v"(u1) : "v"(vtrp0), "v"(vtrp1) : "memory");
          o = __builtin_amdgcn_mfma_f32_32x32x16_bf16(pa, __builtin_shufflevector(u0, u1, 0, 1, 2, 3, 4, 5, 6, 7), o, 0, 0, 0);
        }
        if (kh == 1) {
#pragma unroll
          for (int r = 0; r < 16; ++r) sOp[(nt * 32 + crow_(r, hf)) * 32 + l31] = o[r];
        }
      }
      {
        s16x4 t00, t01, t02, t03, t10, t11, t12, t13;
        s16x4 w0, w1, w2, w3;
        asm volatile(
            "ds_read_b64_tr_b16 %0, %12\n\t"
            "ds_read_b64_tr_b16 %1, %13\n\t"
            "ds_read_b64_tr_b16 %2, %14\n\t"
            "ds_read_b64_tr_b16 %3, %15\n\t"
            "ds_read_b64_tr_b16 %4, %16\n\t"
            "ds_read_b64_tr_b16 %5, %17\n\t"
            "ds_read_b64_tr_b16 %6, %18\n\t"
            "ds_read_b64_tr_b16 %7, %19\n\t"
            "ds_read_b64_tr_b16 %8, %20\n\t"
            "ds_read_b64_tr_b16 %9, %21\n\t"
            "ds_read_b64_tr_b16 %10, %22\n\t"
            "ds_read_b64_tr_b16 %11, %23\n\t"
            "s_waitcnt lgkmcnt(0)"
            : "=&v"(t00), "=&v"(t01), "=&v"(t02), "=&v"(t03), "=&v"(t10), "=&v"(t11), "=&v"(t12), "=&v"(t13),
              "=&v"(w0), "=&v"(w1), "=&v"(w2), "=&v"(w3)
            : "v"(ktr0), "v"(ktr1), "v"(ktr2), "v"(ktr3), "v"(ktr4), "v"(ktr5), "v"(ktr6), "v"(ktr7),
              "v"(vtr0), "v"(vtr1), "v"(vtr2), "v"(vtr3)
            : "memory");
        const bf16x8 a00 = __builtin_shufflevector(t00, t01, 0, 1, 2, 3, 4, 5, 6, 7);
        const bf16x8 a01 = __builtin_shufflevector(t02, t03, 0, 1, 2, 3, 4, 5, 6, 7);
        const bf16x8 a10 = __builtin_shufflevector(t10, t11, 0, 1, 2, 3, 4, 5, 6, 7);
        const bf16x8 a11 = __builtin_shufflevector(t12, t13, 0, 1, 2, 3, 4, 5, 6, 7);
        const bf16x8 bv0 = __builtin_shufflevector(w0, w1, 0, 1, 2, 3, 4, 5, 6, 7);
        const bf16x8 bv1 = __builtin_shufflevector(w2, w3, 0, 1, 2, 3, 4, 5, 6, 7);
        S0 = __builtin_amdgcn_mfma_f32_32x32x16_bf16(a00, bv0, S0, 0, 0, 0);
        S1 = __builtin_amdgcn_mfma_f32_32x32x16_bf16(a10, bv0, S1, 0, 0, 0);
        S0 = __builtin_amdgcn_mfma_f32_32x32x16_bf16(a01, bv1, S0, 0, 0, 0);
        S1 = __builtin_amdgcn_mfma_f32_32x32x16_bf16(a11, bv1, S1, 0, 0, 0);
      }
      __syncthreads();
      if (full && kh == 0) {
        const int ub = sidx * 256 + c * 32;
        const long TB = (long)tbase + (dir ? (L - 32 - ub) : ub);
#pragma unroll
        for (int r = 0; r < 16; ++r) {
          const int srow = crow_(r, hf);
          const float val = o[r] + sOp[(nt * 32 + srow) * 32 + l31];
          bf16_t* uo = obuf + (TB + sgn * (8 * (r >> 2) + (r & 3))) * 1024 + hh * 256;
          uo[offo] = f2bf(val);
        }
      }
    };
    gla_load(0, RA);
    gla_load(1, RB);
    __syncthreads();
    for (int c = 0; c < 8; c += 2) {
      gla_chunk(c, RA);
      gla_chunk(c + 1, RB);
    }
    const int rbo = opq((kh * 64 + 4 * hf) * 256 + vcol);
    if (!lat) {
      float* so = p.out + (long)NTOK * 1024 + ((((long)b * 2 + j) * 2 + dir) * 4 + hh) * 128 * 256 + rbo;
#pragma unroll
      for (int r = 0; r < 16; ++r) {
        __builtin_nontemporal_store(S0[r], &so[crow_(r, 0) * 256]);
        __builtin_nontemporal_store(S1[r], &so[(32 + crow_(r, 0)) * 256]);
      }
    } else if (pass == 0) {
      const int ci = (((b * 8 + sidx) * 4 + hh) * 2 + dir);
      float* sl = sloc + (long)ci * 128 * 256 + rbo;
#pragma unroll
      for (int r = 0; r < 16; ++r) {
        sl[crow_(r, 0) * 256] = S0[r];
        sl[(32 + crow_(r, 0)) * 256] = S1[r];
      }
      if (vt == 0 && tid < 128) gseg[ci * 128 + tid] = gsum;
    }
    __syncthreads();
  }
}

static __device__ __forceinline__ void phase_gla_combine(const Params& p, int j) {
  const int tid = opaque_tid(); const int bid = opaque_bid(); (void)tid; (void)bid;
  const int lane = tid & 63, wave = tid >> 6;
  const bf16_t* proj = GLA_PROJ(p);
  const bf16_t* of = GLA_OF(p);
  const bf16_t* ob = GLA_OB(p);
  const float* og = p.gla_onorm_g + j * 256;
  const float4 gg = *(const float4*)(og + lane * 4);
  const int stride = gridDim.x * 4;
  for (int it0 = bid * 4 + wave; it0 < NTOK * 4; it0 += 4 * stride) {
    uint2 a[4], b[4], r[4];
#pragma unroll
    for (int u = 0; u < 4; ++u) {
      const int it = it0 + u * stride;
      if (it < NTOK * 4) {
        const int t = it >> 2, hh = it & 3;
        const long base = (long)t * 1024 + hh * 256 + lane * 4;
        a[u] = *(const uint2*)(of + base);
        b[u] = *(const uint2*)(ob + base);
        r[u] = *(const uint2*)(proj + (long)t * 3072 + 2048 + hh * 256 + lane * 4);
      }
    }
#pragma unroll
    for (int u = 0; u < 4; ++u) {
      const int it = it0 + u * stride;
      if (it < NTOK * 4) {
        const int t = it >> 2, hh = it & 3;
        const long base = (long)t * 1024 + hh * 256 + lane * 4;
        float o[4];
        o[0] = bf2f(a[u].x & 0xffff) + bf2f(b[u].x & 0xffff);
        o[1] = bf2f(a[u].x >> 16) + bf2f(b[u].x >> 16);
        o[2] = bf2f(a[u].y & 0xffff) + bf2f(b[u].y & 0xffff);
        o[3] = bf2f(a[u].y >> 16) + bf2f(b[u].y >> 16);
        const float r0 = bf2f(r[u].x & 0xffff), r1 = bf2f(r[u].x >> 16), r2 = bf2f(r[u].y & 0xffff), r3 = bf2f(r[u].y >> 16);
        float ss = o[0] * o[0] + o[1] * o[1] + o[2] * o[2] + o[3] * o[3];
#pragma unroll
        for (int sft = 32; sft > 0; sft >>= 1) ss += __shfl_xor(ss, sft);
        const float rstd = rsqrtf(ss * (1.0f / 256.0f) + 1e-6f);
        uint2 w;
        w.x = pk2(o[0] * rstd * gg.x * siluf(r0), o[1] * rstd * gg.y * siluf(r1));
        w.y = pk2(o[2] * rstd * gg.z * siluf(r2), o[3] * rstd * gg.w * siluf(r3));
        *(uint2*)(p.h + base) = w;
      }
    }
  }
}

#define FN_PROJ(p) ((p).big)
#define FN_XCS_CTX(p) ((p).big + (long)NTOK * 2048)
#define FN_XCS_LAT(p) (FN_XCS_CTX(p) + (long)NCTX * 2048)

static __device__ __forceinline__ void phase_fn_in(const Params& p, char* smem) {
  const int tid = opaque_tid(); const int bid = opaque_bid(); (void)tid; (void)bid;
  bf16_t* sA = (bf16_t*)smem;
  GEMM_STAGE_DECL
  bool pre = false;
  bf16_t* proj = FN_PROJ(p);
  const int n_tiles = 96 * 16;
  for (int tile = bid; tile < n_tiles; tile += gridDim.x) {
    const int mt = tile % 96, nt = tile / 96;
    const int m0 = mt * 128, n0 = nt * 128;
    f32x16 acc[2][2];
    {
      const int tn = tile + gridDim.x;
      const bool hn = tn < n_tiles;
      gemm_tile(p.h + (long)m0 * 1024, 1024, p.wt_fn_in + (long)n0 * 1024, 1024, 1024, sA, acc, tid, GEMM_STAGE_ARGS, pre,
                hn ? p.h + (long)((tn % 96) * 128) * 1024 : nullptr, hn ? p.wt_fn_in + (long)((tn / 96) * 128) * 1024 : nullptr);
      pre = hn;
    }
    {
      bf16_t* tb = proj + (long)m0 * 2048 + n0;
      EPIS_BEGIN
        const unsigned lo = 2u * (unsigned)(e_rowl * 2048 + e_coll);
        *(bf16_t*)((char*)(tb + e_rowu * 2048 + e_colu) + lo) = f2bf(val);
      EPI_END
    }
  }
}

static __device__ __forceinline__ void phase_fn_a(const Params& p, char* smem) {
  const int tid = opaque_tid(); const int bid = opaque_bid(); (void)tid; (void)bid;
  bf16_t* sA = (bf16_t*)smem;
  GEMM_STAGE_DECL
  const bf16_t* proj = FN_PROJ(p);
  const int n_tiles = 4 * 96 * 4;
  for (int tile = bid; tile < n_tiles; tile += gridDim.x) {
    const int mt = tile & 3, g = (tile >> 2) & 3, tt = tile >> 4;
    const int m0 = mt * 128, t0 = tt * 128;
    f32x16 acc[2][2];
    gemm_tile(p.tabA + (long)m0 * 256, 256, proj + (long)t0 * 2048 + g * 256, 2048, 256, sA, acc, tid, GEMM_STAGE_ARGS, false, nullptr, nullptr);
    const bool lat = t0 >= NCTX;
    const int L = lat ? LLAT : LCTX;
    const int b = lat ? ((t0 - NCTX) >> 11) : (t0 >> 8);
    const int pos0 = lat ? ((t0 - NCTX) & 2047) : (t0 & 255);
    bf16_t* dst = lat ? FN_XCS_LAT(p) : FN_XCS_CTX(p);
    EPI_BEGIN_OPQ
      const int m = m0 + row;
      const int cs = m >> 8, co = m & 255;
      dst[((long)((b * 4 + g) * 256 + co)) * (2 * L) + cs * L + pos0 + col] = f2bf(val);
    EPI_END
  }
}

static __device__ __forceinline__ void phase_fn_b(const Params& p, char* smem) {
  const int tid = opaque_tid(); const int bid = opaque_bid(); (void)tid; (void)bid;
  bf16_t* sA = (bf16_t*)smem;
  GEMM_STAGE_DECL
  const bf16_t* proj = FN_PROJ(p);
  const int n_lat = 2 * 4 * 16 * 2;
  const int n_ctx = 32 * 4 * 2 * 2;
  const bool rebal = (gridDim.x == 512);
  for (int it_ = bid; it_ < (rebal ? 1024 : n_lat + n_ctx); it_ += gridDim.x) {
    int tile = it_;
    if (rebal) {
      if (it_ < 512) tile = (it_ < 256) ? it_ : (256 + 2 * (it_ - 256));
      else tile = (it_ - 512 < 256) ? -1 : (256 + 2 * (it_ - 768) + 1);
      if (tile < 0) continue;
    }
    int b, g, mt, nt, L, tbase;
    const bf16_t *tab, *xcs;
    if (tile < n_lat) {
      nt = tile & 1; mt = (tile >> 1) & 15; g = (tile >> 5) & 3; b = tile >> 7;
      L = LLAT; tbase = NCTX + b * LLAT; tab = p.tabB_lat; xcs = FN_XCS_LAT(p);
    } else {
      int t2 = tile - n_lat;
      nt = t2 & 1; mt = (t2 >> 1) & 1; g = (t2 >> 2) & 3; b = t2 >> 4;
      L = LCTX; tbase = b * LCTX; tab = p.tabB_ctx; xcs = FN_XCS_CTX(p);
    }
    const int m0 = mt * 128, n0 = nt * 128;
    f32x16 acc[2][2];
    gemm_tile(tab + (long)m0 * (2 * L), 2 * L, xcs + ((long)((b * 4 + g) * 256 + n0)) * (2 * L), 2 * L, 2 * L, sA, acc, tid, GEMM_STAGE_ARGS, false, nullptr, nullptr);
    const float scale = rsqrtf((float)L * 256.0f);
    {
      const int e_lane = tid & 63, e_wave = tid >> 6;
      const int e_wm = e_wave >> 1, e_wn = e_wave & 1;
#pragma unroll
      for (int e_i = 0; e_i < 2; ++e_i)
#pragma unroll
        for (int e_j = 0; e_j < 2; ++e_j) {
          const int rowb = opq(e_wm * 64 + e_i * 32 + 4 * (e_lane >> 5));
          const int ch = g * 256 + n0 + e_wn * 64 + e_j * 32 + (e_lane & 31);
          bf16_t zr[16];
#pragma unroll
          for (int e_r = 0; e_r < 16; ++e_r) zr[e_r] = proj[(long)(tbase + m0 + rowb + 8 * (e_r >> 2) + (e_r & 3)) * 2048 + 1024 + ch];
#pragma unroll
          for (int e_r = 0; e_r < 16; ++e_r)
            p.h[(long)(tbase + m0 + rowb + 8 * (e_r >> 2) + (e_r & 3)) * 1024 + ch] = f2bf(acc[e_i][e_j][e_r] * scale * siluf(bf2f(zr[e_r])));
        }
    }
  }
}

#define HY_UT(p) ((p).big)
#define HY_YT(p) ((p).big + (long)4096 * NTOK)

static __device__ __forceinline__ void phase_hy_in(const Params& p, char* smem) {
  const int tid = opaque_tid(); const int bid = opaque_bid(); (void)tid; (void)bid;
  bf16_t* sA = (bf16_t*)smem;
  GEMM_STAGE_DECL
  bool pre = false;
  bf16_t* uT = HY_UT(p);
  const int n_tiles = 32 * 96;
  for (int tile = bid; tile < n_tiles; tile += gridDim.x) {
    const int nt = tile % 96, mt = tile / 96;
    const int m0 = mt * 128, n0 = nt * 128;
    f32x16 acc[2][2];
    {
      const int tn = tile + gridDim.x;
      const bool hn = tn < n_tiles;
      gemm_tile(p.wt_hy_in + (long)m0 * 1024, 1024, p.h + (long)n0 * 1024, 1024, 1024, sA, acc, tid, GEMM_STAGE_ARGS, pre,
                hn ? p.wt_hy_in + (long)((tn / 96) * 128) * 1024 : nullptr, hn ? p.h + (long)((tn % 96) * 128) * 1024 : nullptr);
      pre = hn;
    }
    {
      bf16_t* tb = uT + (long)m0 * NTOK + n0;
      EPIS_BEGIN
        const unsigned lo = 2u * (unsigned)(e_rowl * NTOK + e_coll);
        *(bf16_t*)((char*)(tb + e_rowu * NTOK + e_colu) + lo) = f2bf(val);
      EPI_END
    }
  }
}

__device__ __forceinline__ int upad(int pos) { return pos + 8 * (pos >> 5); }
static __device__ __forceinline__ void phase_hy_conv(const Params& p, char* smem) {
  const int tid = opaque_tid(); const int bid = opaque_bid();
  bf16_t* sU = (bf16_t*)smem;
  bf16_t* sX1 = sU + 10240;
  bf16_t* sX2 = sX1 + 8192;
  bf16_t* sR0 = sX2 + 8192;
  bf16_t* sR1 = sR0 + 4128;
  const bf16_t* uT = HY_UT(p);
  bf16_t* yT = HY_YT(p);
  const int lane = tid & 63, wave = tid >> 6, l31 = lane & 31, hf = lane >> 5;
  const int n_items = 1024 + 1024;
  for (int it = bid; it < n_items; it += gridDim.x) {
    const bool lat = it < 1024;
    const int ch = lat ? it : (it - 1024);
    const int L = lat ? LLAT : LCTX;
    const int nb = L >> 5;
    const int tok0 = lat ? NCTX : 0;
    const int ntw = lat ? 1 : 2;
    const bf16_t* filt = (lat ? p.filt_lat : p.filt_ctx);
    __syncthreads();
    for (int pc = 0; pc < ntw; ++pc) {
      const int p0 = pc * 4096 + tid * 16;
      const bool has_l = (p0 & (L - 1)) != 0, has_r = ((p0 + 16) & (L - 1)) != 0;
#pragma unroll
      for (int g = 0; g < 3; ++g) {
        const int f = g * 1024 + ch;
        const bf16_t* row = uT + (long)f * NTOK + tok0 + p0;
        const uint4 v0 = *(const uint4*)row, v1 = *(const uint4*)(row + 8);
        float e[18];
        e[0] = has_l ? bf2f(row[-1]) : 0.f;
        e[17] = has_r ? bf2f(row[16]) : 0.f;
        const unsigned vv[8] = {v0.x, v0.y, v0.z, v0.w, v1.x, v1.y, v1.z, v1.w};
#pragma unroll
        for (int q = 0; q < 8; ++q) { e[1 + 2 * q] = bf2f((bf16_t)(vv[q] & 0xffffu)); e[2 + 2 * q] = bf2f((bf16_t)(vv[q] >> 16)); }
        const float w0 = p.hy_conv_w[f], w1 = p.hy_conv_w[3072 + f], w2 = p.hy_conv_w[6144 + f], bb = p.hy_conv_b[f];
        unsigned o[8];
#pragma unroll
        for (int q = 0; q < 8; ++q) {
          const float a0 = e[2 * q] * w0 + e[2 * q + 1] * w1 + e[2 * q + 2] * w2 + bb;
          const float a1 = e[2 * q + 1] * w0 + e[2 * q + 2] * w1 + e[2 * q + 3] * w2 + bb;
          o[q] = pk2(a0, a1);
        }
        bf16_t* dst = (g == 0) ? (sX1 + p0) : (g == 1) ? (sX2 + p0) : (sU + upad(p0));
        uint4 o0, o1;
        o0.x = o[0]; o0.y = o[1]; o0.z = o[2]; o0.w = o[3];
        o1.x = o[4]; o1.y = o[5]; o1.z = o[6]; o1.w = o[7];
        *(uint4*)dst = o0;
        *(uint4*)(dst + 8) = o1;
      }
    }
    const int xa = (L - 1) - l31 + 8 * hf;
    const bf16_t* Rp = (xa & 1) ? (sR1 - 1) : sR0;
    float y1r[2][16];
    for (int order = 0; order < 2; ++order) {
      const bf16_t* fsrc = filt + ((long)(order * 1024 + ch)) * (2 * L);
      for (int x8 = tid; x8 < (2 * L) / 8; x8 += NTHR) {
        const uint4 v = *(const uint4*)(fsrc + 8 * x8);
        *(uint4*)(sR0 + 8 * x8) = v;
        const unsigned vv[4] = {v.x, v.y, v.z, v.w};
#pragma unroll
        for (int q = 0; q < 4; ++q) {
          if (8 * x8 + 2 * q >= 1) sR1[8 * x8 + 2 * q - 1] = (bf16_t)(vv[q] & 0xffffu);
          sR1[8 * x8 + 2 * q] = (bf16_t)(vv[q] >> 16);
        }
      }
      __syncthreads();
      const float dsk = p.hy_d[order * 1024 + ch];
      const bf16_t* gate = order ? sX2 : sX1;
#pragma unroll
      for (int tt = 0; tt < 2; ++tt) {
        if (tt < ntw) {
          int bt, i_blk, dlo, dhi;
          if (lat) { bt = wave >> 1; const int i0 = 32 * (wave & 1); i_blk = i0 + l31; dlo = i0 - 63; dhi = i0 + 31; }
          else { bt = 4 * (2 * wave + tt) + (l31 >> 3); i_blk = l31 & 7; dlo = -7; dhi = 7; }
          const bf16_t* ubase = sU + upad(bt * L);
          const int pos_base = bt * L + 32 * i_blk + 4 * hf;
          f32x16 acc;
#pragma unroll
          for (int r = 0; r < 16; ++r) acc[r] = 0.f;
          for (int d = dlo; d <= dhi; ++d) {
            const int jb = i_blk - d;
            const bool valid = (unsigned)jb < (unsigned)nb;
            const int jc = valid ? jb : 0;
            const bf16_t* bp = ubase + 40 * jc + 8 * hf;
            const unsigned* ap = (const unsigned*)(Rp + (xa - 32 * d));
#pragma unroll
            for (int ks2 = 0; ks2 < 2; ++ks2) {
              union { unsigned u[4]; bf16x8 v; } A;
              A.u[0] = ap[8 * ks2 + 0]; A.u[1] = ap[8 * ks2 + 1]; A.u[2] = ap[8 * ks2 + 2]; A.u[3] = ap[8 * ks2 + 3];
              union { uint4 q; bf16x8 v; } B;
              B.q = *(const uint4*)(bp + 16 * ks2);
              if (!valid) { B.q.x = 0u; B.q.y = 0u; B.q.z = 0u; B.q.w = 0u; }
              acc = __builtin_amdgcn_mfma_f32_32x32x16_bf16(A.v, B.v, acc, 0, 0, 0);
            }
          }
#pragma unroll
          for (int g = 0; g < 4; ++g) {
            const int pos = pos_base + 8 * g;
            const uint2 gg = *(const uint2*)(gate + pos);
            const uint2 uo = *(const uint2*)(sU + upad(pos));
            const float g0 = bf2f((bf16_t)(gg.x & 0xffffu)), g1 = bf2f((bf16_t)(gg.x >> 16)), g2 = bf2f((bf16_t)(gg.y & 0xffffu)), g3 = bf2f((bf16_t)(gg.y >> 16));
            const float u0 = bf2f((bf16_t)(uo.x & 0xffffu)), u1 = bf2f((bf16_t)(uo.x >> 16)), u2 = bf2f((bf16_t)(uo.y & 0xffffu)), u3 = bf2f((bf16_t)(uo.y >> 16));
            y1r[tt][4 * g + 0] = g0 * (acc[4 * g + 0] + dsk * u0);
            y1r[tt][4 * g + 1] = g1 * (acc[4 * g + 1] + dsk * u1);
            y1r[tt][4 * g + 2] = g2 * (acc[4 * g + 2] + dsk * u2);
            y1r[tt][4 * g + 3] = g3 * (acc[4 * g + 3] + dsk * u3);
          }
        }
      }
      __syncthreads();
#pragma unroll
      for (int tt = 0; tt < 2; ++tt) {
        if (tt < ntw) {
          int bt, i_blk;
          if (lat) { bt = wave >> 1; i_blk = 32 * (wave & 1) + l31; }
          else { bt = 4 * (2 * wave + tt) + (l31 >> 3); i_blk = l31 & 7; }
          const int pos_base = bt * L + 32 * i_blk + 4 * hf;
          if (order == 0) {
#pragma unroll
            for (int g = 0; g < 4; ++g) {
              uint2 w;
              w.x = pk2(y1r[tt][4 * g + 0], y1r[tt][4 * g + 1]);
              w.y = pk2(y1r[tt][4 * g + 2], y1r[tt][4 * g + 3]);
              *(uint2*)(sU + upad(pos_base + 8 * g)) = w;
            }
          } else {
            uint2 zz[4];
#pragma unroll
            for (int g = 0; g < 4; ++g) zz[g] = *(const uint2*)(uT + (long)(3072 + ch) * NTOK + tok0 + pos_base + 8 * g);
#pragma unroll
            for (int g = 0; g < 4; ++g) {
              const long gp = (long)tok0 + pos_base + 8 * g;
              const float z0 = bf2f((bf16_t)(zz[g].x & 0xffffu)), z1 = bf2f((bf16_t)(zz[g].x >> 16)), z2 = bf2f((bf16_t)(zz[g].y & 0xffffu)), z3 = bf2f((bf16_t)(zz[g].y >> 16));
              uint2 w;
              w.x = pk2(y1r[tt][4 * g + 0] * siluf(z0), y1r[tt][4 * g + 1] * siluf(z1));
              w.y = pk2(y1r[tt][4 * g + 2] * siluf(z2), y1r[tt][4 * g + 3] * siluf(z3));
              *(uint2*)(yT + (long)ch * NTOK + gp) = w;
            }
          }
        }
      }
    }
  }
}

static __device__ __forceinline__ void phase_hy_transpose(const Params& p, char* smem) {
  const int tid = opaque_tid(); const int bid = opaque_bid(); (void)tid; (void)bid;
  bf16_t* t = (bf16_t*)smem;
  const bf16_t* yT = HY_YT(p);
  const int n_items = 16 * 192;
  for (int it = bid; it < n_items; it += gridDim.x) {
    const int ct = it & 15, tt = it >> 4;
    const int c0 = ct * 64, t0 = tt * 64;
    __syncthreads();
    for (int i = tid; i < 64 * 64; i += NTHR) {
      int r = i >> 6, cc = i & 63;
      t[cc * 66 + r] = yT[(long)(c0 + r) * NTOK + t0 + cc];
    }
    __syncthreads();
    for (int i = tid; i < 64 * 64; i += NTHR) {
      int r = i >> 6, cc = i & 63;
      p.h[(long)(t0 + r) * 1024 + c0 + cc] = t[r * 66 + cc];
    }
  }
}

#define XB_TMO      128
#define XB_XCNT(j)  (256  + 64 * (j))
#define XB_XSUB(j)  (1280 + 64 * (j))
#define XB_XGEN(j)  (2304 + 64 * (j))
#define XB_TOP      3328
#define XB_TOPGEN   3392
#define XCD_BAR_WORDS 3456
#define XB_SPIN_CAP (1u << 18)
#define LAS __attribute__((address_space(3)))
__device__ __forceinline__ unsigned xb_ld(unsigned* p)              { return __hip_atomic_load(p, __ATOMIC_RELAXED, __HIP_MEMORY_SCOPE_AGENT); }
__device__ __forceinline__ unsigned xb_add(unsigned* p, unsigned v) { return __hip_atomic_fetch_add(p, v, __ATOMIC_RELAXED, __HIP_MEMORY_SCOPE_AGENT); }
__device__ __forceinline__ unsigned xb_xcc_id() { return (unsigned)__builtin_amdgcn_s_getreg((3 << 11) | 20) & 0xFu; }
#define XB_SPIN(cond, bar) do { unsigned _sp = 0; while (cond) { __builtin_amdgcn_s_sleep(1); \
    if ((++_sp & 255u) == 0u) { if (xb_ld(&(bar)[XB_TMO])) break; if (_sp > XB_SPIN_CAP) { atomicAdd(&(bar)[XB_TMO], 1u); break; } } } } while (0)
struct XcdBarrier { unsigned* bar; unsigned x; volatile LAS unsigned* st; };
__device__ __forceinline__ XcdBarrier xcd_barrier_post(unsigned* bar, volatile LAS unsigned* st) {
    XcdBarrier b; b.bar = bar; b.x = xb_xcc_id(); b.st = st;
    if (threadIdx.x == 0) (void)xb_add(&bar[XB_XCNT(b.x)], 1u);
    return b;
}
__device__ __forceinline__ void xcd_barrier_complete(unsigned* bar, unsigned x, unsigned& nloc, unsigned& nx) {
    const unsigned G = gridDim.x * gridDim.y * gridDim.z;
    unsigned sum, cnt, mine, sp = 0u;
    for (;;) {
        sum = 0u; cnt = 0u; mine = 0u;
#pragma unroll
        for (unsigned j = 0; j < 16; ++j) { const unsigned c = xb_ld(&bar[XB_XCNT(j)]); sum += c; cnt += (c > 0u) ? 1u : 0u; mine = (j == x) ? c : mine; }
        if (sum == G) break;
        __builtin_amdgcn_s_sleep(1);
        if ((++sp & 255u) == 0u) { if (xb_ld(&bar[XB_TMO])) break; if (sp > XB_SPIN_CAP) { atomicAdd(&bar[XB_TMO], 1u); break; } }
    }
    nloc = mine > 0u ? mine : 1u; nx = cnt > 0u ? cnt : 1u;
}
__device__ __forceinline__ void xcd_barrier(const XcdBarrier& b) {
    asm volatile("s_waitcnt vmcnt(0)" ::: "memory");
    __syncthreads();
    if (threadIdx.x == 0) {
        unsigned* bar = b.bar;
        __builtin_amdgcn_s_waitcnt(0);
        unsigned nloc = b.st[0], nx = b.st[1];
        if (nloc == 0u) { xcd_barrier_complete(bar, b.x, nloc, nx); b.st[0] = nloc; b.st[1] = nx; }
        const unsigned old = xb_add(&bar[XB_XSUB(b.x)], 1u);
        const unsigned gen = old / nloc;
        if (old + 1u == (gen + 1u) * nloc) {
            __builtin_amdgcn_fence(__ATOMIC_RELEASE, "agent");
            asm volatile("s_waitcnt vmcnt(0)" ::: "memory");
            const unsigned og = xb_add(&bar[XB_TOP], 1u);
            const unsigned tg = og / nx;
            if (og + 1u == (tg + 1u) * nx) xb_add(&bar[XB_TOPGEN], 1u);
            else XB_SPIN(xb_ld(&bar[XB_TOPGEN]) == tg, bar);
            __builtin_amdgcn_fence(__ATOMIC_ACQUIRE, "agent");
            xb_add(&bar[XB_XGEN(b.x)], 1u);
            asm volatile("s_waitcnt vmcnt(0)" ::: "memory");
        } else {
            XB_SPIN(xb_ld(&bar[XB_XGEN(b.x)]) == gen, bar);
            __builtin_amdgcn_fence(__ATOMIC_ACQUIRE, "agent");
            asm volatile("s_waitcnt vmcnt(0)" ::: "memory");
        }
    }
    __syncthreads();
}

__global__ void __launch_bounds__(NTHR, 2) mega(Params p) {
  cg::grid_group grid = cg::this_grid();
  __shared__ __attribute__((aligned(16))) char smem[SMEM_BYTES];
  __shared__ uint4 xb_words;
  if (threadIdx.x == 0) xb_words = make_uint4(0u, 0u, 0u, 0u);
  __syncthreads();
  const XcdBarrier xb = xcd_barrier_post(p.bar, (volatile LAS unsigned*)&xb_words);
  if (p.use_cg) grid.sync();
#define GSYNC() xcd_barrier(xb)
#define REP(id) for (int rep##id = 0; rep##id < (PROBE == (id) ? 3 : 1); ++rep##id)
  REP(19) {
  REP(1) { p0_mod(p, smem); }
  REP(2) { p0_filt_mlp(p, smem); }
  REP(3) { p0_tables(p, smem); }
  REP(4) { p0_weights(p, smem); }
  GSYNC();
  }
  if (PROBE == 5) { for (int rep = 0; rep < 40; ++rep) GSYNC(); }
  for (int layer = 0; layer < 4; ++layer) {
    const int kind = layer % 3, j = layer / 3;
    REP(6) { phase_norm(p, layer); if (layer == 1) phase_filt_main(p, smem); GSYNC(); }
    const bf16_t* wt_out;
    if (kind == 0) {
      REP(7) { phase_gla_in(p, j ? p.wt_gla_in1 : p.wt_gla_in0, smem); GSYNC(); }
      for (int rep = 0; rep < (PROBE == 17 ? 3 : 1); ++rep) { phase_gla_prep(p, j, smem, rep + 1 < (PROBE == 17 ? 3 : 1)); GSYNC(); }
      REP(8) { phase_gla_scan(p, j, 0, smem); GSYNC(); }
      REP(9) { phase_gla_scan(p, j, 1, smem); GSYNC(); }
      REP(10) { phase_gla_combine(p, j); GSYNC(); }
      wt_out = j ? p.wt_gla_out1 : p.wt_gla_out0;
    } else if (kind == 1) {
      REP(11) { phase_fn_in(p, smem); GSYNC(); }
      REP(12) { phase_fn_a(p, smem); GSYNC(); }
      REP(13) { phase_fn_b(p, smem); GSYNC(); }
      wt_out = p.wt_fn_out;
    } else {
      REP(14) { phase_hy_in(p, smem); GSYNC(); }
      REP(15) { phase_hy_conv(p, smem); GSYNC(); }
      REP(16) { phase_hy_transpose(p, smem); GSYNC(); }
      wt_out = p.wt_hy_out;
    }
    for (int rep = 0; rep < (PROBE == 18 ? 3 : 1); ++rep) { phase_gemm_out(p, layer, wt_out, smem, rep + 1 < (PROBE == 18 ? 3 : 1)); GSYNC(); }
  }
  phase_final_norm(p);
}

static inline size_t align_up(size_t x) { return (x + 255) & ~(size_t)255; }

extern "C" void kernel_launch(void* const* d_in, const int* in_sizes, int n_in, void* d_out,
                              int out_size, void* d_ws, size_t ws_size, hipStream_t stream) {
  static int grid_blocks = 0;
  if (!grid_blocks) {
    int dev = 0, cus = 0, per_cu = 0;
    hipGetDevice(&dev);
    hipDeviceGetAttribute(&cus, hipDeviceAttributeMultiprocessorCount, dev);
    hipOccupancyMaxActiveBlocksPerMultiprocessor(&per_cu, mega, NTHR, 0);
    if (per_cu > 2) per_cu = 2;
    if (per_cu < 1) per_cu = 1;
    grid_blocks = cus * per_cu;
  }
  Params p{};
  const float* const* in = (const float* const*)d_in;
  p.x_prompt = in[0]; p.x_sample = in[1]; p.state_gla = in[2]; p.c = in[3]; p.c_ctx = in[4];
  p.mod_w = in[5]; p.mod_b = in[6]; p.norm_g = in[7]; p.final_norm_g = in[8];
  p.gla_w_in = in[9]; p.gla_w_dec = in[10]; p.gla_b_dec = in[11]; p.gla_onorm_g = in[12]; p.gla_w_out = in[13];
  p.fn_w_in = in[14]; p.fn_w_out = in[15];
  p.hy_w_in = in[16]; p.hy_conv_w = in[17]; p.hy_conv_b = in[18];
  p.hy_w1 = in[19]; p.hy_b1 = in[20]; p.hy_w2 = in[21]; p.hy_b2 = in[22]; p.hy_w3 = in[23]; p.hy_b3 = in[24];
  p.hy_w4 = in[25]; p.hy_freq = in[26]; p.hy_d = in[27]; p.hy_w_out = in[28];
  p.out = (float*)d_out;
  char* w = (char*)d_ws;
  size_t off = 0;
  auto take = [&](size_t bytes) { char* r = w + off; off = align_up(off + bytes); return r; };
  p.h = (bf16_t*)take((size_t)NTOK * 1024 * 2);
  p.big = (bf16_t*)take((size_t)156 * 1024 * 1024);
  p.wt_gla_in0 = (bf16_t*)take((size_t)3200 * 1024 * 2);
  p.wt_gla_in1 = (bf16_t*)take((size_t)3200 * 1024 * 2);
  p.wt_gla_out0 = (bf16_t*)take((size_t)1024 * 1024 * 2);
  p.wt_gla_out1 = (bf16_t*)take((size_t)1024 * 1024 * 2);
  p.wt_fn_in = (bf16_t*)take((size_t)2048 * 1024 * 2);
  p.wt_fn_out = (bf16_t*)take((size_t)1024 * 1024 * 2);
  p.wt_hy_in = (bf16_t*)take((size_t)4096 * 1024 * 2);
  p.wt_hy_out = (bf16_t*)take((size_t)1024 * 1024 * 2);
  p.tabA = (bf16_t*)take((size_t)512 * 256 * 2);
  p.tabB_ctx = (bf16_t*)take((size_t)256 * 512 * 2);
  p.tabB_lat = (bf16_t*)take((size_t)2048 * 4096 * 2);
  p.filt_ctx = (bf16_t*)take((size_t)2 * 1024 * 512 * 2);
  p.filt_lat = (bf16_t*)take((size_t)2 * 1024 * 4096 * 2);
  p.filt_a3 = (float*)take((size_t)2304 * 64 * 4);
  p.bar = (unsigned*)take((size_t)XCD_BAR_WORDS * 4 + (size_t)4 * 3 * 3072 * 4);
  p.modv = (float*)(p.bar + XCD_BAR_WORDS);
  p.use_cg = 0; p.pad = 0;
  hipMemsetAsync(p.bar, 0, (size_t)XCD_BAR_WORDS * 4 + (size_t)4 * 3 * 3072 * 4, stream);
  void* args[] = {&p};
  hipError_t e = hipLaunchCooperativeKernel((void*)mega, dim3(grid_blocks), dim3(NTHR), args, 0, stream);
  if (e != hipSuccess) fprintf(stderr, "cooperative launch failed: %s (grid %d, ws %zu need %zu)\n", hipGetErrorString(e), grid_blocks, ws_size, off);
}
```
